# Optimizing an MI355X kernel written in HIP

```python
import jax, jax.numpy as jnp
from jax import lax
import numpy as np

D_MODEL = 2048
BATCH = 8
SEQ = 4096
DEPTH = 2

D_MIX = D_MODEL
W_ATTN = D_MIX // 4
W_CONV = D_MIX // 4
W_HGRN = D_MIX // 4
W_RET = D_MIX - W_ATTN - W_CONV - W_HGRN

HEAD_DIM = 64
N_ATTN_HEADS = W_ATTN // HEAD_DIM
N_KV_HEADS = 2
WINDOW = 128
ATTN_BLOCK = 128

CONV_WIDTH = 3

HGRN_HEADS = 4
HGRN_DK = W_HGRN // HGRN_HEADS
HGRN_DV = W_HGRN // HGRN_HEADS
HGRN_CHUNK = 64

RET_HEADS = 4
RET_DK = W_RET // RET_HEADS
RET_DV = W_RET // RET_HEADS
RET_CHUNK = 128

N_EXPERTS = 16
N_GROUPS = 4
EXPERTS_PER_GROUP = N_EXPERTS // N_GROUPS
TOP_K = 2
D_EXPERT = 1024

DEEPNORM_ALPHA = (2.0 * DEPTH) ** 0.25
DEEPNORM_BETA = (8.0 * DEPTH) ** -0.25
LN_EPS = 1e-5
HEAD_NORM_EPS = 1e-6

SPLIT_SIZES = (
    N_ATTN_HEADS * HEAD_DIM,
    N_KV_HEADS * HEAD_DIM,
    N_KV_HEADS * HEAD_DIM,
    W_CONV,
    W_CONV,
    W_CONV,
    HGRN_HEADS * HGRN_DK,
    HGRN_HEADS * HGRN_DK,
    HGRN_HEADS * HGRN_DK,
    HGRN_HEADS * HGRN_DV,
    W_HGRN,
    RET_HEADS * RET_DK,
    RET_HEADS * RET_DK,
    RET_HEADS * RET_DV,
    W_RET,
)
D_IN_PROJ = sum(SPLIT_SIZES)
SPLIT_POINTS = tuple(sum(SPLIT_SIZES[:i + 1]) for i in range(len(SPLIT_SIZES) - 1))

kernel_name = "hybrid_parallel_groups_deepnorm_grouped_moe"


def layer_norm(x, g, b):
    xf = x.astype(jnp.float32)
    mu = xf.mean(-1, keepdims=True)
    var = jnp.square(xf - mu).mean(-1, keepdims=True)
    return ((xf - mu) * lax.rsqrt(var + LN_EPS)).astype(x.dtype) * g + b


def rms_norm_heads(o, g):
    o = o * lax.rsqrt(jnp.square(o).mean(-1, keepdims=True) + HEAD_NORM_EPS)
    return o.reshape(o.shape[0], o.shape[1], -1) * g.astype(jnp.float32)


def group_norm_heads(o, g):
    o = o - o.mean(-1, keepdims=True)
    o = o * lax.rsqrt(jnp.square(o).mean(-1, keepdims=True) + HEAD_NORM_EPS)
    return o.reshape(o.shape[0], o.shape[1], -1) * g.astype(jnp.float32)


def flip_seq(t):
    return jnp.flip(t, axis=1)


def windowed_gqa_attention(q, k, v, sink):
    B, S = q.shape[0], q.shape[1]
    L = ATTN_BLOCK
    nb = S // L
    G = N_ATTN_HEADS // N_KV_HEADS
    qb = q.reshape(B, nb, L, N_KV_HEADS, G, HEAD_DIM)

    def neighbours(t):
        tb = t.reshape(B, nb, L, N_KV_HEADS, HEAD_DIM)
        tp = jnp.pad(tb, ((0, 0), (1, 1), (0, 0), (0, 0), (0, 0)))
        return jnp.concatenate([tp[:, :-2], tp[:, 1:-1], tp[:, 2:]], axis=2)

    kb, vb = neighbours(k), neighbours(v)
    scores = jnp.einsum('bnqhgd,bnkhd->bnhgqk', qb, kb,
                        preferred_element_type=jnp.float32) * (HEAD_DIM ** -0.5)

    k_rel = jnp.arange(3 * L) - L
    dist = k_rel[None, :] - jnp.arange(L)[:, None]
    k_abs = jnp.arange(nb)[:, None] * L + k_rel[None, :]
    valid = (k_abs >= 0) & (k_abs < S)
    mask = (jnp.abs(dist) <= WINDOW)[None] & valid[:, None, :]

    slopes = 2.0 ** (-8.0 * jnp.arange(1, N_ATTN_HEADS + 1, dtype=jnp.float32) / N_ATTN_HEADS)
    alibi = -slopes.reshape(N_KV_HEADS, G)[:, :, None, None] * jnp.abs(dist).astype(jnp.float32)
    scores = jnp.where(mask[None, :, None, None], scores + alibi, -jnp.inf)

    sink_l = sink.astype(jnp.float32).reshape(N_KV_HEADS, G)[None, None, :, :, None, None]
    m = jnp.maximum(scores.max(-1, keepdims=True), sink_l)
    p = jnp.exp(scores - m)
    probs = p / (p.sum(-1, keepdims=True) + jnp.exp(sink_l - m))
    out = jnp.einsum('bnhgqk,bnkhd->bnqhgd', probs.astype(vb.dtype), vb)
    return out.reshape(B, S, N_ATTN_HEADS * HEAD_DIM)


def short_conv_mixer(b_gate, c_gate, h, conv_w):
    u = c_gate * h
    up = jnp.pad(u, ((0, 0), (1, 1), (0, 0)))
    y = conv_w[0] * up[:, :-2] + conv_w[1] * up[:, 1:-1] + conv_w[2] * up[:, 2:]
    return b_gate * y


def hgrn2_chunk_scan(q, k, log_f, v):
    B, S, H, dk = q.shape
    dv = v.shape[-1]
    L = HGRN_CHUNK
    nc = S // L

    def chunks(t):
        return t.reshape(B, nc, L, H, t.shape[-1]).transpose(1, 0, 3, 2, 4)

    causal = jnp.tril(jnp.ones((L, L), dtype=bool))[..., None]

    def step(state, inp):
        qi, ki, gi, vi = inp
        b = jnp.cumsum(gi.astype(jnp.float32), axis=2)
        diff = b[:, :, :, None, :] - b[:, :, None, :, :]
        decay = jnp.exp(jnp.where(causal, diff, -jnp.inf))
        a = jnp.einsum('bhtd,bhsd,bhtsd->bhts', qi, ki, decay)
        o_intra = jnp.einsum('bhts,bhsv->bhtv', a, vi)
        o_inter = jnp.einsum('bhtd,bhdv->bhtv', qi * jnp.exp(b), state)
        b_last = b[:, :, -1:, :]
        k_dec = ki * jnp.exp(b_last - b)
        new_state = jnp.exp(b_last[:, :, 0, :])[..., None] * state + \
            jnp.einsum('bhsd,bhsv->bhdv', k_dec, vi)
        return new_state, o_intra + o_inter

    state0 = jnp.zeros((B, H, dk, dv), jnp.float32)
    _, o = lax.scan(step, state0, (chunks(q), chunks(k), chunks(log_f), chunks(v)))
    return o.transpose(1, 0, 3, 2, 4).reshape(B, S, H, dv)


def hgrn2_mixer(q, z_fwd, z_bwd, i, g, lb, norm_g):
    lb = lb.reshape(HGRN_HEADS, HGRN_DK)

    def gates(z):
        z = z.astype(jnp.float32)
        log_f = jnp.logaddexp(jnp.log(lb), jnp.log1p(-lb) + jax.nn.log_sigmoid(z))
        k = (1.0 - lb) * jax.nn.sigmoid(-z)
        return k, log_f

    k_f, lf_f = gates(z_fwd)
    k_b, lf_b = gates(z_bwd)
    o = hgrn2_chunk_scan(q, k_f, lf_f, i) + flip_seq(
        hgrn2_chunk_scan(flip_seq(q), flip_seq(k_b), flip_seq(lf_b), flip_seq(i)))
    return rms_norm_heads(o, norm_g) * jax.nn.silu(g.astype(jnp.float32))


def retention_chunkwise(q, k, v, log_gamma):
    B, S, H, dk = q.shape
    dv = v.shape[-1]
    L = RET_CHUNK
    nc = S // L
    qc = q.reshape(B, nc, L, H, dk)
    kc = k.reshape(B, nc, L, H, dk)
    vc = v.reshape(B, nc, L, H, dv)
    pos = jnp.arange(L, dtype=jnp.float32)
    rel = pos[:, None] - pos[None, :]
    D = jnp.exp(jnp.where(rel[None] >= 0, log_gamma[:, None, None] * rel[None], -jnp.inf))
    a = jnp.einsum('bnthd,bnshd->bnhts', qc, kc) * D
    o_intra = jnp.einsum('bnhts,bnshv->bnthv', a, vc)
    k_dec = kc * jnp.exp(log_gamma[None, :] * (L - 1 - pos)[:, None])[:, :, None]
    kv = jnp.einsum('bnshd,bnshv->nbhdv', k_dec, vc)
    chunk_decay = jnp.exp(log_gamma * L)[None, :, None, None]

    def step(state, kv_c):
        return chunk_decay * state + kv_c, state

    _, prev = lax.scan(step, jnp.zeros((B, H, dk, dv), jnp.float32), kv)
    q_dec = qc * jnp.exp(log_gamma[None, :] * (pos + 1.0)[:, None])[:, :, None]
    o_inter = jnp.einsum('bnthd,nbhdv->bnthv', q_dec, prev)
    return (o_intra + o_inter).reshape(B, S, H, dv)


def retention_mixer(q, k, v, g, decay_logit, norm_g):
    log_gamma = jax.nn.log_sigmoid(decay_logit.astype(jnp.float32))
    k = k * (RET_DK ** -0.5)
    o = retention_chunkwise(q, k, v, log_gamma[0]) + flip_seq(
        retention_chunkwise(flip_seq(q), flip_seq(k), flip_seq(v), log_gamma[1]))
    return group_norm_heads(o, norm_g) * jax.nn.silu(g.astype(jnp.float32))


def token_mixing(h, w_in, w_out, attn_sink, conv_w, lb, hgrn_norm_g, ret_decay_logit, ret_norm_g):
    B, S, _ = h.shape
    proj = h @ w_in
    (a_q, a_k, a_v, c_b, c_c, c_h, g_q, g_zf, g_zb, g_i, g_o,
     r_q, r_k, r_v, r_g) = jnp.split(proj, SPLIT_POINTS, axis=-1)

    def heads(t, n):
        return t.reshape(B, S, n, -1)

    y_attn = windowed_gqa_attention(heads(a_q, N_ATTN_HEADS), heads(a_k, N_KV_HEADS),
                                    heads(a_v, N_KV_HEADS), attn_sink)
    y_conv = short_conv_mixer(c_b, c_c, c_h, conv_w)
    y_hgrn = hgrn2_mixer(heads(g_q, HGRN_HEADS), heads(g_zf, HGRN_HEADS), heads(g_zb, HGRN_HEADS),
                         heads(g_i, HGRN_HEADS), g_o, lb, hgrn_norm_g)
    y_ret = retention_mixer(heads(r_q, RET_HEADS), heads(r_k, RET_HEADS), heads(r_v, RET_HEADS),
                            r_g, ret_decay_logit, ret_norm_g)
    y = jnp.concatenate([y_attn.astype(h.dtype), y_conv.astype(h.dtype),
                         y_hgrn.astype(h.dtype), y_ret.astype(h.dtype)], axis=-1)
    return y @ w_out


def grouped_moe(h, router_w, router_b, w_gate, w_up, w_down):
    B, S, D = h.shape
    t = h.reshape(-1, D)
    logits = (t @ router_w).astype(jnp.float32) + router_b.astype(jnp.float32)
    probs = jax.nn.softmax(logits, axis=-1)
    grouped = probs.reshape(-1, N_GROUPS, EXPERTS_PER_GROUP)
    group_score = lax.top_k(grouped, TOP_K)[0].sum(-1)
    g_sel = jnp.argmax(group_score, axis=-1)
    in_group = jnp.take_along_axis(grouped, g_sel[:, None, None], axis=1)[:, 0]
    top_p, top_i = lax.top_k(in_group, TOP_K)
    weights = top_p / top_p.sum(-1, keepdims=True)
    expert_ids = g_sel[:, None] * EXPERTS_PER_GROUP + top_i
    combine = (jax.nn.one_hot(expert_ids, N_EXPERTS, dtype=jnp.float32)
               * weights[..., None]).sum(1).astype(t.dtype)
    out = jnp.zeros_like(t)
    for e in range(N_EXPERTS):
        hid = jax.nn.silu(t @ w_gate[e]) * (t @ w_up[e])
        out = out + combine[:, e:e + 1] * (hid @ w_down[e])
    return out.reshape(B, S, D)


def setup_inputs(seed: int = 0) -> dict:
    key = jax.random.key(seed)
    ks = jax.random.split(key, 21)
    f32 = jnp.float32

    def nrm(k, shape, scale):
        return jax.random.normal(k, shape, f32) * scale

    gamma0 = 1.0 - 2.0 ** (-5.0 - np.arange(RET_HEADS, dtype=np.float32))
    ret_logit0 = jnp.asarray(np.log(gamma0) - np.log1p(-gamma0), dtype=f32)
    return {
        "x": nrm(ks[0], (BATCH, SEQ, D_MODEL), 1.0),
        "emb_ln_g": 1.0 + nrm(ks[1], (D_MODEL,), 0.02),
        "emb_ln_b": nrm(ks[2], (D_MODEL,), 0.02),
        "w_in": nrm(ks[3], (DEPTH, D_MODEL, D_IN_PROJ), D_MODEL ** -0.5),
        "attn_sink": nrm(ks[4], (DEPTH, N_ATTN_HEADS), 0.5),
        "conv_w": nrm(ks[5], (DEPTH, CONV_WIDTH, W_CONV), CONV_WIDTH ** -0.5),
        "hgrn_lb": nrm(ks[6], (DEPTH, HGRN_HEADS * HGRN_DK), 1.0),
        "hgrn_norm_g": 1.0 + nrm(ks[7], (DEPTH, W_HGRN), 0.02),
        "ret_decay_logit": ret_logit0[None, None, :] + nrm(ks[8], (DEPTH, 2, RET_HEADS), 0.01),
        "ret_norm_g": 1.0 + nrm(ks[9], (DEPTH, W_RET), 0.02),
        "w_out": nrm(ks[10], (DEPTH, D_MIX, D_MODEL), D_MIX ** -0.5 * DEEPNORM_BETA),
        "ln1_g": 1.0 + nrm(ks[11], (DEPTH, D_MODEL), 0.02),
        "ln1_b": nrm(ks[12], (DEPTH, D_MODEL), 0.02),
        "router_w": nrm(ks[13], (D_MODEL, N_EXPERTS), D_MODEL ** -0.5),
        "router_b": nrm(ks[14], (N_EXPERTS,), 0.01),
        "w_gate": nrm(ks[15], (DEPTH, N_EXPERTS, D_MODEL, D_EXPERT), D_MODEL ** -0.5),
        "w_up": nrm(ks[16], (DEPTH, N_EXPERTS, D_MODEL, D_EXPERT), D_MODEL ** -0.5),
        "w_down": nrm(ks[17], (DEPTH, N_EXPERTS, D_EXPERT, D_MODEL), D_EXPERT ** -0.5 * DEEPNORM_BETA),
        "ln2_g": 1.0 + nrm(ks[18], (DEPTH, D_MODEL), 0.02),
        "ln2_b": nrm(ks[19], (DEPTH, D_MODEL), 0.02),
    }


def reference(x, emb_ln_g, emb_ln_b, w_in, attn_sink, conv_w, hgrn_lb, hgrn_norm_g,
              ret_decay_logit, ret_norm_g, w_out, ln1_g, ln1_b, router_w, router_b,
              w_gate, w_up, w_down, ln2_g, ln2_b):
    lb_all = jnp.cumsum(jax.nn.softmax(hgrn_lb.astype(jnp.float32), axis=0), axis=0)
    lb_all = lb_all - lb_all[0:1]
    h = layer_norm(x, emb_ln_g, emb_ln_b)
    for l in range(DEPTH):
        mix = token_mixing(h, w_in[l], w_out[l], attn_sink[l], conv_w[l], lb_all[l],
                           hgrn_norm_g[l], ret_decay_logit[l], ret_norm_g[l])
        h = layer_norm(DEEPNORM_ALPHA * h + mix, ln1_g[l], ln1_b[l])
        ffn = grouped_moe(h, router_w, router_b, w_gate[l], w_up[l], w_down[l])
        h = layer_norm(DEEPNORM_ALPHA * h + ffn, ln2_g[l], ln2_b[l])
    return h
```

```cpp
#include <hip/hip_runtime.h>
#ifndef PH_DUP
#define PH_DUP 0u
#endif
#include <cstdio>
#include <cstdint>

#ifndef MK_ONE_LAUNCH
#define MK_ONE_LAUNCH 1
#endif

#define LAS __attribute__((address_space(3)))
#define GAS __attribute__((address_space(1)))
typedef unsigned short bf16;
typedef short bf16x8 __attribute__((ext_vector_type(8)));
typedef short s16x4 __attribute__((ext_vector_type(4)));
typedef float f32x2 __attribute__((ext_vector_type(2)));
typedef float f32x4 __attribute__((ext_vector_type(4)));
typedef float f32x16 __attribute__((ext_vector_type(16)));
typedef unsigned u32x2 __attribute__((ext_vector_type(2)));
typedef unsigned u32x4 __attribute__((ext_vector_type(4)));
#define DI __device__ __forceinline__

constexpr int T_TOK = 32768, DM = 2048, SEQ = 4096, NBATCH = 8, NPROJ = 6912, NEXP = 16, DEXP = 1024, DEPTH = 2;
constexpr int SLOT_CAP = 69632;
constexpr float LN_EPS = 1e-5f, HN_EPS = 1e-6f, ALPHA = 1.41421356237f;
constexpr int C_AQ = 0, C_AK = 512, C_AV = 640, C_CB = 768, C_CC = 1280, C_CH = 1792, C_GQ = 2304, C_GZF = 2816, C_GZB = 3328, C_GI = 3840, C_GO = 4352,
              C_RQ = 4864, C_RK = 5376, C_RV = 5888, C_RG = 6400;

constexpr size_t MiB = 1u << 20, KiB = 1u << 10;
constexpr size_t WS_CTL = 0, CTL_ZERO_BYTES = 1 * MiB;
constexpr size_t WS_EID = 1 * MiB, WS_EW = WS_EID + 256 * KiB, WS_SOT = WS_EW + 256 * KiB, WS_TOS = WS_SOT + 256 * KiB, WS_CNT = WS_TOS + 272 * KiB, WS_TST = WS_CNT + 16 * KiB;
constexpr size_t WS_WDS = WS_TST + 3072;
constexpr size_t WS_GUS = WS_WDS + 128;
constexpr size_t WS_HS = 3 * MiB, WS_YSC = WS_HS + 128 * KiB;
constexpr size_t WS_WIN = 8 * MiB, WS_WOUT = 22 * MiB, WS_WGU = 26 * MiB, WS_WD = 90 * MiB;
constexpr size_t WS_H8 = 154 * MiB;
constexpr size_t WS_H = 235 * MiB, WS_PROJ = 363 * MiB, WS_OB1 = 795 * MiB, WS_Y8 = 923 * MiB, WS_W1 = 987 * MiB, WS_END = 1101 * MiB;
constexpr size_t WS_MIX = WS_PROJ, WS_MSC = WS_PROJ + 64 * MiB, WS_HID = WS_PROJ, WS_YS = WS_PROJ + 136 * MiB, WS_YSS = WS_YS + 136 * MiB;
constexpr size_t WS_WSET = WS_W1 - WS_WIN;
static_assert(WS_Y8 + (size_t)T_TOK * DM <= WS_W1 && WS_WD + WS_WSET + (size_t)NEXP * DM * DEXP <= WS_END, "ws map");
static_assert(WS_TST + 4096 <= WS_HS && WS_YSC + 128 * KiB <= WS_WIN, "ws map");
static_assert(WS_WIN + (size_t)NPROJ * DM <= WS_WOUT && WS_WOUT + (size_t)DM * DM <= WS_WGU && WS_WGU + (size_t)NEXP * 2048 * DM <= WS_WD && WS_WD + (size_t)NEXP * DM * DEXP * 2 <= WS_H8 && WS_H8 + (size_t)T_TOK * DM <= WS_H, "ws map");
static_assert(WS_H + (size_t)T_TOK * DM * 2 <= WS_PROJ && WS_PROJ + (size_t)T_TOK * NPROJ * 2 <= WS_OB1 && WS_YSS + (size_t)SLOT_CAP * 8 * 4 <= WS_OB1 && WS_YS + (size_t)SLOT_CAP * DM <= WS_YSS && WS_MSC + (size_t)T_TOK * 8 * 4 <= WS_YS && WS_HID + (size_t)SLOT_CAP * DEXP * 2 <= WS_YS, "ws map");
constexpr size_t CTL_ABS = 64 * KiB; constexpr int ABS_IN = 0, ABS_OUT = NPROJ, ABS_GU = NPROJ + DM, ABS_PER_LAYER = NPROJ + DM + NEXP * 2048;
static_assert(CTL_ABS + (size_t)2 * ABS_PER_LAYER * 4 <= CTL_ZERO_BYTES, "ctl map");
constexpr size_t DO_Y = 0, DO_OB = 128 * MiB;
constexpr int CW_BAR = 4096;

constexpr int RING_BYTES = 131072, LDSCTL_OFF = 147456, MISC_OFF = LDSCTL_OFF + 320, LDS_BYTES = 148480;

typedef __bf16 bf16x2_t __attribute__((ext_vector_type(2)));
DI unsigned cvt_pk_bf16(float lo, float hi) { const f32x2 v = {lo, hi}; const bf16x2_t b = __builtin_convertvector(v, bf16x2_t); return __builtin_bit_cast(unsigned, b); }
DI float bf_lo(unsigned w) { return __uint_as_float(w << 16); }
DI float bf_hi(unsigned w) { return __uint_as_float(w & 0xffff0000u); }
DI float bf2f(bf16 b) { return __uint_as_float(((unsigned)b) << 16); }
DI bf16 f2bf(float f) { return (bf16)(cvt_pk_bf16(f, 0.f) & 0xffffu); }
DI int lane_fresh() { unsigned z = 0u; asm volatile("" : "+s"(z)); int ln = (int)__builtin_amdgcn_mbcnt_hi(~0u, __builtin_amdgcn_mbcnt_lo(~0u, z)); return ln; }
DI float shfl_idx(float v, int src_lane) { return __builtin_bit_cast(float, __builtin_amdgcn_ds_bpermute(src_lane << 2, __builtin_bit_cast(int, v))); }
template <int M> DI float sx(float v) { static_assert(M >= 1 && M < 32, "swizzle mask"); return __builtin_bit_cast(float, __builtin_amdgcn_ds_swizzle(__builtin_bit_cast(int, v), (M << 10) | 0x1f)); }
DI float sum32(float v) { return v + __builtin_bit_cast(float, __builtin_amdgcn_ds_bpermute((lane_fresh() ^ 32) << 2, __builtin_bit_cast(int, v))); }
DI float max32(float v) { return fmaxf(v, __builtin_bit_cast(float, __builtin_amdgcn_ds_bpermute((lane_fresh() ^ 32) << 2, __builtin_bit_cast(int, v)))); }
DI float sx32(float v, int lane) { return __builtin_bit_cast(float, __builtin_amdgcn_ds_bpermute((lane ^ 32) << 2, __builtin_bit_cast(int, v))); }
DI float wave_sum(float v) { v += sx<1>(v); v += sx<2>(v); v += sx<4>(v); v += sx<8>(v); v += sx<16>(v); return sum32(v); }
DI float wave_max(float v) { v = fmaxf(v, sx<1>(v)); v = fmaxf(v, sx<2>(v)); v = fmaxf(v, sx<4>(v)); v = fmaxf(v, sx<8>(v)); v = fmaxf(v, sx<16>(v)); return max32(v); }
DI float sigmoidf_(float z) { return __builtin_amdgcn_rcpf(1.0f + __expf(-z)); }
DI float siluf_(float z) { return z * __builtin_amdgcn_rcpf(1.0f + __expf(-z)); }
DI void unpack8(const u32x4 w, float (&f)[8]) { f[0] = bf_lo(w.x); f[1] = bf_hi(w.x); f[2] = bf_lo(w.y); f[3] = bf_hi(w.y); f[4] = bf_lo(w.z); f[5] = bf_hi(w.z); f[6] = bf_lo(w.w); f[7] = bf_hi(w.w); }
DI void unpack_i8(const u32x2 w, float sc, float (&f)[8]) {
#pragma unroll
    for (int k = 0; k < 4; ++k) { f[k] = (float)((int)(w.x << (24 - 8 * k)) >> 24) * sc; f[4 + k] = (float)((int)(w.y << (24 - 8 * k)) >> 24) * sc; }
}
DI u32x4 pack8(const float (&f)[8]) { u32x4 w; w.x = cvt_pk_bf16(f[0], f[1]); w.y = cvt_pk_bf16(f[2], f[3]); w.z = cvt_pk_bf16(f[4], f[5]); w.w = cvt_pk_bf16(f[6], f[7]); return w; }
DI int crow(int i, int h) { return (i & 3) + 8 * (i >> 2) + 4 * h; }
#define LDS_WAIT() asm volatile("s_waitcnt lgkmcnt(0)" ::: "memory")
#define VM_WAIT() asm volatile("s_waitcnt vmcnt(0)" ::: "memory")
#define MFMA32(a, b, c) __builtin_amdgcn_mfma_f32_32x32x16_bf16((a), (b), (c), 0, 0, 0)

namespace pg8 {
typedef unsigned short bf16_t;
constexpr int BM = 256, BK = 64, HALF = 128, HTB = HALF * BK * 2, STAGE_BYTES = 8 * HTB, NXCD = 8, WGM = 8;
__host__ __device__ __forceinline__ int lds_byte(int r, int c) { const int st = (r >> 4) * 2 + (c >> 5), rr = r & 15, cc = c & 31, ob = rr * 64 + cc * 2; return st * 1024 + (ob ^ (((ob >> 9) & 1) << 5)); }
__host__ __device__ __forceinline__ void stage_rc(int b, int& R, int& C) { const int st = b / 1024, sb = b % 1024, swz = sb ^ (((sb >> 9) & 1) << 5); R = (st >> 1) * 16 + swz / 64; C = (st & 1) * 32 + (swz % 64) / 2; }
__host__ __device__ __forceinline__ int perm32(int rho) { const int n = rho >> 4, i = rho & 15; return 8 * (i >> 2) + 4 * n + (i & 3); }

struct Unit { int pm, pn; };
struct Gemm { const bf16_t* A; const bf16_t* Bt; int K; };

struct StaticOrder {
    int nM, nN, nwg, G, c;
    DI void init(int nM_, int nN_, int G_, int c_) { nM = nM_; nN = nN_; nwg = nM * nN; G = G_; c = c_; }
    DI bool next(int i, Unit& u) const {
        const long L = (long)i * G + c; if (L >= nwg) return false;
        int wgid = (int)L; { const int q = nwg / NXCD, r = nwg % NXCD, xcd = wgid % NXCD, off = wgid / NXCD; wgid = (xcd < r ? xcd * (q + 1) : r * (q + 1) + (xcd - r) * q) + off; }
        const int nig = WGM * nN, gid = wgid / nig, fm = gid * WGM, gsz = (nM - fm) < WGM ? (nM - fm) : WGM;
        u.pm = fm + ((wgid % nig) % gsz); u.pn = (wgid % nig) / gsz; return true;
    }
    DI size_t b_off(const Unit& u, size_t tstep) const { return (size_t)u.pn * tstep; }
};
struct MoeOrder : StaticOrder {
    const int* tile_start; size_t expert_stride;
    DI bool next(int i, Unit& u) const { Unit t; const bool ok = StaticOrder::next(i, t); u.pm = __builtin_amdgcn_readfirstlane(t.pm); u.pn = __builtin_amdgcn_readfirstlane(t.pn); return ok; }
    DI size_t b_off(const Unit& u, size_t tstep) const {
        int e = 0;
#pragma unroll
        for (int j = 1; j < 16; ++j) e += (u.pm >= tile_start[j]) ? 1 : 0;
        e = __builtin_amdgcn_readfirstlane(e);
        return (size_t)e * expert_stride + (size_t)u.pn * tstep;
    }
};

typedef int i32x4 __attribute__((ext_vector_type(4)));
DI unsigned q8f(float x) { return (unsigned)(int)__builtin_rintf(x) & 0xffu; }
struct EpiBf16Q {
    static constexpr bool PERM = true, I8 = true, F8 = false;
    bf16_t* O; int ldc; const float* sa; const float* sb;
    DI void operator()(const f32x4 (&acc)[2][2][4][2], const Unit& u, int wr, int wc, int fr, int fq) const {
        const int row0 = u.pm * BM + wr * 64 + fr; const int col0 = u.pn * BM + wc * 32 + 8 * fq;
        f32x4 bv[2][2];
#pragma unroll
        for (int bj = 0; bj < 2; ++bj)
#pragma unroll
            for (int n = 0; n < 2; ++n) bv[bj][n] = *(const f32x4*)(sb + col0 + bj * HALF + 4 * n) * (1.0f / 127.0f);
#pragma unroll
        for (int ai = 0; ai < 2; ++ai)
#pragma unroll
            for (int m = 0; m < 4; ++m) { const int row = row0 + ai * HALF + m * 16; const float ra = sa[row]; bf16_t* rowp = O + (size_t)row * ldc + col0;
#pragma unroll
                for (int bj = 0; bj < 2; ++bj) { const f32x4 v0 = __builtin_convertvector(__builtin_bit_cast(i32x4, acc[ai][bj][m][0]), f32x4) * (bv[bj][0] * ra), v1 = __builtin_convertvector(__builtin_bit_cast(i32x4, acc[ai][bj][m][1]), f32x4) * (bv[bj][1] * ra);
                    u32x4 w; w.x = cvt_pk_bf16(v0[0], v0[1]); w.y = cvt_pk_bf16(v0[2], v0[3]); w.z = cvt_pk_bf16(v1[0], v1[1]); w.w = cvt_pk_bf16(v1[2], v1[3]);
                    *(u32x4*)(rowp + bj * HALF) = w; } }
    }
};
typedef int i32x8 __attribute__((ext_vector_type(8)));
constexpr float ACT_SCALE = 16.0f;
constexpr float HID_SCALE = 8.0f;
DI unsigned pk_fp8x4(float a, float b, float c, float d) {
    a = __builtin_amdgcn_fmed3f(a, -448.f, 448.f); b = __builtin_amdgcn_fmed3f(b, -448.f, 448.f); c = __builtin_amdgcn_fmed3f(c, -448.f, 448.f); d = __builtin_amdgcn_fmed3f(d, -448.f, 448.f);
    int w = __builtin_amdgcn_cvt_pk_fp8_f32(a, b, 0, false); w = __builtin_amdgcn_cvt_pk_fp8_f32(c, d, w, true); return (unsigned)w; }
struct EpiSwiGLUF8 {
    static constexpr bool PERM = true, I8 = false, F8 = true;
    unsigned char* O; int ldc; const float* gus; const int* tile_start;
    DI void operator()(const f32x4 (&acc)[2][2][4][2], const Unit& u, int wr, int wc, int fr, int fq) const {
        int e = 0;
#pragma unroll
        for (int j = 1; j < 16; ++j) e += (u.pm >= tile_start[j]) ? 1 : 0;
        const float mg = gus[2 * e], mu = gus[2 * e + 1] * HID_SCALE;
        const int row0 = u.pm * BM + wr * 64 + fr; const int col0 = u.pn * HALF + wc * 32 + 8 * fq;
#pragma unroll
        for (int ai = 0; ai < 2; ++ai)
#pragma unroll
            for (int m = 0; m < 4; ++m) { unsigned char* rowp = O + (size_t)(row0 + ai * HALF + m * 16) * ldc + col0;
                float o[8];
#pragma unroll
                for (int n = 0; n < 2; ++n)
#pragma unroll
                    for (int j = 0; j < 4; ++j) { const float g = acc[ai][0][m][n][j] * mg; o[n * 4 + j] = g * __builtin_amdgcn_rcpf(1.0f + __expf(-g)) * (acc[ai][1][m][n][j] * mu); }
                u32x2 w; w.x = pk_fp8x4(o[0], o[1], o[2], o[3]); w.y = pk_fp8x4(o[4], o[5], o[6], o[7]);
                *(u32x2*)rowp = w; }
    }
};
struct EpiSwiGLUQ {
    static constexpr bool PERM = true, I8 = true, F8 = false;
    unsigned char* O; int ldc; const float* sa; const float* sb; const int* rowmap; const int* tile_start;
    DI void operator()(const f32x4 (&acc)[2][2][4][2], const Unit& u, int wr, int wc, int fr, int fq) const {
        int e = 0;
#pragma unroll
        for (int j = 1; j < 16; ++j) e += (u.pm >= tile_start[j]) ? 1 : 0;
        const int row0 = u.pm * BM + wr * 64 + fr; const int col0 = u.pn * HALF + wc * 32 + 8 * fq, bcol0 = e * 2048 + u.pn * BM + wc * 32 + 8 * fq;
        f32x4 bv[2][2];
#pragma unroll
        for (int bj = 0; bj < 2; ++bj)
#pragma unroll
            for (int n = 0; n < 2; ++n) bv[bj][n] = *(const f32x4*)(sb + bcol0 + bj * HALF + 4 * n) * (1.0f / 127.0f);
#pragma unroll
        for (int ai = 0; ai < 2; ++ai)
#pragma unroll
            for (int m = 0; m < 4; ++m) { const int row = row0 + ai * HALF + m * 16; const float ra = sa[rowmap[row]]; unsigned char* rowp = O + (size_t)row * ldc + col0;
                float o[8];
#pragma unroll
                for (int n = 0; n < 2; ++n) { const f32x4 gv = __builtin_convertvector(__builtin_bit_cast(i32x4, acc[ai][0][m][n]), f32x4) * (bv[0][n] * ra), uv = __builtin_convertvector(__builtin_bit_cast(i32x4, acc[ai][1][m][n]), f32x4) * (bv[1][n] * ra);
#pragma unroll
                    for (int j = 0; j < 4; ++j) { const float g = gv[j]; o[n * 4 + j] = g * __builtin_amdgcn_rcpf(1.0f + __expf(-g)) * (uv[j] * HID_SCALE); } }
                u32x2 w; w.x = pk_fp8x4(o[0], o[1], o[2], o[3]); w.y = pk_fp8x4(o[4], o[5], o[6], o[7]);
                *(u32x2*)rowp = w; }
    }
};
template <bool QIN, bool F8IN = false> struct EpiI8Tile {
    static constexpr bool PERM = true, I8 = QIN, F8 = F8IN;
    unsigned char* O8; int ldc; float* SC; int ntile; const float* sa; const float* sb; LAS float* xch; const float* wds; const int* tile_start;
    DI void operator()(const f32x4 (&acc)[2][2][4][2], const Unit& u, int wr, int wc, int fr, int fq) const {
        const int row0 = u.pm * BM + wr * 64 + fr; const int col0 = u.pn * BM + wc * 32 + 8 * fq;
        float mul = 1.0f / 127.0f;
        if constexpr (F8IN) { int e = 0;
#pragma unroll
            for (int j = 1; j < 16; ++j) e += (u.pm >= tile_start[j]) ? 1 : 0;
            mul *= wds[e]; }
        f32x4 bv[2][2];
        if constexpr (QIN) {
#pragma unroll
            for (int bj = 0; bj < 2; ++bj)
#pragma unroll
                for (int n = 0; n < 2; ++n) bv[bj][n] = *(const f32x4*)(sb + col0 + bj * HALF + 4 * n) * (1.0f / 127.0f); }
        f32x4 v[2][4][2][2]; float lmax[2][4];
#pragma unroll
        for (int ai = 0; ai < 2; ++ai)
#pragma unroll
            for (int m = 0; m < 4; ++m) { float ra = 1.f; if constexpr (QIN) ra = sa[row0 + ai * HALF + m * 16]; float mx = 0.f;
#pragma unroll
                for (int bj = 0; bj < 2; ++bj)
#pragma unroll
                    for (int n = 0; n < 2; ++n) { f32x4 x; if constexpr (QIN) x = __builtin_convertvector(__builtin_bit_cast(i32x4, acc[ai][bj][m][n]), f32x4) * (bv[bj][n] * ra); else x = acc[ai][bj][m][n];
                        v[ai][m][bj][n] = x; mx = fmaxf(mx, fmaxf(fmaxf(fabsf(x[0]), fabsf(x[1])), fmaxf(fabsf(x[2]), fabsf(x[3])))); }
                mx = fmaxf(mx, sx<16>(mx)); mx = max32(mx);
                lmax[ai][m] = mx;
                if (fq == 0) xch[(ai * HALF + wr * 64 + m * 16 + fr) * 4 + wc] = mx; }
        asm volatile("s_waitcnt lgkmcnt(0)\n\ts_barrier" ::: "memory");
#pragma unroll
        for (int ai = 0; ai < 2; ++ai)
#pragma unroll
            for (int m = 0; m < 4; ++m) { const int rl = ai * HALF + wr * 64 + m * 16 + fr; const f32x4 q4 = *(const LAS f32x4*)(xch + rl * 4);
                const float rmax = fmaxf(fmaxf(q4[0], q4[1]), fmaxf(q4[2], q4[3])); const float inv = rmax > 0.f ? 127.0f * __builtin_amdgcn_rcpf(rmax) : 0.f;
                const int row = row0 + ai * HALF + m * 16;
                if (wc == 0 && fq == 0) SC[(size_t)row * ntile + u.pn] = rmax * mul;
                unsigned char* rowp = O8 + (size_t)row * ldc + col0;
#pragma unroll
                for (int bj = 0; bj < 2; ++bj) { const f32x4 x0 = v[ai][m][bj][0] * inv, x1 = v[ai][m][bj][1] * inv;
                    u32x2 w2; w2.x = q8f(x0[0]) | (q8f(x0[1]) << 8) | (q8f(x0[2]) << 16) | (q8f(x0[3]) << 24); w2.y = q8f(x1[0]) | (q8f(x1[1]) << 8) | (q8f(x1[2]) << 16) | (q8f(x1[3]) << 24);
                    *(u32x2*)(rowp + bj * HALF) = w2; } }
    }
};
constexpr float YS_SCALE = 64.0f;
struct EpiF8Out {
    static constexpr bool PERM = true, I8 = false, F8 = true;
    unsigned char* O8; int ldc; const float* wds; const int* tile_start;
    DI void operator()(const f32x4 (&acc)[2][2][4][2], const Unit& u, int wr, int wc, int fr, int fq) const {
        int e = 0;
#pragma unroll
        for (int j = 1; j < 16; ++j) e += (u.pm >= tile_start[j]) ? 1 : 0;
        const float mul = wds[e] * YS_SCALE;
        const int row0 = u.pm * BM + wr * 64 + fr; const int col0 = u.pn * BM + wc * 32 + 8 * fq;
#pragma unroll
        for (int ai = 0; ai < 2; ++ai)
#pragma unroll
            for (int m = 0; m < 4; ++m) { unsigned char* rowp = O8 + (size_t)(row0 + ai * HALF + m * 16) * ldc + col0;
#pragma unroll
                for (int bj = 0; bj < 2; ++bj) { const f32x4 x0 = acc[ai][bj][m][0] * mul, x1 = acc[ai][bj][m][1] * mul;
                    u32x2 w2; w2.x = pk_fp8x4(x0[0], x0[1], x0[2], x0[3]); w2.y = pk_fp8x4(x1[0], x1[1], x1[2], x1[3]);
                    *(u32x2*)(rowp + bj * HALF) = w2; } }
    }
};
struct EpiBf16 {
    static constexpr bool PERM = true, I8 = false, F8 = false;
    bf16_t* O; int ldc;
    DI void operator()(const f32x4 (&acc)[2][2][4][2], const Unit& u, int wr, int wc, int fr, int fq) const {
        const int row0 = u.pm * BM + wr * 64 + fr; const int col0 = u.pn * BM + wc * 32 + 8 * fq;
#pragma unroll
        for (int ai = 0; ai < 2; ++ai)
#pragma unroll
            for (int m = 0; m < 4; ++m) { bf16_t* rowp = O + (size_t)(row0 + ai * HALF + m * 16) * ldc + col0;
#pragma unroll
                for (int bj = 0; bj < 2; ++bj) { const f32x4 v0 = acc[ai][bj][m][0], v1 = acc[ai][bj][m][1];
                    u32x4 w; w.x = cvt_pk_bf16(v0[0], v0[1]); w.y = cvt_pk_bf16(v0[2], v0[3]); w.z = cvt_pk_bf16(v1[0], v1[1]); w.w = cvt_pk_bf16(v1[2], v1[3]);
                    *(u32x4*)(rowp + bj * HALF) = w; } }
    }
};
struct EpiSwiGLU {
    static constexpr bool PERM = true, I8 = false, F8 = false;
    bf16_t* O; int ldc;
    DI void operator()(const f32x4 (&acc)[2][2][4][2], const Unit& u, int wr, int wc, int fr, int fq) const {
        const int row0 = u.pm * BM + wr * 64 + fr; const int col0 = u.pn * HALF + wc * 32 + 8 * fq;
#pragma unroll
        for (int ai = 0; ai < 2; ++ai)
#pragma unroll
            for (int m = 0; m < 4; ++m) { bf16_t* rowp = O + (size_t)(row0 + ai * HALF + m * 16) * ldc + col0;
                float o[8];
#pragma unroll
                for (int n = 0; n < 2; ++n)
#pragma unroll
                    for (int j = 0; j < 4; ++j) { const float g = acc[ai][0][m][n][j], up = acc[ai][1][m][n][j]; o[n * 4 + j] = g * __builtin_amdgcn_rcpf(1.0f + __expf(-g)) * up; }
                u32x4 w; w.x = cvt_pk_bf16(o[0], o[1]); w.y = cvt_pk_bf16(o[2], o[3]); w.z = cvt_pk_bf16(o[4], o[5]); w.w = cvt_pk_bf16(o[6], o[7]);
                *(u32x4*)rowp = w; }
    }
};

template <class Epi, class Sched, bool GATHER>
DI void gemm_phase(LAS unsigned char* lds, const int tid, const Gemm g, const Sched& S, const Epi& E, const int* rowmap) {
    const int wid = __builtin_amdgcn_readfirstlane(tid >> 6), lane = tid & 63, wr = wid >> 2, wc = wid & 3, fr = lane & 15, fq = lane >> 4;
    const int K = g.K, nt = K / BK;
    unsigned voffA[2], voffB[2];
#pragma unroll
    for (int i = 0; i < 2; ++i) { int R, C; stage_rc(tid * 16 + i * 8192, R, C); const int Rb = Epi::PERM ? ((R & ~31) + perm32(R & 31)) : R;
        voffA[i] = (unsigned)(R * K + C) * 2u; voffB[i] = (unsigned)(Rb * K + C) * 2u; }
    const size_t kstep = (size_t)(BK * 2);
    const size_t hstep = (size_t)HALF * K * 2;
    const size_t tstep = 2 * hstep;
    const unsigned ldsw = (unsigned)wid * 1024u;
    const int aoff = lds_byte(wr * 64 + fr, fq * 8), boff = lds_byte(wc * 32 + fr, fq * 8);
#define PG8_SA(b, h) (((b) * 2 + (h)) * HTB)
#define PG8_SB(b, h) ((4 + (b) * 2 + (h)) * HTB)
#define PG8_STAGE(bufoff, gbase, voff) do { _Pragma("unroll") for (int _i = 0; _i < 2; ++_i) { unsigned vo_ = (voff)[_i]; asm volatile("" : "+v"(vo_)); \
        __builtin_amdgcn_global_load_lds((const unsigned*)((const char*)(gbase) + vo_), (LAS unsigned*)(lds + (bufoff) + ldsw + _i * 8192), 16, 0, 0); } } while (0)
#define PG8_LDA(dst, b, h) do { _Pragma("unroll") for (int m = 0; m < 4; ++m) { if constexpr (Epi::F8) { const i32x4 lo_ = *(const LAS i32x4*)(lds + PG8_SA(b, h) + aoff + m * 2048), hi_ = *(const LAS i32x4*)(lds + PG8_SA(b, h) + aoff + m * 2048 + 1024); \
            dst##8[m] = __builtin_shufflevector(lo_, hi_, 0, 1, 2, 3, 4, 5, 6, 7); } else { _Pragma("unroll") for (int k = 0; k < 2; ++k) dst[m][k] = *(const LAS bf16x8*)(lds + PG8_SA(b, h) + aoff + m * 2048 + k * 1024); } } } while (0)
#define PG8_LDB(dst, b, h) do { _Pragma("unroll") for (int n = 0; n < 2; ++n) { if constexpr (Epi::F8) { const i32x4 lo_ = *(const LAS i32x4*)(lds + PG8_SB(b, h) + boff + n * 2048), hi_ = *(const LAS i32x4*)(lds + PG8_SB(b, h) + boff + n * 2048 + 1024); \
            dst##8[n] = __builtin_shufflevector(lo_, hi_, 0, 1, 2, 3, 4, 5, 6, 7); } else { _Pragma("unroll") for (int k = 0; k < 2; ++k) dst[n][k] = *(const LAS bf16x8*)(lds + PG8_SB(b, h) + boff + n * 2048 + k * 1024); } } } while (0)
#define PG8_MMA(ai, bj, At, Bt) do { __builtin_amdgcn_s_setprio(1); _Pragma("unroll") for (int m = 0; m < 4; ++m) _Pragma("unroll") for (int n = 0; n < 2; ++n) _Pragma("unroll") for (int k = 0; k < 2; ++k) { \
        if constexpr (Epi::F8) { if (k == 0) acc[ai][bj][m][n] = __builtin_amdgcn_mfma_scale_f32_16x16x128_f8f6f4(Bt##8[n], At##8[m], acc[ai][bj][m][n], 0, 0, 0, 0, 0, 0); } \
        else if constexpr (Epi::I8) acc[ai][bj][m][n] = __builtin_bit_cast(f32x4, __builtin_amdgcn_mfma_i32_16x16x64_i8(__builtin_bit_cast(i32x4, Bt[n][k]), __builtin_bit_cast(i32x4, At[m][k]), __builtin_bit_cast(i32x4, acc[ai][bj][m][n]), 0, 0, 0)); \
        else acc[ai][bj][m][n] = __builtin_amdgcn_mfma_f32_16x16x32_bf16(Bt[n][k], At[m][k], acc[ai][bj][m][n], 0, 0, 0); } __builtin_amdgcn_s_setprio(0); } while (0)
#define PG8_WAIT_V(n) asm volatile("s_waitcnt vmcnt(" #n ")" ::: "memory")
#define PG8_WAIT_L(n) asm volatile("s_waitcnt lgkmcnt(" #n ")" ::: "memory")
#define PG8_BAR __builtin_amdgcn_s_barrier()
#define PG8_SCHED __builtin_amdgcn_sched_barrier(0)
    Unit cur, nxt; int ui = 0;
    if (!S.next(0, cur)) return;
    f32x4 acc[2][2][4][2];
#pragma unroll
    for (int a = 0; a < 2; ++a)
#pragma unroll
        for (int b = 0; b < 2; ++b)
#pragma unroll
            for (int m = 0; m < 4; ++m)
#pragma unroll
                for (int n = 0; n < 2; ++n) acc[a][b][m][n] = (f32x4){0.f, 0.f, 0.f, 0.f};
    bf16x8 At[4][2], B0[2][2], B1[2][2];
    i32x8 At8[4], B08[2], B18[2];
    unsigned cvA[2][2];
    const char* cA = (const char*)g.A + (GATHER ? (size_t)0 : (size_t)cur.pm * tstep);
#define PG8_LOAD_ROWS(unit) do { _Pragma("unroll") for (int h = 0; h < 2; ++h) _Pragma("unroll") for (int i = 0; i < 2; ++i) { int R, C; stage_rc(tid * 16 + i * 8192, R, C); \
        cvA[h][i] = (unsigned)(rowmap[(unit).pm * BM + h * HALF + R] * K + C) * 2u; } } while (0)
    if constexpr (GATHER) { PG8_LOAD_ROWS(cur); }
    const char* cB = (const char*)g.Bt + S.b_off(cur, tstep);
#define PG8_STAGE_A(bufoff, base_direct, koff_gather, h, usenext) do { if constexpr (GATHER) { PG8_STAGE(bufoff, (const char*)g.A + (koff_gather), cvA[h]); } \
        else { PG8_STAGE(bufoff, (base_direct), voffA); } } while (0)
    PG8_STAGE(PG8_SB(0, 0), cB, voffB); PG8_STAGE(PG8_SB(0, 1), cB + hstep, voffB); PG8_STAGE_A(PG8_SA(0, 0), cA, 0, 0, false); PG8_STAGE_A(PG8_SA(0, 1), cA + hstep, 0, 1, false);
    if (wr == 1) PG8_BAR;
    PG8_WAIT_V(2); PG8_BAR;
    PG8_STAGE(PG8_SB(1, 0), cB + kstep, voffB); PG8_STAGE_A(PG8_SA(1, 0), cA + kstep, kstep, 0, false); PG8_STAGE(PG8_SB(1, 1), cB + hstep + kstep, voffB);
    PG8_WAIT_V(6); PG8_BAR;
    for (;;) {
        const bool has_next = S.next(ui + 1, nxt);
        const char* nA = has_next ? (const char*)g.A + (GATHER ? (size_t)0 : (size_t)nxt.pm * tstep) : cA; const char* nB = has_next ? (const char*)g.Bt + S.b_off(nxt, tstep) : cB;
        for (int t = 0; t < nt; t += 2) {
            const bool last = (t == nt - 2);
            const char* a1 = cA + (size_t)(t + 1) * kstep;
            const char* a2 = last ? nA : cA + (size_t)(t + 2) * kstep; const char* b2 = last ? nB : cB + (size_t)(t + 2) * kstep;
            const char* a3 = a2 + kstep; const char* b3 = b2 + kstep;
            const size_t k1 = (size_t)(t + 1) * kstep, k2 = last ? (size_t)0 : (size_t)(t + 2) * kstep, k3 = k2 + kstep;
            PG8_LDB(B0, 0, 0); PG8_LDB(B1, 0, 1); PG8_SCHED; PG8_LDA(At, 0, 0); PG8_STAGE_A(PG8_SA(1, 1), a1 + hstep, k1, 1, false);
            if constexpr (GATHER) { if (last && has_next) { PG8_LOAD_ROWS(nxt); } }
            PG8_WAIT_V(8); PG8_WAIT_L(0); PG8_BAR; PG8_MMA(0, 0, At, B0); PG8_MMA(0, 1, At, B1); PG8_BAR; PG8_SCHED;
            PG8_LDA(At, 0, 1); PG8_STAGE(PG8_SB(0, 0), b2, voffB); PG8_STAGE(PG8_SB(0, 1), b2 + hstep, voffB); PG8_STAGE_A(PG8_SA(0, 0), a2, k2, 0, last);
            PG8_WAIT_V(8); PG8_WAIT_L(0); PG8_BAR; PG8_MMA(1, 0, At, B0); PG8_MMA(1, 1, At, B1); PG8_BAR; PG8_SCHED;
            PG8_LDB(B0, 1, 0); PG8_LDB(B1, 1, 1); PG8_SCHED; PG8_LDA(At, 1, 0); PG8_STAGE_A(PG8_SA(0, 1), a2 + hstep, k2, 1, last);
            PG8_WAIT_V(8); PG8_WAIT_L(0); PG8_BAR; PG8_MMA(0, 0, At, B0); PG8_MMA(0, 1, At, B1); PG8_BAR; PG8_SCHED;
            PG8_LDA(At, 1, 1); PG8_STAGE(PG8_SB(1, 0), b3, voffB); PG8_STAGE(PG8_SB(1, 1), b3 + hstep, voffB); PG8_STAGE_A(PG8_SA(1, 0), a3, k3, 0, last);
            PG8_WAIT_V(8); PG8_WAIT_L(0); PG8_BAR; PG8_MMA(1, 0, At, B0); PG8_MMA(1, 1, At, B1); PG8_BAR; PG8_SCHED;
        }
        if (wr == 0) PG8_BAR;
        { const int ln_ = lane_fresh(); int fr_ = ln_ & 15, fq_ = ln_ >> 4; asm volatile("" : "+v"(fr_), "+v"(fq_));
          E(acc, cur, wr, wc, fr_, fq_); }
        if (!has_next) break;
#pragma unroll
        for (int a = 0; a < 2; ++a)
#pragma unroll
            for (int b = 0; b < 2; ++b)
#pragma unroll
                for (int m = 0; m < 4; ++m)
#pragma unroll
                    for (int n = 0; n < 2; ++n) acc[a][b][m][n] = (f32x4){0.f, 0.f, 0.f, 0.f};
        cur = nxt; cA = nA; cB = nB; ++ui;
        if (wr == 1) PG8_BAR;
    }
    PG8_WAIT_V(0);
    PG8_BAR;
#undef PG8_SA
#undef PG8_SB
#undef PG8_STAGE
#undef PG8_STAGE_A
#undef PG8_LOAD_ROWS
#undef PG8_LDA
#undef PG8_LDB
#undef PG8_MMA
#undef PG8_WAIT_V
#undef PG8_WAIT_L
#undef PG8_BAR
#undef PG8_SCHED
}
}

#define XB_TMO      128
#define XB_XCNT(j)  (256  + 64 * (j))
#define XB_XSUB(j)  (1280 + 64 * (j))
#define XB_XGEN(j)  (2304 + 64 * (j))
#define XB_TOP      3328
#define XB_TOPGEN   3392
#define XCD_BAR_WORDS 3456
#define XB_SPIN_CAP (1u << 18)
__device__ __forceinline__ unsigned xb_ld(unsigned* p)              { return __hip_atomic_load(p, __ATOMIC_RELAXED, __HIP_MEMORY_SCOPE_AGENT); }
__device__ __forceinline__ unsigned xb_add(unsigned* p, unsigned v) { return __hip_atomic_fetch_add(p, v, __ATOMIC_RELAXED, __HIP_MEMORY_SCOPE_AGENT); }
__device__ __forceinline__ unsigned xb_xcc_id() { return (unsigned)__builtin_amdgcn_s_getreg((3 << 11) | 20) & 0xFu; }
#define XB_SPIN(cond, bar) do { unsigned _sp = 0; while (cond) { __builtin_amdgcn_s_sleep(1); \
    if ((++_sp & 255u) == 0u) { if (xb_ld(&(bar)[XB_TMO])) break; if (_sp > XB_SPIN_CAP) { atomicAdd(&(bar)[XB_TMO], 1u); break; } } } } while (0)
struct XcdBarrier { unsigned* bar; unsigned x; volatile LAS unsigned* st; };
__device__ __forceinline__ XcdBarrier xcd_barrier_post(unsigned* bar, volatile LAS unsigned* st) {
    XcdBarrier b; b.bar = bar; b.x = xb_xcc_id(); b.st = st;
    if (threadIdx.x == 0) (void)xb_add(&bar[XB_XCNT(b.x)], 1u);
    return b;
}
__device__ __forceinline__ void xcd_barrier_complete(unsigned* bar, unsigned x, unsigned& nloc, unsigned& nx) {
    const unsigned G = gridDim.x * gridDim.y * gridDim.z;
    unsigned sum, cnt, mine, sp = 0u;
    for (;;) {
        sum = 0u; cnt = 0u; mine = 0u;
#pragma unroll
        for (unsigned j = 0; j < 16; ++j) { const unsigned c = xb_ld(&bar[XB_XCNT(j)]); sum += c; cnt += (c > 0u) ? 1u : 0u; mine = (j == x) ? c : mine; }
        if (sum == G) break;
        __builtin_amdgcn_s_sleep(1);
        if ((++sp & 255u) == 0u) { if (xb_ld(&bar[XB_TMO])) break; if (sp > XB_SPIN_CAP) { atomicAdd(&bar[XB_TMO], 1u); break; } }
    }
    nloc = mine > 0u ? mine : 1u; nx = cnt > 0u ? cnt : 1u;
}
__device__ __forceinline__ void xcd_barrier(const XcdBarrier& b) {
    asm volatile("s_waitcnt vmcnt(0)" ::: "memory");
    __syncthreads();
    if (threadIdx.x == 0) {
        unsigned* bar = b.bar;
        __builtin_amdgcn_s_waitcnt(0);
        unsigned nloc = b.st[0], nx = b.st[1];
        if (nloc == 0u) { xcd_barrier_complete(bar, b.x, nloc, nx); b.st[0] = nloc; b.st[1] = nx; }
        const unsigned old = xb_add(&bar[XB_XSUB(b.x)], 1u);
        const unsigned gen = old / nloc;
        if (old + 1u == (gen + 1u) * nloc) {
            __builtin_amdgcn_fence(__ATOMIC_RELEASE, "agent");
            asm volatile("s_waitcnt vmcnt(0)" ::: "memory");
            const unsigned og = xb_add(&bar[XB_TOP], 1u);
            const unsigned tg = og / nx;
            if (og + 1u == (tg + 1u) * nx) xb_add(&bar[XB_TOPGEN], 1u);
            else XB_SPIN(xb_ld(&bar[XB_TOPGEN]) == tg, bar);
            __builtin_amdgcn_fence(__ATOMIC_ACQUIRE, "agent");
            xb_add(&bar[XB_XGEN(b.x)], 1u);
            asm volatile("s_waitcnt vmcnt(0)" ::: "memory");
        } else {
            XB_SPIN(xb_ld(&bar[XB_XGEN(b.x)]) == gen, bar);
            __builtin_amdgcn_fence(__ATOMIC_ACQUIRE, "agent");
            asm volatile("s_waitcnt vmcnt(0)" ::: "memory");
        }
    }
    __syncthreads();
}

struct Args { const float* in[20]; float* out; unsigned char* ws; int ph_lo, ph_hi; };
typedef __attribute__((address_space(4))) const unsigned char* kptr_t;
struct Frame {
    LAS unsigned char* lds;
    int tid, lane, wave, vcu, G, bx;
    int wave0;
    kptr_t ka;
};
DI void frame_refresh(Frame& F) {
    int wv = F.wave0; asm volatile("" : "+s"(wv)); int ln = lane_fresh(); asm volatile("" : "+v"(ln));
    F.lane = ln; F.wave = wv; F.tid = wv * 64 + ln;
    int g = gridDim.x; asm volatile("" : "+s"(g)); F.G = g; int bx = blockIdx.x; asm volatile("" : "+s"(bx)); F.bx = bx;
    F.vcu = (g % 8 == 0) ? (bx % 8) * (g / 8) + bx / 8 : bx;
    kptr_t p = (kptr_t)__builtin_amdgcn_kernarg_segment_ptr(); asm volatile("" : "+s"(p)); F.ka = p;
}
DI kptr_t karg_fresh() { kptr_t p = (kptr_t)__builtin_amdgcn_kernarg_segment_ptr(); asm volatile("" : "+s"(p)); return p; }
DI const float* fin(const Frame& F, int i) { return (const float*)(*(const GAS float* const __attribute__((address_space(4)))*)(F.ka + 8 * i)); }
DI unsigned char* fout(const Frame& F) { return (unsigned char*)(*(GAS unsigned char* const __attribute__((address_space(4)))*)(F.ka + 160)); }
DI unsigned char* fws(const Frame& F) { return (unsigned char*)(*(GAS unsigned char* const __attribute__((address_space(4)))*)(F.ka + 168)); }

typedef short v4i16_t __attribute__((ext_vector_type(4)));
DI s16x4 lds_tr(const LAS bf16* p) { return __builtin_bit_cast(s16x4, __builtin_amdgcn_ds_read_tr16_b64_v4i16((LAS v4i16_t*)p)); }
DI bf16x8 tr_frag(const LAS bf16* img, int stride, int row_lo, int row_hi, int colbase, int lane) {
    const int q = (lane & 15) >> 2, p = lane & 3, blk = (lane >> 4) & 1;
    const s16x4 lo = lds_tr(img + (row_lo + q) * stride + colbase + 16 * blk + 4 * p);
    const s16x4 hi = lds_tr(img + (row_hi + q) * stride + colbase + 16 * blk + 4 * p);
    return (bf16x8){lo[0], lo[1], lo[2], lo[3], hi[0], hi[1], hi[2], hi[3]};
}
DI void transpose_item(const float* W, int N, int K, int k0, int n0, bf16* WT, int dst_row0, LAS bf16* img, int lane) {
    const int kk = lane >> 4, n4 = (lane & 15) * 4;
    f32x4 v[16];
#pragma unroll
    for (int i = 0; i < 16; ++i) v[i] = __builtin_nontemporal_load((const f32x4*)(W + (size_t)(k0 + 4 * i + kk) * N + n0 + n4));
#pragma unroll
    for (int i = 0; i < 16; ++i) { u32x2 w2; w2.x = cvt_pk_bf16(v[i].x, v[i].y); w2.y = cvt_pk_bf16(v[i].z, v[i].w); *(LAS u32x2*)(img + (4 * i + kk) * 72 + n4) = w2; }
    LDS_WAIT(); asm volatile("" ::: "memory");
    const int r = lane & 31, h = lane >> 5;
#pragma unroll
    for (int cb = 0; cb < 2; ++cb)
#pragma unroll
        for (int kb = 0; kb < 4; ++kb) { const bf16x8 f = tr_frag(img, 72, 16 * kb + 8 * h, 16 * kb + 8 * h + 4, 32 * cb, lane);
            *(bf16x8*)(WT + (size_t)(dst_row0 + 32 * cb + r) * K + k0 + 16 * kb + 8 * h) = f; }
    LDS_WAIT(); asm volatile("" ::: "memory");
}
DI void wabs_item(const float* W, int N, int k0, int n0, unsigned* dst, int lane) {
    const float* p = W + (size_t)k0 * N + n0 + lane * 4;
    f32x4 m = (f32x4){0.f, 0.f, 0.f, 0.f};
#pragma unroll 8
    for (int k = 0; k < 128; ++k) { const f32x4 v = __builtin_nontemporal_load((const f32x4*)(p + (size_t)k * N)); m.x = fmaxf(m.x, fabsf(v.x)); m.y = fmaxf(m.y, fabsf(v.y)); m.z = fmaxf(m.z, fabsf(v.z)); m.w = fmaxf(m.w, fabsf(v.w)); }
    unsigned* d = dst + lane * 4;
    __hip_atomic_fetch_max(d + 0, __float_as_uint(m.x), __ATOMIC_RELAXED, __HIP_MEMORY_SCOPE_AGENT); __hip_atomic_fetch_max(d + 1, __float_as_uint(m.y), __ATOMIC_RELAXED, __HIP_MEMORY_SCOPE_AGENT);
    __hip_atomic_fetch_max(d + 2, __float_as_uint(m.z), __ATOMIC_RELAXED, __HIP_MEMORY_SCOPE_AGENT); __hip_atomic_fetch_max(d + 3, __float_as_uint(m.w), __ATOMIC_RELAXED, __HIP_MEMORY_SCOPE_AGENT);
}
constexpr int WABS_I_IN = (NPROJ / 256) * 16, WABS_I_OUT = (DM / 256) * 16, WABS_I_G1 = (DEXP / 256) * 16, WABS_I_GU = NEXP * 2 * WABS_I_G1, WABS_PER_L = WABS_I_IN + WABS_I_OUT;
DI void wabs_layer_item(Frame& F, int l, int r) {
    unsigned* A = (unsigned*)(fws(F) + WS_CTL + CTL_ABS) + (size_t)l * ABS_PER_LAYER;
    if (r < WABS_I_IN) { const int nb = r >> 4, kr = r & 15; wabs_item(fin(F, 3) + (size_t)l * DM * NPROJ, NPROJ, 128 * kr, 256 * nb, A + ABS_IN + 256 * nb, F.lane); return; } r -= WABS_I_IN;
    if (r < WABS_I_OUT) { const int nb = r >> 4, kr = r & 15; wabs_item(fin(F, 10) + (size_t)l * DM * DM, DM, 128 * kr, 256 * nb, A + ABS_OUT + 256 * nb, F.lane); return; } r -= WABS_I_OUT;
    { const int e = r / (2 * WABS_I_G1), r2 = r % (2 * WABS_I_G1), isup = r2 / WABS_I_G1, r3 = r2 % WABS_I_G1, nb = r3 >> 4, kr = r3 & 15;
      const float* W = (isup ? fin(F, 16) : fin(F, 15)) + ((size_t)l * NEXP + e) * DM * DEXP;
      const int n0 = 256 * nb; unsigned* dst = A + ABS_GU + e * 2048;
      const float* p = W + (size_t)(128 * kr) * DEXP + n0 + F.lane * 4;
      f32x4 m = (f32x4){0.f, 0.f, 0.f, 0.f};
#pragma unroll 8
      for (int k = 0; k < 128; ++k) { const f32x4 v = __builtin_nontemporal_load((const f32x4*)(p + (size_t)k * DEXP)); m.x = fmaxf(m.x, fabsf(v.x)); m.y = fmaxf(m.y, fabsf(v.y)); m.z = fmaxf(m.z, fabsf(v.z)); m.w = fmaxf(m.w, fabsf(v.w)); }
      const int n = n0 + F.lane * 4; unsigned* d = dst + 256 * (n >> 7) + 128 * isup + (n & 127);
      __hip_atomic_fetch_max(d + 0, __float_as_uint(m.x), __ATOMIC_RELAXED, __HIP_MEMORY_SCOPE_AGENT); __hip_atomic_fetch_max(d + 1, __float_as_uint(m.y), __ATOMIC_RELAXED, __HIP_MEMORY_SCOPE_AGENT);
      __hip_atomic_fetch_max(d + 2, __float_as_uint(m.z), __ATOMIC_RELAXED, __HIP_MEMORY_SCOPE_AGENT); __hip_atomic_fetch_max(d + 3, __float_as_uint(m.w), __ATOMIC_RELAXED, __HIP_MEMORY_SCOPE_AGENT); }
}
DI void wabs_phase(Frame& F, int l) {
    const int gw = F.vcu * 8 + F.wave, NGW = F.G * 8;
    for (int it = gw; it < WABS_PER_L; it += NGW) wabs_layer_item(F, l, it);
}
constexpr int WABS_T1 = WABS_PER_L < 1024 ? WABS_PER_L : 1024;
DI int wabs_t2(int G, int nunits) { const int nfull = nunits % G, nidle = nfull ? G - nfull : G; const int t2 = WABS_T1 + nidle * 8; return t2 < WABS_PER_L ? t2 : WABS_PER_L; }
DI void wabs_tail(Frame& F, int nunits, int lo, int hi) {
    const int nfull = nunits % F.G; const int nidle = nfull ? F.G - nfull : F.G; const int fi = nfull ? F.bx - nfull : F.bx;
    if (fi < 0) return;
    for (int it = lo + fi * 8 + F.wave; it < hi; it += nidle * 8) wabs_layer_item(F, 1, it);
}
DI unsigned q8(float x) { return (unsigned)(int)__builtin_rintf(x) & 0xffu; }
DI void transpose_item_q(const float* W, int N, int K8, int k0, int n0, unsigned char* WT8, int dst_row0, const float* amax, LAS bf16* img, int lane) {
    const int kk2 = lane >> 4, n4 = (lane & 15) * 4;
    const f32x4 am = *(const f32x4*)(amax + dst_row0 + n4);
    const f32x4 inv = (f32x4){am.x > 0.f ? 127.0f / am.x : 0.f, am.y > 0.f ? 127.0f / am.y : 0.f, am.z > 0.f ? 127.0f / am.z : 0.f, am.w > 0.f ? 127.0f / am.w : 0.f};
    f32x4 va[8], vb[8];
#pragma unroll
    for (int i = 0; i < 8; ++i) { const float* p = W + (size_t)(k0 + 8 * i + 2 * kk2) * N + n0 + n4; va[i] = __builtin_nontemporal_load((const f32x4*)p); vb[i] = __builtin_nontemporal_load((const f32x4*)(p + N)); }
#pragma unroll
    for (int i = 0; i < 8; ++i) { const f32x4 a = va[i] * inv, b2 = vb[i] * inv;
        const unsigned e0 = q8(a.x) | (q8(b2.x) << 8), e1 = q8(a.y) | (q8(b2.y) << 8), e2 = q8(a.z) | (q8(b2.z) << 8), e3 = q8(a.w) | (q8(b2.w) << 8);
        u32x2 w2; w2.x = e0 | (e1 << 16); w2.y = e2 | (e3 << 16); *(LAS u32x2*)(img + (4 * i + kk2) * 72 + n4) = w2; }
    LDS_WAIT(); asm volatile("" ::: "memory");
    const int r = lane & 31, h = lane >> 5;
#pragma unroll
    for (int cb = 0; cb < 2; ++cb)
#pragma unroll
        for (int kb = 0; kb < 2; ++kb) { const bf16x8 f = tr_frag(img, 72, 16 * kb + 8 * h, 16 * kb + 8 * h + 4, 32 * cb, lane);
            *(bf16x8*)(WT8 + (size_t)(dst_row0 + 32 * cb + r) * K8 + k0 + 32 * kb + 16 * h) = f; }
    LDS_WAIT(); asm volatile("" ::: "memory");
}
DI void transpose_item_f8(const float* W, int N, int K8, int k0, int n0, unsigned char* WT8, int dst_row0, const float scale, LAS bf16* img, int lane) {
    const int kk2 = lane >> 4, n4 = (lane & 15) * 4;
    f32x4 va[8], vb[8];
#pragma unroll
    for (int i = 0; i < 8; ++i) { const float* p = W + (size_t)(k0 + 8 * i + 2 * kk2) * N + n0 + n4; va[i] = __builtin_nontemporal_load((const f32x4*)p); vb[i] = __builtin_nontemporal_load((const f32x4*)(p + N)); }
#pragma unroll
    for (int i = 0; i < 8; ++i) { const f32x4 a = va[i] * scale, b2 = vb[i] * scale;
        u32x2 w2; w2.x = pg8::pk_fp8x4(a.x, b2.x, a.y, b2.y); w2.y = pg8::pk_fp8x4(a.z, b2.z, a.w, b2.w); *(LAS u32x2*)(img + (4 * i + kk2) * 72 + n4) = w2; }
    LDS_WAIT(); asm volatile("" ::: "memory");
    const int r = lane & 31, h = lane >> 5;
#pragma unroll
    for (int cb = 0; cb < 2; ++cb)
#pragma unroll
        for (int kb = 0; kb < 2; ++kb) { const bf16x8 f = tr_frag(img, 72, 16 * kb + 8 * h, 16 * kb + 8 * h + 4, 32 * cb, lane);
            *(bf16x8*)(WT8 + (size_t)(dst_row0 + 32 * cb + r) * K8 + k0 + 32 * kb + 16 * h) = f; }
    LDS_WAIT(); asm volatile("" ::: "memory");
}
struct F8Item { const float* W; int N, K8, k0, n0; unsigned char* WT8; int dst_row0; float scale; };
DI void f8_item_load(const F8Item& a, int lane, f32x4 (&va)[8], f32x4 (&vb)[8]) {
    const int kk2 = lane >> 4, n4 = (lane & 15) * 4;
#pragma unroll
    for (int i = 0; i < 8; ++i) { const float* p = a.W + (size_t)(a.k0 + 8 * i + 2 * kk2) * a.N + a.n0 + n4; va[i] = __builtin_nontemporal_load((const f32x4*)p); vb[i] = __builtin_nontemporal_load((const f32x4*)(p + a.N)); }
}
DI void f8_item_finish(const F8Item& a, int lane, const f32x4 (&va)[8], const f32x4 (&vb)[8], LAS bf16* img) {
    const int kk2 = lane >> 4, n4 = (lane & 15) * 4;
#pragma unroll
    for (int i = 0; i < 8; ++i) { const f32x4 x = va[i] * a.scale, y = vb[i] * a.scale;
        u32x2 w2; w2.x = pg8::pk_fp8x4(x.x, y.x, x.y, y.y); w2.y = pg8::pk_fp8x4(x.z, y.z, x.w, y.w); *(LAS u32x2*)(img + (4 * i + kk2) * 72 + n4) = w2; }
    LDS_WAIT(); asm volatile("" ::: "memory");
    const int r = lane & 31, h = lane >> 5;
#pragma unroll
    for (int cb = 0; cb < 2; ++cb)
#pragma unroll
        for (int kb = 0; kb < 2; ++kb) { const bf16x8 f = tr_frag(img, 72, 16 * kb + 8 * h, 16 * kb + 8 * h + 4, 32 * cb, lane);
            *(bf16x8*)(a.WT8 + (size_t)(a.dst_row0 + 32 * cb + r) * a.K8 + a.k0 + 32 * kb + 16 * h) = f; }
    LDS_WAIT(); asm volatile("" ::: "memory");
}
constexpr int CV_I_IN = (DM / 64) * (NPROJ / 64), CV_I_OUT = (DM / 64) * (DM / 64), CV_I_G1 = (DM / 64) * (DEXP / 64), CV_I_GU = NEXP * 2 * CV_I_G1, CV_I_D1 = (DEXP / 64) * (DM / 64), CV_I_D = NEXP * CV_I_D1;
constexpr int CV_F8 = CV_I_GU + CV_I_D, CV_N = CV_F8 + CV_I_IN + CV_I_OUT;
DI LAS float* convert_scales(Frame& F, int l, bool publish) {
    const float* w_gate = fin(F, 15) + (size_t)l * NEXP * DM * DEXP; const float* w_up = fin(F, 16) + (size_t)l * NEXP * DM * DEXP; const float* w_down = fin(F, 17) + (size_t)l * NEXP * DEXP * DM;
    LAS float* wred = (LAS float*)(F.lds + 81920); LAS float* wsc = wred + 384;
    __syncthreads();
#pragma unroll 1
    for (int eb = 0; eb < 3 * NEXP; eb += 16) {
        f32x4 v[16];
#pragma unroll
        for (int i = 0; i < 16; ++i) { const int e = eb + i; const float* src = e < NEXP ? w_down + (size_t)e * DEXP * DM : ((e & 1) ? w_up : w_gate) + (size_t)((e - NEXP) >> 1) * DM * DEXP;
            v[i] = *(const f32x4*)(src + 4 * F.tid); }
#pragma unroll
        for (int i = 0; i < 16; ++i) { const float m = wave_max(fmaxf(fmaxf(fabsf(v[i].x), fabsf(v[i].y)), fmaxf(fabsf(v[i].z), fabsf(v[i].w)))); if (F.lane == 0) wred[(eb + i) * 8 + F.wave] = m; } }
    __syncthreads();
    if (F.tid < 3 * NEXP) { float m = 1e-30f;
#pragma unroll
        for (int j = 0; j < 8; ++j) m = fmaxf(m, wred[F.tid * 8 + j]);
        const float sc = exp2f(floorf(log2f(64.0f / m))); wsc[F.tid] = sc;
        if (publish && F.bx == 0) { if (F.tid < NEXP) ((float*)(fws(F) + WS_WDS))[l * NEXP + F.tid] = 1.0f / (pg8::HID_SCALE * sc); else ((float*)(fws(F) + WS_GUS))[l * 2 * NEXP + F.tid - NEXP] = 1.0f / (pg8::ACT_SCALE * sc); } }
    __syncthreads();
    return wsc;
}
DI void convert_range(Frame& F, int l, int p_lo, int p_hi, int widx, int nw, const LAS float* wsc) {
    LAS bf16* img = (LAS bf16*)(F.lds + F.wave * 9216);
    const float* w_in = fin(F, 3) + (size_t)l * DM * NPROJ; const float* w_out = fin(F, 10) + (size_t)l * DM * DM;
    const float* w_gate = fin(F, 15) + (size_t)l * NEXP * DM * DEXP; const float* w_up = fin(F, 16) + (size_t)l * NEXP * DM * DEXP; const float* w_down = fin(F, 17) + (size_t)l * NEXP * DEXP * DM;
    unsigned char* wb = fws(F) + (size_t)l * WS_WSET;
    unsigned char* WIN = wb + WS_WIN; unsigned char* WOUT = wb + WS_WOUT; unsigned char* WGU = wb + WS_WGU; unsigned char* WD = wb + WS_WD;
    const float* ABS = (const float*)(fws(F) + WS_CTL + CTL_ABS) + (size_t)l * ABS_PER_LAYER;
    auto f8item = [&](int r) -> F8Item {
        if (r < CV_I_GU) { const int e = r / (2 * CV_I_G1), r2 = r % (2 * CV_I_G1), isup = r2 / CV_I_G1, r3 = r2 % CV_I_G1; const int nblk = DEXP / 64, kb = r3 / nblk, nb = r3 % nblk, n0 = 64 * nb;
            return F8Item{(isup ? w_up : w_gate) + (size_t)e * DM * DEXP, DEXP, DM, 64 * kb, n0, WGU + (size_t)e * 2048 * DM, 256 * (n0 >> 7) + 128 * isup + (n0 & 127), wsc[NEXP + 2 * e + isup]}; }
        r -= CV_I_GU; const int e = r / CV_I_D1, r3 = r % CV_I_D1; const int nblk = DM / 64, kb = r3 / nblk, nb = r3 % nblk;
        return F8Item{w_down + (size_t)e * DEXP * DM, DM, DEXP, 64 * kb, 64 * nb, WD + (size_t)e * DM * DEXP, 64 * nb, wsc[e]}; };
    int p = p_lo + widx;
    const int f8_hi = p_hi < CV_F8 ? p_hi : CV_F8;
    if (p < f8_hi) {
        f32x4 va[8], vb[8], vc[8], vd[8];
        F8Item a = f8item(p); f8_item_load(a, F.lane, va, vb);
        for (;;) {
            const int p1 = p + nw; const bool has1 = p1 < f8_hi; F8Item b = a;
            if (has1) { b = f8item(p1); f8_item_load(b, F.lane, vc, vd); }
            f8_item_finish(a, F.lane, va, vb, img);
            p = p1; if (!has1) break;
            const int p2 = p1 + nw; const bool has2 = p2 < f8_hi;
            if (has2) { a = f8item(p2); f8_item_load(a, F.lane, va, vb); }
            f8_item_finish(b, F.lane, vc, vd, img + 32 * 72);
            p = p2; if (!has2) break;
        }
    }
    for (; p < p_hi; p += nw) {
        int r = p;
        if (r < CV_I_GU) { const int e = r / (2 * CV_I_G1), r2 = r % (2 * CV_I_G1), isup = r2 / CV_I_G1, r3 = r2 % CV_I_G1; const int nblk = DEXP / 64, kb = r3 / nblk, nb = r3 % nblk, n0 = 64 * nb;
            const float* W = (isup ? w_up : w_gate) + (size_t)e * DM * DEXP;
            transpose_item_f8(W, DEXP, DM, 64 * kb, n0, WGU + (size_t)e * 2048 * DM, 256 * (n0 >> 7) + 128 * isup + (n0 & 127), wsc[NEXP + 2 * e + isup], img, F.lane); continue; } r -= CV_I_GU;
        if (r < CV_I_D) { const int e = r / CV_I_D1, r3 = r % CV_I_D1; const int nblk = DM / 64, kb = r3 / nblk, nb = r3 % nblk;
            transpose_item_f8(w_down + (size_t)e * DEXP * DM, DM, DEXP, 64 * kb, 64 * nb, WD + (size_t)e * DM * DEXP, 64 * nb, wsc[e], img, F.lane); continue; } r -= CV_I_D;
        if (r < CV_I_IN) { const int nblk = NPROJ / 64, kb = r / nblk, nb = r % nblk; transpose_item_q(w_in, NPROJ, DM, 64 * kb, 64 * nb, WIN, 64 * nb, ABS + ABS_IN, img, F.lane); continue; } r -= CV_I_IN;
        { const int nblk = DM / 64, kb = r / nblk, nb = r % nblk; transpose_item_q(w_out, DM, DM, 64 * kb, 64 * nb, WOUT, 64 * nb, ABS + ABS_OUT, img, F.lane); }
    }
}
DI void convert_weights(Frame& F, int l, int p_lo) {
    const LAS float* wsc = convert_scales(F, l, true);
    convert_range(F, l, p_lo, CV_N, F.vcu * 8 + F.wave, F.G * 8, wsc);
}
DI int gemm_workers(int G, int units) { if (G % 8) return G; const int R = (units + G - 1) / G; const int gw = 8 * ((units + 8 * R - 1) / (8 * R)); return gw < G ? gw : G; }
constexpr int HQ_A = 56, HQ_B = 40, HQ_C = 20;
constexpr int UNITS_IN = (T_TOK / 256) * (NPROJ / 256);
DI int helper_items_a(int G) { const int n = (G - gemm_workers(G, UNITS_IN)) * 8 * HQ_A; return n < CV_F8 ? n : CV_F8; }
DI int helper_items_bc(int G, int units, int q) { return (G - gemm_workers(G, units)) * 8 * q; }
DI void helper_convert(Frame& F, int Gw, int p_lo, int count, bool with_wabs) {
    const int hw = (F.bx - Gw) * 8 + F.wave, nhw = (F.G - Gw) * 8;
    if (with_wabs) for (int it = hw; it < WABS_PER_L; it += nhw) wabs_layer_item(F, 1, it);
    const LAS float* wsc = convert_scales(F, 1, false);
    const int hi = p_lo + count < CV_N ? p_lo + count : CV_N;
    convert_range(F, 1, p_lo, hi, hw, nhw, wsc);
}
DI void stage_gb(Frame& F, const float* g, const float* bb, LAS float* gl, LAS float* bl) {
    const f32x4 gv = *(const f32x4*)(g + 4 * F.tid), bv = *(const f32x4*)(bb + 4 * F.tid);
    *(LAS f32x4*)(gl + 4 * F.tid) = gv; *(LAS f32x4*)(bl + 4 * F.tid) = bv;
}
DI void ln_emb(Frame& F) {
    const int gw = F.vcu * 8 + F.wave, NGW = F.G * 8;
    const float* x = fin(F, 0); const float* g = fin(F, 1); const float* bb = fin(F, 2); bf16* H = (bf16*)(fws(F) + WS_H); unsigned char* H8 = fws(F) + WS_H8; float* HS = (float*)(fws(F) + WS_HS);
    LAS float* gl = (LAS float*)F.lds; LAS float* bl = gl + DM;
    __syncthreads(); stage_gb(F, g, bb, gl, bl); __syncthreads();
    f32x4 pre[8];
    if (gw < T_TOK) { const f32x4* xr = (const f32x4*)(x + (size_t)gw * DM) + F.lane;
#pragma unroll
        for (int j = 0; j < 8; ++j) pre[j] = __builtin_nontemporal_load(xr + 64 * j); }
    for (int m = gw; m < T_TOK; m += NGW) {
        f32x4 v[8]; float s = 0.f;
#pragma unroll
        for (int j = 0; j < 8; ++j) { v[j] = pre[j]; s += (v[j].x + v[j].y) + (v[j].z + v[j].w); }
        if (m + NGW < T_TOK) { const f32x4* xr = (const f32x4*)(x + (size_t)(m + NGW) * DM) + F.lane;
#pragma unroll
            for (int j = 0; j < 8; ++j) pre[j] = __builtin_nontemporal_load(xr + 64 * j); }
        const float mean = wave_sum(s) * (1.f / DM); float s2 = 0.f;
#pragma unroll
        for (int j = 0; j < 8; ++j) { v[j] = v[j] - mean; s2 += (v[j].x * v[j].x + v[j].y * v[j].y) + (v[j].z * v[j].z + v[j].w * v[j].w); }
        const float rstd = 1.f / sqrtf(wave_sum(s2) * (1.f / DM) + LN_EPS);
        u32x2* o8 = (u32x2*)(H + (size_t)m * DM) + F.lane; float am = 0.f;
#pragma unroll
        for (int j = 0; j < 8; ++j) { const f32x4 gg = ((const LAS f32x4*)gl)[F.lane + 64 * j], bv = ((const LAS f32x4*)bl)[F.lane + 64 * j];
            v[j] = v[j] * rstd * gg + bv; am = fmaxf(fmaxf(am, fmaxf(fabsf(v[j].x), fabsf(v[j].y))), fmaxf(fabsf(v[j].z), fabsf(v[j].w)));
            u32x2 w; w.x = cvt_pk_bf16(v[j].x, v[j].y); w.y = cvt_pk_bf16(v[j].z, v[j].w); o8[64 * j] = w; }
        am = wave_max(am); const float inv = am > 0.f ? 127.0f / am : 0.f;
        unsigned* q4 = (unsigned*)(H8 + (size_t)m * DM) + F.lane;
#pragma unroll
        for (int j = 0; j < 8; ++j) q4[64 * j] = q8(v[j].x * inv) | (q8(v[j].y * inv) << 8) | (q8(v[j].z * inv) << 16) | (q8(v[j].w * inv) << 24);
        if (F.lane == 0) HS[m] = am * (1.0f / 127.0f);
    }
}

constexpr int AT_KS = 72, AT_VS = 392;
DI void attn_phase(Frame& F, int l) {
    const bf16* P = (const bf16*)(fws(F) + WS_PROJ); bf16* Y = (bf16*)(fout(F) + DO_Y);
    LAS bf16* Ks = (LAS bf16*)F.lds; LAS bf16* Vt = (LAS bf16*)(F.lds + 384 * AT_KS * 2);
    const int tid = F.tid, lane = F.lane, w = F.wave, r = lane & 31, h = lane >> 5;
    const float* sinkp = fin(F, 4) + l * 8;
    const bool deal = (F.G == 256);
    const int u_first = deal ? (F.vcu >= 128 ? (F.vcu - 128) * 4 : F.vcu * 4 + 3) : F.vcu, u_step = deal ? 1 : F.G, u_end = deal ? (F.vcu >= 128 ? (F.vcu - 128) * 4 + 3 : F.vcu * 4 + 4) : NBATCH * 32 * 2;
    for (int u = u_first; u < u_end; u += u_step) {
        const int kvh = u & 1, n = (u >> 1) & 31, b = u >> 6;
        const size_t rowb = (size_t)b * SEQ;
        __syncthreads();
#pragma unroll
        for (int i = 0; i < 6; ++i) { const int idx = tid + 512 * i, row = idx >> 3, ch = idx & 7; const int tok = n * 128 - 128 + row;
            u32x4 kv = (u32x4){0u, 0u, 0u, 0u}, vv = (u32x4){0u, 0u, 0u, 0u};
            if (tok >= 0 && tok < SEQ) { const bf16* src = P + (rowb + tok) * NPROJ; kv = *(const u32x4*)(src + C_AK + kvh * 64 + ch * 8); vv = *(const u32x4*)(src + C_AV + kvh * 64 + ch * 8); }
            *(LAS u32x4*)(Ks + row * AT_KS + ch * 8) = kv;
            LAS bf16* vd = Vt + (ch * 8) * AT_VS + row;
            vd[0 * AT_VS] = (bf16)(vv.x & 0xffffu); vd[1 * AT_VS] = (bf16)(vv.x >> 16); vd[2 * AT_VS] = (bf16)(vv.y & 0xffffu); vd[3 * AT_VS] = (bf16)(vv.y >> 16);
            vd[4 * AT_VS] = (bf16)(vv.z & 0xffffu); vd[5 * AT_VS] = (bf16)(vv.z >> 16); vd[6 * AT_VS] = (bf16)(vv.w & 0xffffu); vd[7 * AT_VS] = (bf16)(vv.w >> 16); }
        __syncthreads();
        const int hq = kvh * 4 + (w >> 1);
        const float slope2 = exp2f(-(float)(hq + 1)) * 1.4426950408889634f; const float sink2 = sinkp[hq] * 1.4426950408889634f; const float c1 = 0.125f * 1.4426950408889634f;
        const bool edge = (n == 0) || (n == 31); const int jlo = (n == 0) ? 128 : 0, jhi = (n == 31) ? 256 : 384;
#pragma unroll 1
        for (int qi = 0; qi < 2; ++qi) {
            const int t0 = (w & 1) * 64 + 32 * qi;
            const bf16* qsrc = P + (rowb + n * 128 + t0 + r) * NPROJ + C_AQ + hq * 64 + 8 * h;
            bf16x8 qf[4];
#pragma unroll
            for (int ks = 0; ks < 4; ++ks) qf[ks] = *(const bf16x8*)(qsrc + ks * 16);
            float m = sink2, lsum = (h == 0) ? 1.0f : 0.0f;
            f32x16 O0, O1;
#pragma unroll
            for (int i = 0; i < 16; ++i) { O0[i] = 0.f; O1[i] = 0.f; }
#pragma unroll 1
            for (int kt = 0; kt < 9; ++kt) {
                const int j0 = t0 + 32 * kt;
                f32x16 s;
#pragma unroll
                for (int i = 0; i < 16; ++i) s[i] = 0.f;
#pragma unroll
                for (int ks = 0; ks < 4; ++ks) { const bf16x8 a = *(const LAS bf16x8*)(Ks + (j0 + r) * AT_KS + ks * 16 + 8 * h); s = MFMA32(a, qf[ks], s); }
                const float fbase = (float)(32 * kt - 128 - r + 4 * h);
#pragma unroll
                for (int i = 0; i < 16; ++i) { const float fd = fbase + (float)((i & 3) + 8 * (i >> 2)); s[i] = __builtin_fmaf(s[i], c1, -slope2 * __builtin_fabsf(fd)); }
                if (kt == 0 || kt == 8 || edge) {
#pragma unroll
                    for (int i = 0; i < 16; ++i) { const float fd = fbase + (float)((i & 3) + 8 * (i >> 2)); const int j = j0 + crow(i, h);
                        const bool ok = (__builtin_fabsf(fd) <= 128.f) && (j >= jlo) && (j < jhi); s[i] = ok ? s[i] : -INFINITY; } }
                float mx = -INFINITY;
#pragma unroll
                for (int i = 0; i < 16; ++i) mx = fmaxf(mx, s[i]);
                mx = max32(mx);
                const float mn = fmaxf(m, mx); const float sc = __builtin_amdgcn_exp2f(m - mn); m = mn;
                float ps = 0.f;
#pragma unroll
                for (int i = 0; i < 16; ++i) { const float p = __builtin_amdgcn_exp2f(s[i] - mn); s[i] = p; ps += p; }
                lsum = lsum * sc + ps;
#pragma unroll
                for (int i = 0; i < 16; ++i) { O0[i] *= sc; O1[i] *= sc; }
#pragma unroll
                for (int s2 = 0; s2 < 2; ++s2) {
                    u32x4 pw; pw.x = cvt_pk_bf16(s[8 * s2 + 0], s[8 * s2 + 1]); pw.y = cvt_pk_bf16(s[8 * s2 + 2], s[8 * s2 + 3]); pw.z = cvt_pk_bf16(s[8 * s2 + 4], s[8 * s2 + 5]); pw.w = cvt_pk_bf16(s[8 * s2 + 6], s[8 * s2 + 7]);
                    const bf16x8 pf = __builtin_bit_cast(bf16x8, pw);
                    const LAS bf16* vb = Vt + j0 + 16 * s2 + 4 * h;
                    { const u32x2 lo = *(const LAS u32x2*)(vb + r * AT_VS), hi = *(const LAS u32x2*)(vb + r * AT_VS + 8); const u32x4 aw = (u32x4){lo.x, lo.y, hi.x, hi.y}; O0 = MFMA32(__builtin_bit_cast(bf16x8, aw), pf, O0); }
                    { const u32x2 lo = *(const LAS u32x2*)(vb + (32 + r) * AT_VS), hi = *(const LAS u32x2*)(vb + (32 + r) * AT_VS + 8); const u32x4 aw = (u32x4){lo.x, lo.y, hi.x, hi.y}; O1 = MFMA32(__builtin_bit_cast(bf16x8, aw), pf, O1); }
                }
            }
            const float lt = sum32(lsum); const float inv = __builtin_amdgcn_rcpf(lt);
            bf16* yo = Y + (rowb + n * 128 + t0 + r) * DM + hq * 64 + 4 * h;
#pragma unroll
            for (int g4 = 0; g4 < 4; ++g4) {
                u32x2 w0; w0.x = cvt_pk_bf16(O0[4 * g4] * inv, O0[4 * g4 + 1] * inv); w0.y = cvt_pk_bf16(O0[4 * g4 + 2] * inv, O0[4 * g4 + 3] * inv); *(u32x2*)(yo + 8 * g4) = w0;
                u32x2 w1; w1.x = cvt_pk_bf16(O1[4 * g4] * inv, O1[4 * g4 + 1] * inv); w1.y = cvt_pk_bf16(O1[4 * g4 + 2] * inv, O1[4 * g4 + 3] * inv); *(u32x2*)(yo + 32 + 8 * g4) = w1; }
        }
    }
}

DI void conv_phase(Frame& F, int l) {
    const bf16* P = (const bf16*)(fws(F) + WS_PROJ); bf16* Y = (bf16*)(fout(F) + DO_Y);
    const float* cw = fin(F, 5) + (size_t)l * 3 * 512;
    const int nthr = F.G * 512;
    for (int it = F.vcu * 512 + F.tid; it < T_TOK * 64; it += nthr) {
        const int ch = it & 63, tok = it >> 6, tl = tok & (SEQ - 1);
        const bf16* src = P + (size_t)tok * NPROJ + ch * 8;
        float u0[8], u1[8], u2[8], bq[8], a[8], c[8];
        { const u32x4 cc = *(const u32x4*)(src + C_CC), hh = *(const u32x4*)(src + C_CH); unpack8(cc, a); unpack8(hh, c);
#pragma unroll
          for (int j = 0; j < 8; ++j) u1[j] = a[j] * c[j]; }
        if (tl > 0) { const u32x4 cc = *(const u32x4*)(src - NPROJ + C_CC), hh = *(const u32x4*)(src - NPROJ + C_CH); unpack8(cc, a); unpack8(hh, c);
#pragma unroll
          for (int j = 0; j < 8; ++j) u0[j] = a[j] * c[j]; }
        else {
#pragma unroll
          for (int j = 0; j < 8; ++j) u0[j] = 0.f; }
        if (tl < SEQ - 1) { const u32x4 cc = *(const u32x4*)(src + NPROJ + C_CC), hh = *(const u32x4*)(src + NPROJ + C_CH); unpack8(cc, a); unpack8(hh, c);
#pragma unroll
          for (int j = 0; j < 8; ++j) u2[j] = a[j] * c[j]; }
        else {
#pragma unroll
          for (int j = 0; j < 8; ++j) u2[j] = 0.f; }
        { const u32x4 bw = *(const u32x4*)(src + C_CB); unpack8(bw, bq); }
        float o[8];
#pragma unroll
        for (int j = 0; j < 8; ++j) { const int cidx = ch * 8 + j; o[j] = bq[j] * (cw[cidx] * u0[j] + cw[512 + cidx] * u1[j] + cw[1024 + cidx] * u2[j]); }
        *(u32x4*)(Y + (size_t)tok * DM + 512 + ch * 8) = pack8(o);
    }
}

constexpr int GL_RS = 72;
constexpr int GL_VS = 136;
constexpr int GL_QH_OFF = 0;
constexpr int GL_KD_OFF = GL_QH_OFF + 64 * GL_RS * 2;
constexpr int GL_KT_OFF = GL_KD_OFF + 64 * GL_RS * 2;
constexpr int GL_QT_OFF = GL_KT_OFF + 64 * GL_RS * 2;
constexpr int GL_KO_OFF = GL_QT_OFF + 32 * GL_RS * 2;
constexpr int GL_V_OFF = GL_KO_OFF + 32 * GL_RS * 2;
constexpr int GL_RZ_OFF = GL_V_OFF + 2 * 64 * GL_VS * 2;
constexpr int GL_RQ_OFF = GL_RZ_OFF + 64 * GL_RS * 2;
constexpr int GL_OB_OFF = GL_RQ_OFF + 64 * GL_RS * 2;
constexpr int GL_SX_OFF = GL_OB_OFF + 64 * GL_VS * 2;
constexpr int GL_DEC_OFF = GL_SX_OFF + 2 * 128 * GL_RS * 2;
constexpr int GL_END = GL_DEC_OFF + 64 * 4;
static_assert(GL_END <= LDSCTL_OFF, "GLA LDS");
#define LDS_BARRIER() asm volatile("s_waitcnt lgkmcnt(0)\n\ts_barrier" ::: "memory")

template <int N> DI float dpp_row_shr(float x) { return __builtin_bit_cast(float, __builtin_amdgcn_update_dpp(0, __builtin_bit_cast(int, x), 0x110 + N, 0xf, 0xf, true)); }
DI float wave_scan_incl(float x, int lane) {
    x += dpp_row_shr<1>(x); x += dpp_row_shr<2>(x); x += dpp_row_shr<4>(x); x += dpp_row_shr<8>(x);
    x += __builtin_bit_cast(float, __builtin_amdgcn_update_dpp(0, __builtin_bit_cast(int, x), 0x142, 0xa, 0xf, false));
    x += __builtin_bit_cast(float, __builtin_amdgcn_update_dpp(0, __builtin_bit_cast(int, x), 0x143, 0xc, 0xf, false));
    (void)lane;
    return x;
}
DI float gla_lgamma(Frame& F, int l, int dir, int hh) { const float dl = fin(F, 8)[(l * 2 + dir) * 4 + hh]; return -__logf(1.0f + __expf(-dl)); }
DI bf16* gla_partial(Frame& F, int mixer, int dir, int dkh) {
    unsigned char* base = mixer == 0 ? (fout(F) + DO_OB) : (fws(F) + WS_OB1);
    return (bf16*)base + (size_t)(dir * 2 + dkh) * T_TOK * 512;
}

template <int I>
DI void gla_out_tile(const LAS bf16* Sc, const LAS bf16* Qh, const LAS bf16* Qt, const LAS bf16* Kd, const LAS bf16* Ko, const LAS bf16* Vc, LAS bf16* Ob, const int dvt, const int r, const int h, const int lane) {
    const LAS bf16* Qi = (I == 0) ? Qh : Qt;
    f32x16 acc;
#pragma unroll
    for (int i = 0; i < 16; ++i) acc[i] = 0.f;
#pragma unroll
    for (int ks = 0; ks < 4; ++ks) { const bf16x8 a = tr_frag(Sc, GL_VS, 16 * ks + 8 * h, 16 * ks + 8 * h + 4, 32 * dvt, lane), bb = *(const LAS bf16x8*)(Qi + r * GL_RS + ks * 16 + 8 * h); acc = MFMA32(a, bb, acc); }
    bf16x8 qb[4];
#pragma unroll
    for (int ks = 0; ks < 4; ++ks) qb[ks] = *(const LAS bf16x8*)(Qh + (32 * I + r) * GL_RS + ks * 16 + 8 * h);
#pragma unroll
    for (int J = 0; J <= I; ++J) {
        const LAS bf16* Ksrc = (J == I) ? (Kd + (32 * J) * GL_RS) : Ko;
        f32x16 s;
#pragma unroll
        for (int i = 0; i < 16; ++i) s[i] = 0.f;
#pragma unroll
        for (int ks = 0; ks < 4; ++ks) { const bf16x8 a = *(const LAS bf16x8*)(Ksrc + r * GL_RS + ks * 16 + 8 * h); s = MFMA32(a, qb[ks], s); }
        if (J == I) {
#pragma unroll
            for (int i = 0; i < 16; ++i) s[i] = (crow(i, h) <= r) ? s[i] : 0.f; }
#pragma unroll
        for (int s2 = 0; s2 < 2; ++s2) {
            u32x4 pw; pw.x = cvt_pk_bf16(s[8 * s2 + 0], s[8 * s2 + 1]); pw.y = cvt_pk_bf16(s[8 * s2 + 2], s[8 * s2 + 3]); pw.z = cvt_pk_bf16(s[8 * s2 + 4], s[8 * s2 + 5]); pw.w = cvt_pk_bf16(s[8 * s2 + 6], s[8 * s2 + 7]);
            const int rl = 32 * J + 16 * s2 + 4 * h;
            const bf16x8 a = tr_frag(Vc, GL_VS, rl, rl + 8, 32 * dvt, lane);
            acc = MFMA32(a, __builtin_bit_cast(bf16x8, pw), acc); }
    }
    LAS bf16* yo = Ob + (32 * I + r) * GL_VS + 32 * dvt + 4 * h;
#pragma unroll
    for (int g4 = 0; g4 < 4; ++g4) { u32x2 w0; w0.x = cvt_pk_bf16(acc[4 * g4], acc[4 * g4 + 1]); w0.y = cvt_pk_bf16(acc[4 * g4 + 2], acc[4 * g4 + 3]); *(LAS u32x2*)(yo + 8 * g4) = w0; }
}

DI void gla_seq_phase(Frame& F, int l, const float* lbp) {
    const bf16* P = (const bf16*)(fws(F) + WS_PROJ);
    const int tid = F.tid, lane = F.lane, w = F.wave, r = lane & 31, h = lane >> 5;
    LAS bf16* Qh = (LAS bf16*)(F.lds + GL_QH_OFF); LAS bf16* Kd = (LAS bf16*)(F.lds + GL_KD_OFF); LAS bf16* Qt = (LAS bf16*)(F.lds + GL_QT_OFF); LAS bf16* Kt = (LAS bf16*)(F.lds + GL_KT_OFF);
    LAS bf16* Ko = (LAS bf16*)(F.lds + GL_KO_OFF); LAS bf16* Vs = (LAS bf16*)(F.lds + GL_V_OFF); LAS bf16* Sx = (LAS bf16*)(F.lds + GL_SX_OFF); LAS float* dec = (LAS float*)(F.lds + GL_DEC_OFF);
    LAS bf16* Rz = (LAS bf16*)(F.lds + GL_RZ_OFF); LAS bf16* Rq = (LAS bf16*)(F.lds + GL_RQ_OFF); LAS bf16* Ob = (LAS bf16*)(F.lds + GL_OB_OFF);
    const int zrow = tid >> 3, zch = tid & 7, vrow0 = tid >> 4, vch = tid & 15;
    for (int unit = F.vcu; unit < 256; unit += F.G)
#pragma unroll 1
    for (int rp_ = 0; rp_ < 1 + (int)((((PH_DUP >> 17) & 1u) && unit < 128) || (((PH_DUP >> 18) & 1u) && unit >= 128)); ++rp_) {
        const int dkh = unit & 1, dir = (unit >> 1) & 1, hh = (unit >> 2) & 3, b = (unit >> 4) & 7, mixer = unit >> 7;
        const int qcol = mixer == 0 ? C_GQ : C_RQ, zcol = mixer == 0 ? (dir ? C_GZB : C_GZF) : C_RK, vcol = mixer == 0 ? C_GI : C_RV;
        const float lg = mixer == 1 ? gla_lgamma(F, l, dir, hh) : 0.f;
        const float rbu = (float)(lane + 1) * lg, rbeta = (lane >= 32) ? 32.f * lg : 0.f;
        const float rfa = __expf(rbu - rbeta), rfna = __expf(fminf(rbeta - rbu, 80.f)), rfkt = __expf(64.f * lg - rbu), re31 = __expf(32.f * lg), rdec = __expf(64.f * lg);
        const size_t rowb = (size_t)b * SEQ;
        bf16* ob = gla_partial(F, mixer, dir, dkh);
        const int dch = hh * 128 + 64 * dkh;
        float lbv[8];
#pragma unroll
        for (int j = 0; j < 8; ++j) lbv[j] = (mixer == 0 && lbp) ? lbp[dch + 8 * w + j] : 0.f;
        __syncthreads();
        for (int i = tid; i < 64 * GL_VS / 2; i += 512) ((LAS unsigned*)Sx)[i] = 0u;
        f32x16 st0, st1;
#pragma unroll
        for (int i = 0; i < 16; ++i) { st0[i] = 0.f; st1[i] = 0.f; }
        u32x4 zr, qr, vr0, vr1;
#define GLA_LOAD(cc) do { const int c_ = (cc); const bf16* s0_ = P + (rowb + c_ * 64 + (dir ? 63 - zrow : zrow)) * NPROJ; zr = *(const u32x4*)(s0_ + zcol + dch + 8 * zch); qr = *(const u32x4*)(s0_ + qcol + dch + 8 * zch); \
        const bf16* s1_ = P + (rowb + c_ * 64 + (dir ? 63 - vrow0 : vrow0)) * NPROJ + vcol + hh * 128 + 8 * vch; const bf16* s2_ = P + (rowb + c_ * 64 + (dir ? 63 - (vrow0 + 32) : (vrow0 + 32))) * NPROJ + vcol + hh * 128 + 8 * vch; \
        vr0 = *(const u32x4*)s1_; vr1 = *(const u32x4*)s2_; } while (0)
#define GLA_STASH(vb) do { *(LAS u32x4*)(Rz + zrow * GL_RS + 8 * zch) = zr; *(LAS u32x4*)(Rq + zrow * GL_RS + 8 * zch) = qr; \
        *(LAS u32x4*)(Vs + (vb) * (64 * GL_VS) + vrow0 * GL_VS + 8 * vch) = vr0; *(LAS u32x4*)(Vs + (vb) * (64 * GL_VS) + (vrow0 + 32) * GL_VS + 8 * vch) = vr1; } while (0)
        GLA_LOAD(dir ? 63 : 0);
        GLA_STASH(0);
        GLA_LOAD(dir ? 62 : 1);
        LDS_BARRIER();
#pragma unroll 1
        for (int cs = 0; cs < 64; ++cs) {
            const int c = dir ? 63 - cs : cs;
            if (cs > 0) { const int cp = dir ? 64 - cs : cs - 1;
#pragma unroll
                for (int k2 = 0; k2 < 2; ++k2) { const int u = vrow0 + 32 * k2; const u32x4 ov = *(const LAS u32x4*)(Ob + u * GL_VS + 8 * vch);
                    *(u32x4*)(ob + (rowb + cp * 64 + (dir ? 63 - u : u)) * 512 + hh * 128 + 8 * vch) = ov; } }
            float kk[8], bq[8], qv[8];
            unpack8(*(const LAS u32x4*)(Rz + lane * GL_RS + 8 * w), kk); unpack8(*(const LAS u32x4*)(Rq + lane * GL_RS + 8 * w), qv);
            float qh[8], kd[8], kq[8], kt[8];
            if (mixer == 1) {
#pragma unroll
                for (int j = 0; j < 8; ++j) { const float k2 = kk[j] * 0.08838834764831845f; qh[j] = qv[j] * rfa; kd[j] = k2 * rfna; kt[j] = k2 * rfkt; kq[j] = (lane >= 32 ? qh[j] : kd[j]) * re31; }
                if (lane < 8) dec[8 * w + lane] = rdec;
            } else {
#pragma unroll
            for (int j = 0; j < 8; ++j) { const float f = lbv[j] + (1.0f - lbv[j]) * __builtin_amdgcn_rcpf(1.0f + __builtin_amdgcn_exp2f(kk[j] * -1.4426950408889634f)); kk[j] = 1.0f - f; bq[j] = __builtin_amdgcn_logf(f); }
#pragma unroll
            for (int j = 0; j < 8; ++j) bq[j] = wave_scan_incl(bq[j], lane);
#pragma unroll
            for (int j = 0; j < 8; ++j) {
                const float b31 = __builtin_bit_cast(float, __builtin_amdgcn_readlane(__builtin_bit_cast(int, bq[j]), 31));
                const float bl = __builtin_bit_cast(float, __builtin_amdgcn_readlane(__builtin_bit_cast(int, bq[j]), 63));
                const bool up = lane >= 32; const float beta = up ? b31 : 0.f; const float a = bq[j] - beta;
                const float e31 = __builtin_amdgcn_exp2f(b31);
                qh[j] = qv[j] * __builtin_amdgcn_exp2f(a); kd[j] = kk[j] * __builtin_amdgcn_exp2f(fminf(-a, 115.f)); kt[j] = kk[j] * __builtin_amdgcn_exp2f(bl - bq[j]);
                kq[j] = (up ? qh[j] : kd[j]) * e31;
            }
            if (lane == 63) {
                *(LAS f32x4*)(dec + 8 * w) = (f32x4){__builtin_amdgcn_exp2f(bq[0]), __builtin_amdgcn_exp2f(bq[1]), __builtin_amdgcn_exp2f(bq[2]), __builtin_amdgcn_exp2f(bq[3])};
                *(LAS f32x4*)(dec + 8 * w + 4) = (f32x4){__builtin_amdgcn_exp2f(bq[4]), __builtin_amdgcn_exp2f(bq[5]), __builtin_amdgcn_exp2f(bq[6]), __builtin_amdgcn_exp2f(bq[7])}; }
            }
            { const int off = lane * GL_RS + 8 * w;
              *(LAS u32x4*)(Qh + off) = pack8(qh); *(LAS u32x4*)(Kd + off) = pack8(kd); *(LAS u32x4*)(Kt + off) = pack8(kt);
              if (lane < 32) *(LAS u32x4*)(Ko + off) = pack8(kq); else *(LAS u32x4*)(Qt + (lane - 32) * GL_RS + 8 * w) = pack8(kq); }
            LDS_BARRIER();
            if (cs + 1 < 64) { GLA_STASH((cs + 1) & 1); if (cs + 2 < 64) GLA_LOAD(dir ? 61 - cs : cs + 2); }
            const LAS bf16* Vc = Vs + (cs & 1) * (64 * GL_VS);
            if (w < 4) {
                gla_out_tile<0>(Sx + (cs & 1) * (64 * GL_VS), Qh, Qt, Kd, Ko, Vc, Ob, w, r, h, lane);
                const float dl0 = dec[r], dl1 = dec[32 + r];
                LAS bf16* Sn = Sx + ((cs + 1) & 1) * (64 * GL_VS);
#pragma unroll
                for (int i = 0; i < 16; ++i) { st0[i] *= dl0; st1[i] *= dl1; }
#pragma unroll
                for (int ks = 0; ks < 4; ++ks) {
                    const bf16x8 a = tr_frag(Vc, GL_VS, 16 * ks + 8 * h, 16 * ks + 8 * h + 4, 32 * w, lane);
                    const bf16x8 b0 = tr_frag(Kt, GL_RS, 16 * ks + 8 * h, 16 * ks + 8 * h + 4, 0, lane), b1 = tr_frag(Kt, GL_RS, 16 * ks + 8 * h, 16 * ks + 8 * h + 4, 32, lane);
                    st0 = MFMA32(a, b0, st0); st1 = MFMA32(a, b1, st1); }
#pragma unroll
                for (int g4 = 0; g4 < 4; ++g4) {
                    u32x2 w0; w0.x = cvt_pk_bf16(st0[4 * g4], st0[4 * g4 + 1]); w0.y = cvt_pk_bf16(st0[4 * g4 + 2], st0[4 * g4 + 3]); *(LAS u32x2*)(Sn + r * GL_VS + 32 * w + 8 * g4 + 4 * h) = w0;
                    u32x2 w1; w1.x = cvt_pk_bf16(st1[4 * g4], st1[4 * g4 + 1]); w1.y = cvt_pk_bf16(st1[4 * g4 + 2], st1[4 * g4 + 3]); *(LAS u32x2*)(Sn + (32 + r) * GL_VS + 32 * w + 8 * g4 + 4 * h) = w1; }
            } else gla_out_tile<1>(Sx + (cs & 1) * (64 * GL_VS), Qh, Qt, Kd, Ko, Vc, Ob, w & 3, r, h, lane);
            LDS_BARRIER();
        }
        { const int cp = dir ? 0 : 63;
#pragma unroll
          for (int k2 = 0; k2 < 2; ++k2) { const int u = vrow0 + 32 * k2; const u32x4 ov = *(const LAS u32x4*)(Ob + u * GL_VS + 8 * vch);
              *(u32x4*)(ob + (rowb + cp * 64 + (dir ? 63 - u : u)) * 512 + hh * 128 + 8 * vch) = ov; } }
#undef GLA_LOAD
#undef GLA_STASH
    }
}
DI void gla_norm_phase(Frame& F, int l) {
    const bf16* P = (const bf16*)(fws(F) + WS_PROJ); const bf16* Y = (const bf16*)(fout(F) + DO_Y); unsigned char* Y8 = fws(F) + WS_Y8; float* YSC = (float*)(fws(F) + WS_YSC);
    const int gw = F.vcu * 8 + F.wave, NGW = F.G * 8, lane = F.lane;
    const bf16* p0 = gla_partial(F, 0, 0, 0); const bf16* p1 = gla_partial(F, 1, 0, 0);
    const float* ng0 = fin(F, 7) + (size_t)l * 512 + lane * 8; const float* ng1 = fin(F, 9) + (size_t)l * 512 + lane * 8;
    float cwv[3][8];
    { const float* cw = fin(F, 5) + (size_t)l * 3 * 512 + lane * 8;
#pragma unroll
      for (int t3 = 0; t3 < 3; ++t3) { const f32x4 c0 = *(const f32x4*)(cw + t3 * 512), c1 = *(const f32x4*)(cw + t3 * 512 + 4); cwv[t3][0] = c0.x; cwv[t3][1] = c0.y; cwv[t3][2] = c0.z; cwv[t3][3] = c0.w; cwv[t3][4] = c1.x; cwv[t3][5] = c1.y; cwv[t3][6] = c1.z; cwv[t3][7] = c1.w; } }
    for (int tok = gw; tok < T_TOK; tok += NGW) {
        float v[32];
        const u32x4 ya = __builtin_nontemporal_load((const u32x4*)(Y + (size_t)tok * DM + lane * 8));
        const int tl = tok & (SEQ - 1); const bf16* cs = P + (size_t)tok * NPROJ + lane * 8;
        const u32x4 z4 = (u32x4){0u, 0u, 0u, 0u};
        const u32x4 cbw = *(const u32x4*)(cs + C_CB), cc1 = *(const u32x4*)(cs + C_CC), ch1 = *(const u32x4*)(cs + C_CH);
        const u32x4 cc0 = tl > 0 ? *(const u32x4*)(cs - NPROJ + C_CC) : z4, ch0 = tl > 0 ? *(const u32x4*)(cs - NPROJ + C_CH) : z4;
        const u32x4 cc2 = tl < SEQ - 1 ? *(const u32x4*)(cs + NPROJ + C_CC) : z4, ch2 = tl < SEQ - 1 ? *(const u32x4*)(cs + NPROJ + C_CH) : z4;
        u32x4 pa[4], pb[4];
#pragma unroll
        for (int part = 0; part < 4; ++part) { pa[part] = __builtin_nontemporal_load((const u32x4*)(p0 + ((size_t)part * T_TOK + tok) * 512 + lane * 8)); pb[part] = __builtin_nontemporal_load((const u32x4*)(p1 + ((size_t)part * T_TOK + tok) * 512 + lane * 8)); }
        const u32x4 g0 = __builtin_nontemporal_load((const u32x4*)(P + (size_t)tok * NPROJ + C_GO + lane * 8)), g1 = __builtin_nontemporal_load((const u32x4*)(P + (size_t)tok * NPROJ + C_RG + lane * 8));
        { float t8[8]; unpack8(ya, t8);
#pragma unroll
          for (int q = 0; q < 8; ++q) v[q] = t8[q];
          float a0[8], h0[8], a1[8], h1[8], a2[8], h2[8], bq8[8]; unpack8(cc0, a0); unpack8(ch0, h0); unpack8(cc1, a1); unpack8(ch1, h1); unpack8(cc2, a2); unpack8(ch2, h2); unpack8(cbw, bq8);
#pragma unroll
          for (int q = 0; q < 8; ++q) v[8 + q] = bq8[q] * (cwv[0][q] * (a0[q] * h0[q]) + cwv[1][q] * (a1[q] * h1[q]) + cwv[2][q] * (a2[q] * h2[q])); }
#pragma unroll
        for (int mixer = 0; mixer < 2; ++mixer) {
            float o[8];
#pragma unroll
            for (int q = 0; q < 8; ++q) o[q] = 0.f;
#pragma unroll
            for (int part = 0; part < 4; ++part) { float t8[8]; unpack8(mixer == 0 ? pa[part] : pb[part], t8);
#pragma unroll
                for (int q = 0; q < 8; ++q) o[q] += t8[q]; }
            float s1 = 0.f, s2 = 0.f;
#pragma unroll
            for (int q = 0; q < 8; ++q) { s1 += o[q]; s2 += o[q] * o[q]; }
            s1 += sx<1>(s1); s2 += sx<1>(s2); s1 += sx<2>(s1); s2 += sx<2>(s2); s1 += sx<4>(s1); s2 += sx<4>(s2); s1 += sx<8>(s1); s2 += sx<8>(s2);
            float mean = 0.f, rstd;
            if (mixer == 0) rstd = __builtin_amdgcn_rsqf(s2 * (1.f / 128.f) + HN_EPS);
            else { mean = s1 * (1.f / 128.f); const float var = fmaxf(s2 * (1.f / 128.f) - mean * mean, 0.f); rstd = __builtin_amdgcn_rsqf(var + HN_EPS); }
            const float* ng = mixer == 0 ? ng0 : ng1; const f32x4 n0 = *(const f32x4*)ng, n1 = *(const f32x4*)(ng + 4); const float nn[8] = {n0.x, n0.y, n0.z, n0.w, n1.x, n1.y, n1.z, n1.w};
            float gate[8]; unpack8(mixer == 0 ? g0 : g1, gate);
#pragma unroll
            for (int q = 0; q < 8; ++q) v[16 + 8 * mixer + q] = (o[q] - mean) * rstd * nn[q] * siluf_(gate[q]);
        }
        float am = 0.f;
#pragma unroll
        for (int q = 0; q < 32; ++q) am = fmaxf(am, fabsf(v[q]));
        am = wave_max(am); const float inv = am > 0.f ? 127.0f / am : 0.f;
#pragma unroll
        for (int j = 0; j < 4; ++j) { u32x2 w2; w2.x = q8(v[j * 8] * inv) | (q8(v[j * 8 + 1] * inv) << 8) | (q8(v[j * 8 + 2] * inv) << 16) | (q8(v[j * 8 + 3] * inv) << 24);
            w2.y = q8(v[j * 8 + 4] * inv) | (q8(v[j * 8 + 5] * inv) << 8) | (q8(v[j * 8 + 6] * inv) << 16) | (q8(v[j * 8 + 7] * inv) << 24); *(u32x2*)(Y8 + (size_t)tok * DM + lane * 8 + 512 * j) = w2; }
        if (lane == 0) YSC[tok] = am * (1.0f / 127.0f);
    }
}

DI float reduce16(const float (&v)[16], int lane) {
    float a[8];
#pragma unroll
    for (int e = 0; e < 8; ++e) { const bool up = (lane & 32) != 0; const float keep = up ? v[e + 8] : v[e], give = up ? v[e] : v[e + 8]; a[e] = keep + sx32(give, lane); }
    float b4[4];
#pragma unroll
    for (int e = 0; e < 4; ++e) { const bool up = (lane & 16) != 0; const float keep = up ? a[e + 4] : a[e], give = up ? a[e] : a[e + 4]; b4[e] = keep + sx<16>(give); }
    float c2[2];
#pragma unroll
    for (int e = 0; e < 2; ++e) { const bool up = (lane & 8) != 0; const float keep = up ? b4[e + 2] : b4[e], give = up ? b4[e] : b4[e + 2]; c2[e] = keep + sx<8>(give); }
    float d; { const bool up = (lane & 4) != 0; const float keep = up ? c2[1] : c2[0], give = up ? c2[0] : c2[1]; d = keep + sx<4>(give); }
    d += sx<2>(d); d += sx<1>(d);
    return d;
}
constexpr int RW_RS = 2056;
DI void ln1_router_phase(Frame& F, int l, bool dry = false) {
    bf16* H = (bf16*)(fws(F) + WS_H); const unsigned char* MIX = fws(F) + WS_MIX; const float* MSC = (const float*)(fws(F) + WS_MSC);
    const float* g = fin(F, 11) + (size_t)l * DM; const float* bb = fin(F, 12) + (size_t)l * DM; const float* rw = fin(F, 13); const float* rb = fin(F, 14);
    int* EID = (int*)(fws(F) + WS_EID); float* EW = (float*)(fws(F) + WS_EW); int* CNT = (int*)(fws(F) + WS_CNT); unsigned char* H8 = fws(F) + WS_H8; float* HS = (float*)(fws(F) + WS_HS);
    bf16* HO = H; if (dry) { HO = (bf16*)(fws(F) + WS_OB1); H8 = fout(F) + DO_OB; EID = (int*)(fws(F) + WS_Y8); EW = (float*)(fws(F) + WS_Y8 + MiB); CNT = (int*)(fws(F) + WS_Y8 + 2 * MiB); HS = (float*)(fws(F) + WS_Y8 + 3 * MiB); }
    LAS bf16* rwb = (LAS bf16*)F.lds;
    LAS float* gl = (LAS float*)(F.lds + 16 * RW_RS * 2); LAS float* bl = gl + DM;
    LAS int* cnt = (LAS int*)(F.lds + LDSCTL_OFF + 64);
    const int lane = F.lane;
    const float rbe = rb[lane & 15];
    __syncthreads();
    stage_gb(F, g, bb, gl, bl);
    { f32x4 rv[16];
#pragma unroll
      for (int it = 0; it < 16; ++it) rv[it] = *(const f32x4*)(rw + 4 * (F.tid + 512 * it));
#pragma unroll
      for (int it = 0; it < 16; ++it) { const int i = 4 * (F.tid + 512 * it), k = i >> 4, e = i & 15; rwb[e * RW_RS + k] = f2bf(rv[it].x); rwb[(e + 1) * RW_RS + k] = f2bf(rv[it].y); rwb[(e + 2) * RW_RS + k] = f2bf(rv[it].z); rwb[(e + 3) * RW_RS + k] = f2bf(rv[it].w); } }
    for (int ch = F.vcu; ch < 256; ch += F.G) {
        if (F.tid < 16) cnt[F.tid] = 0;
        __syncthreads();
        const int tok0 = ch * 128 + F.wave * 16;
        u32x4 ph[4]; u32x2 pm[4]; float psc[4];
#pragma unroll
        for (int j = 0; j < 4; ++j) { ph[j] = *(const u32x4*)(H + (size_t)tok0 * DM + lane * 8 + 512 * j); pm[j] = __builtin_nontemporal_load((const u32x2*)(MIX + (size_t)tok0 * DM + lane * 8 + 512 * j)); psc[j] = MSC[(size_t)tok0 * 8 + (lane >> 5) + 2 * j]; }
#pragma unroll 1
        for (int ti = 0; ti < 16; ++ti) {
            const int tok = tok0 + ti;
            float v[32]; float s = 0.f;
#pragma unroll
            for (int j = 0; j < 4; ++j) { float a[8], m8[8]; unpack8(ph[j], a); unpack_i8(pm[j], psc[j], m8);
#pragma unroll
                for (int q = 0; q < 8; ++q) { v[j * 8 + q] = ALPHA * a[q] + m8[q]; s += v[j * 8 + q]; } }
            if (ti + 1 < 16) {
#pragma unroll
                for (int j = 0; j < 4; ++j) { ph[j] = *(const u32x4*)(H + (size_t)(tok + 1) * DM + lane * 8 + 512 * j); pm[j] = __builtin_nontemporal_load((const u32x2*)(MIX + (size_t)(tok + 1) * DM + lane * 8 + 512 * j)); psc[j] = MSC[(size_t)(tok + 1) * 8 + (lane >> 5) + 2 * j]; } }
            const float mean = wave_sum(s) * (1.f / DM); float s2 = 0.f;
#pragma unroll
            for (int q = 0; q < 32; ++q) { v[q] -= mean; s2 += v[q] * v[q]; }
            const float rstd = 1.f / sqrtf(wave_sum(s2) * (1.f / DM) + LN_EPS);
            float am = 0.f;
#pragma unroll
            for (int j = 0; j < 4; ++j) { const int c0 = lane * 8 + 512 * j; const f32x4 g0 = *(const LAS f32x4*)(gl + c0), g1 = *(const LAS f32x4*)(gl + c0 + 4), b0 = *(const LAS f32x4*)(bl + c0), b1 = *(const LAS f32x4*)(bl + c0 + 4);
                const float gg[8] = {g0.x, g0.y, g0.z, g0.w, g1.x, g1.y, g1.z, g1.w}, bv[8] = {b0.x, b0.y, b0.z, b0.w, b1.x, b1.y, b1.z, b1.w};
                float o[8];
#pragma unroll
                for (int q = 0; q < 8; ++q) { o[q] = v[j * 8 + q] * rstd * gg[q] + bv[q]; v[j * 8 + q] = o[q]; am = fmaxf(am, fabsf(o[q])); }
                *(u32x4*)(HO + (size_t)tok * DM + c0) = pack8(o); }
            (void)am; (void)HS;
#pragma unroll
            for (int j = 0; j < 4; ++j) { u32x2 w2; w2.x = pg8::pk_fp8x4(v[j * 8] * pg8::ACT_SCALE, v[j * 8 + 1] * pg8::ACT_SCALE, v[j * 8 + 2] * pg8::ACT_SCALE, v[j * 8 + 3] * pg8::ACT_SCALE);
                w2.y = pg8::pk_fp8x4(v[j * 8 + 4] * pg8::ACT_SCALE, v[j * 8 + 5] * pg8::ACT_SCALE, v[j * 8 + 6] * pg8::ACT_SCALE, v[j * 8 + 7] * pg8::ACT_SCALE); *(u32x2*)(H8 + (size_t)tok * DM + lane * 8 + 512 * j) = w2; }
        }
        asm volatile("s_waitcnt vmcnt(0)" ::: "memory");
        f32x4 acc = (f32x4){0.f, 0.f, 0.f, 0.f};
        { const bf16* hrow = HO + (size_t)(tok0 + (lane & 15)) * DM + 8 * (lane >> 4); const LAS bf16* wrow = rwb + (lane & 15) * RW_RS + 8 * (lane >> 4);
#pragma unroll 16
          for (int st = 0; st < 64; ++st) { const bf16x8 a = *(const bf16x8*)(hrow + 32 * st), bq = *(const LAS bf16x8*)(wrow + 32 * st); acc = __builtin_amdgcn_mfma_f32_16x16x32_bf16(a, bq, acc, 0, 0, 0); } }
#pragma unroll
        for (int reg = 0; reg < 4; ++reg) {
            const int tok = tok0 + 4 * (lane >> 4) + reg; const int rowb = lane & 48;
            const float x = acc[reg] + rbe;
            float mx = x;
            mx = fmaxf(mx, sx<1>(mx)); mx = fmaxf(mx, sx<2>(mx)); mx = fmaxf(mx, sx<4>(mx)); mx = fmaxf(mx, sx<8>(mx));
            const float p = __expf(x - mx);
            float qa = -1.f, qc = -1.f;
#pragma unroll
            for (int q = 0; q < 4; ++q) { const float y = shfl_idx(p, (lane & ~3) + q); if (y > qa) { qc = qa; qa = y; } else if (y > qc) qc = y; }
            const float gs = qa + qc;
            int gsel = 0; float gbest = -1.f;
#pragma unroll
            for (int gi = 0; gi < 4; ++gi) { const float y = shfl_idx(gs, rowb + 4 * gi); if (y > gbest) { gbest = y; gsel = gi; } }
            int i1 = 0, i2 = 0; float p1 = -1.f, p2 = -1.f;
#pragma unroll
            for (int q = 0; q < 4; ++q) { const float y = shfl_idx(p, rowb + 4 * gsel + q); if (y > p1) { p2 = p1; i2 = i1; p1 = y; i1 = q; } else if (y > p2) { p2 = y; i2 = q; } }
            if ((lane & 15) == 0) { const float inv = 1.f / (p1 + p2); const int e1 = gsel * 4 + i1, e2 = gsel * 4 + i2;
                EID[tok * 2] = e1; EID[tok * 2 + 1] = e2; EW[tok * 2] = p1 * inv; EW[tok * 2 + 1] = p2 * inv;
                __hip_atomic_fetch_add(cnt + e1, 1, __ATOMIC_RELAXED, __HIP_MEMORY_SCOPE_WORKGROUP); __hip_atomic_fetch_add(cnt + e2, 1, __ATOMIC_RELAXED, __HIP_MEMORY_SCOPE_WORKGROUP); }
        }
        __syncthreads();
        if (F.tid < 16) CNT[ch * 16 + F.tid] = cnt[F.tid];
        __syncthreads();
    }
}
DI void assign_phase(Frame& F) {
    const int* EID = (const int*)(fws(F) + WS_EID); const int* CNT = (const int*)(fws(F) + WS_CNT);
    int* SOT = (int*)(fws(F) + WS_SOT); int* TOS = (int*)(fws(F) + WS_TOS); int* TST = (int*)(fws(F) + WS_TST);
    LAS int* tot = (LAS int*)F.lds;
    LAS int* base = tot + 16;
    LAS int* pre = base + 16;
    LAS int* eids = pre + 16;
    LAS int* part = eids + 256;
    const int tid = F.tid;
    const int e = tid & 15, pp = tid >> 4;
    int cv[8];
#pragma unroll
    for (int k = 0; k < 8; ++k) cv[k] = CNT[(pp * 8 + k) * 16 + e];
    __syncthreads();
    { int s = 0;
#pragma unroll
      for (int k = 0; k < 8; ++k) s += cv[k];
      part[pp * 16 + e] = s; }
    __syncthreads();
    if (tid < 16) { int s = 0; for (int q = 0; q < 32; ++q) s += part[q * 16 + tid]; tot[tid] = s; }
    __syncthreads();
    if (tid == 0) { int acc = 0; for (int q = 0; q < 16; ++q) { base[q] = acc; acc += (tot[q] + 255) & ~255; }
        if (F.bx == 0) { int tacc = 0; for (int q = 0; q < 16; ++q) { TST[q] = tacc; tacc += (tot[q] + 255) >> 8; } TST[16] = tacc; } }
    __syncthreads();
    if (F.bx == 0) { for (int q = 0; q < 16; ++q) { const int lo = base[q] + tot[q], hi = base[q] + ((tot[q] + 255) & ~255); for (int s = lo + tid; s < hi; s += 512) TOS[s] = 0; } }
    for (int ch = F.vcu; ch < 256; ch += F.G) {
        __syncthreads();
        { int s = 0;
#pragma unroll
          for (int k = 0; k < 8; ++k) s += (pp * 8 + k < ch) ? cv[k] : 0;
          part[pp * 16 + e] = s; }
        if (tid < 256) eids[tid] = EID[ch * 256 + tid];
        __syncthreads();
        if (tid < 16) { int s = 0; for (int q = 0; q < 32; ++q) s += part[q * 16 + tid]; pre[tid] = s; }
        __syncthreads();
        if (tid < 256) { const int ee = eids[tid]; int rank = 0; for (int j = 0; j < tid; ++j) rank += (eids[j] == ee) ? 1 : 0;
            const int pos = base[ee] + pre[ee] + rank; const int tok = ch * 128 + (tid >> 1);
            TOS[pos] = tok; SOT[ch * 256 + tid] = pos; }
    }
}
DI void unpack_f8(u32x2 w, float* o) {
    const f32x2 a = __builtin_amdgcn_cvt_pk_f32_fp8((int)w.x, false), b = __builtin_amdgcn_cvt_pk_f32_fp8((int)w.x, true), c = __builtin_amdgcn_cvt_pk_f32_fp8((int)w.y, false), d = __builtin_amdgcn_cvt_pk_f32_fp8((int)w.y, true);
    o[0] = a.x; o[1] = a.y; o[2] = b.x; o[3] = b.y; o[4] = c.x; o[5] = c.y; o[6] = d.x; o[7] = d.y; }
DI void combine_ln2_phase(Frame& F, int l, bool final_out, bool dry = false) {
    bf16* H = (bf16*)(fws(F) + WS_H); const unsigned char* YS = fws(F) + WS_YS;
    const float* g = fin(F, 18) + (size_t)l * DM; const float* bb = fin(F, 19) + (size_t)l * DM;
    const int* SOT = (const int*)(fws(F) + WS_SOT); const float* EW = (const float*)(fws(F) + WS_EW);
    float* OUT = (float*)fout(F); unsigned char* H8 = fws(F) + WS_H8; float* HS = (float*)(fws(F) + WS_HS);
    bf16* HO = H; if (dry) { HO = (bf16*)(fws(F) + WS_OB1); H8 = fws(F) + WS_Y8; HS = (float*)(fws(F) + WS_YSC); final_out = false; }
    const int gw = F.vcu * 8 + F.wave, NGW = F.G * 8, lane = F.lane;
    LAS float* gl = (LAS float*)F.lds; LAS float* bl = gl + DM;
    __syncthreads(); stage_gb(F, g, bb, gl, bl); __syncthreads();
    int s0n = 0, s1n = 0; float w0n = 0.f, w1n = 0.f;
    float w0c = 0.f, w1c = 0.f; u32x4 ph[4]; u32x2 py0[4], py1[4];
    if (gw < T_TOK) { const int s0 = SOT[gw * 2], s1 = SOT[gw * 2 + 1]; w0c = EW[gw * 2]; w1c = EW[gw * 2 + 1];
#pragma unroll
        for (int j = 0; j < 4; ++j) { const int c0 = lane * 8 + 512 * j; ph[j] = *(const u32x4*)(H + (size_t)gw * DM + c0); py0[j] = __builtin_nontemporal_load((const u32x2*)(YS + (size_t)s0 * DM + c0)); py1[j] = __builtin_nontemporal_load((const u32x2*)(YS + (size_t)s1 * DM + c0)); }
        if (gw + NGW < T_TOK) { const int t2 = gw + NGW; s0n = SOT[t2 * 2]; s1n = SOT[t2 * 2 + 1]; w0n = EW[t2 * 2]; w1n = EW[t2 * 2 + 1]; } }
    for (int tok = gw; tok < T_TOK; tok += NGW) {
        const float w0 = w0c * (1.0f / pg8::YS_SCALE), w1 = w1c * (1.0f / pg8::YS_SCALE);
        float v[32]; float s = 0.f;
#pragma unroll
        for (int j = 0; j < 4; ++j) { float a[8], y0[8], y1[8]; unpack8(ph[j], a); unpack_f8(py0[j], y0); unpack_f8(py1[j], y1);
#pragma unroll
            for (int q = 0; q < 8; ++q) { v[j * 8 + q] = ALPHA * a[q] + w0 * y0[q] + w1 * y1[q]; s += v[j * 8 + q]; } }
        if (tok + NGW < T_TOK) { const int t1 = tok + NGW; const int s0 = s0n, s1 = s1n; w0c = w0n; w1c = w1n;
#pragma unroll
            for (int j = 0; j < 4; ++j) { const int c0 = lane * 8 + 512 * j; ph[j] = *(const u32x4*)(H + (size_t)t1 * DM + c0); py0[j] = __builtin_nontemporal_load((const u32x2*)(YS + (size_t)s0 * DM + c0)); py1[j] = __builtin_nontemporal_load((const u32x2*)(YS + (size_t)s1 * DM + c0)); }
            if (t1 + NGW < T_TOK) { const int t2 = t1 + NGW; s0n = SOT[t2 * 2]; s1n = SOT[t2 * 2 + 1]; w0n = EW[t2 * 2]; w1n = EW[t2 * 2 + 1]; } }
        const float mean = wave_sum(s) * (1.f / DM); float s2 = 0.f;
#pragma unroll
        for (int q = 0; q < 32; ++q) { v[q] -= mean; s2 += v[q] * v[q]; }
        const float rstd = 1.f / sqrtf(wave_sum(s2) * (1.f / DM) + LN_EPS);
#pragma unroll
        for (int j = 0; j < 4; ++j) { const int c0 = lane * 8 + 512 * j; const f32x4 g0 = *(const LAS f32x4*)(gl + c0), g1 = *(const LAS f32x4*)(gl + c0 + 4), b0 = *(const LAS f32x4*)(bl + c0), b1 = *(const LAS f32x4*)(bl + c0 + 4);
            const float gg[8] = {g0.x, g0.y, g0.z, g0.w, g1.x, g1.y, g1.z, g1.w}, bv[8] = {b0.x, b0.y, b0.z, b0.w, b1.x, b1.y, b1.z, b1.w};
            float o[8];
#pragma unroll
            for (int q = 0; q < 8; ++q) { o[q] = v[j * 8 + q] * rstd * gg[q] + bv[q]; v[j * 8 + q] = o[q]; }
            if (final_out) { __builtin_nontemporal_store((f32x4){o[0], o[1], o[2], o[3]}, (f32x4*)(OUT + (size_t)tok * DM + c0)); __builtin_nontemporal_store((f32x4){o[4], o[5], o[6], o[7]}, (f32x4*)(OUT + (size_t)tok * DM + c0 + 4)); }
            else *(u32x4*)(HO + (size_t)tok * DM + c0) = pack8(o); }
        if (!final_out) { float am = 0.f;
#pragma unroll
            for (int q = 0; q < 32; ++q) am = fmaxf(am, fabsf(v[q]));
            am = wave_max(am); const float inv = am > 0.f ? 127.0f / am : 0.f;
#pragma unroll
            for (int j = 0; j < 4; ++j) { u32x2 w2; w2.x = q8(v[j * 8] * inv) | (q8(v[j * 8 + 1] * inv) << 8) | (q8(v[j * 8 + 2] * inv) << 16) | (q8(v[j * 8 + 3] * inv) << 24);
                w2.y = q8(v[j * 8 + 4] * inv) | (q8(v[j * 8 + 5] * inv) << 8) | (q8(v[j * 8 + 6] * inv) << 16) | (q8(v[j * 8 + 7] * inv) << 24); *(u32x2*)(H8 + (size_t)tok * DM + lane * 8 + 512 * j) = w2; }
            if (lane == 0) HS[tok] = am * (1.0f / 127.0f); }
    }
}

constexpr int PH_PER_LAYER = 9, N_PHASES = 2 + DEPTH * PH_PER_LAYER;
#ifndef PH_MASK
#define PH_MASK 0xFFFFFFFFu
#endif
#define PHM(b) ((PH_MASK >> (b)) & 1u)
#define REP(b) _Pragma("unroll") for (int rep_ = 0; rep_ < 1 + (int)((PH_DUP >> (b)) & 1u); ++rep_)
__global__ void __launch_bounds__(512, 2) mk_fwd(Args args) {
    extern __shared__ __attribute__((aligned(16))) unsigned char lds_raw[];
    Frame F;
    F.lds = (LAS unsigned char*)lds_raw;
    F.wave0 = __builtin_amdgcn_readfirstlane((int)threadIdx.x >> 6);
    frame_refresh(F);
    volatile LAS unsigned* MISC = (volatile LAS unsigned*)(F.lds + MISC_OFF);
    for (int u = F.tid; u < (LDS_BYTES - LDSCTL_OFF) / 4; u += 512) ((LAS unsigned*)(F.lds + LDSCTL_OFF))[u] = 0u;
    __syncthreads();
    unsigned* ctl = (unsigned*)(fws(F) + WS_CTL);
    XcdBarrier bar; bar.bar = ctl + CW_BAR; bar.x = 0; bar.st = nullptr;
    const int lo = args.ph_lo, hi = args.ph_hi;
    const bool multi = (hi - lo) > 1;
    if (multi) bar = xcd_barrier_post(ctl + CW_BAR, MISC + 8);
#define IN(k) (frame_refresh(F), (lo <= (k) && (k) < hi))
#define SEAM(k) do { if (lo <= (k) && (k) + 1 < hi) { _Pragma("unroll") for (int rb_ = 0; rb_ < 1 + (int)((PH_DUP >> 16) & 1u); ++rb_) { XcdBarrier b2_ = bar; asm volatile("" : "+s"(b2_.bar)); xcd_barrier(b2_); } } } while (0)
    if (IN(0) && PHM(0)) {
        REP(0) wabs_phase(F, 0);
        wabs_phase(F, 1);
        REP(14) ln_emb(F);
        if (F.bx == 0) { float* LB = (float*)(fws(F) + WS_TST + 128); const float* hl = fin(F, 6); for (int d = F.tid; d < 512; d += 512) LB[d] = 1.0f / (1.0f + __expf(hl[d] - hl[512 + d])); }
    }
    SEAM(0);
    if (IN(1) && PHM(0)) { REP(15) { convert_weights(F, 0, 0); __syncthreads(); } }
    SEAM(1);
#pragma unroll 1
    for (int l = 0; l < DEPTH; ++l) {
        const int p0 = 2 + l * PH_PER_LAYER;
        const float* lbp = (l == 0) ? nullptr : (const float*)(fws(F) + WS_TST + 128);
        if (IN(p0 + 0) && PHM(1)) REP(1) {
            const float* ABS = (const float*)(fws(F) + WS_CTL + CTL_ABS) + (size_t)l * ABS_PER_LAYER;
            const int Gw = (l == 0) ? gemm_workers(F.G, UNITS_IN) : F.G;
            if (F.bx < Gw) {
                pg8::Gemm g{(const bf16*)(fws(F) + WS_H8), (const bf16*)(fws(F) + (size_t)l * WS_WSET + WS_WIN), DM / 2}; pg8::StaticOrder S; S.init(T_TOK / 256, NPROJ / 256, Gw, F.bx);
                pg8::EpiBf16Q E{(bf16*)(fws(F) + WS_PROJ), NPROJ, (const float*)(fws(F) + WS_HS), ABS + ABS_IN};
                pg8::gemm_phase<pg8::EpiBf16Q, pg8::StaticOrder, false>(F.lds, F.tid, g, S, E, nullptr);
            } else helper_convert(F, Gw, 0, helper_items_a(F.G), false);
        }
        SEAM(p0 + 0);
        if (IN(p0 + 1)) { if (PHM(4)) REP(4) gla_seq_phase(F, l, lbp); if (PHM(2)) REP(2) attn_phase(F, l); }
        SEAM(p0 + 1);
        if (IN(p0 + 2) && PHM(5)) REP(5) gla_norm_phase(F, l);
        SEAM(p0 + 2);
        if (IN(p0 + 3) && PHM(7)) REP(7) {
            __syncthreads();
            const float* ABS = (const float*)(fws(F) + WS_CTL + CTL_ABS) + (size_t)l * ABS_PER_LAYER;
            pg8::Gemm g{(const bf16*)(fws(F) + WS_Y8), (const bf16*)(fws(F) + (size_t)l * WS_WSET + WS_WOUT), DM / 2}; pg8::StaticOrder S; S.init(T_TOK / 256, DM / 256, F.G, F.bx);
            pg8::EpiI8Tile<true> E{fws(F) + WS_MIX, DM, (float*)(fws(F) + WS_MSC), 8, (const float*)(fws(F) + WS_YSC), ABS + ABS_OUT, (LAS float*)(F.lds + RING_BYTES)};
            pg8::gemm_phase<pg8::EpiI8Tile<true>, pg8::StaticOrder, false>(F.lds, F.tid, g, S, E, nullptr);
        }
        SEAM(p0 + 3);
        if (IN(p0 + 4) && PHM(8)) {
#pragma unroll 1
            for (int rep_ = 0; rep_ < 1 + (int)((PH_DUP >> 8) & 1u); ++rep_) ln1_router_phase(F, l, rep_ == 1); }
        SEAM(p0 + 4);
        if (IN(p0 + 5) && PHM(9)) REP(9) assign_phase(F);
        SEAM(p0 + 5);
        if (IN(p0 + 6) && PHM(10)) REP(10) {
            __syncthreads();
            const int* TST = (const int*)(fws(F) + WS_TST);
            const float* ABS = (const float*)(fws(F) + WS_CTL + CTL_ABS) + (size_t)l * ABS_PER_LAYER;
            const int ntile = __builtin_amdgcn_readfirstlane(TST[16]); const int Gw = (l == 0) ? gemm_workers(F.G, ntile * 8) : F.G; (void)ABS;
            if (F.bx < Gw) {
                pg8::Gemm g{(const bf16*)(fws(F) + WS_H8), (const bf16*)(fws(F) + (size_t)l * WS_WSET + WS_WGU), DM / 2}; pg8::MoeOrder S; S.init(ntile, 8, Gw, F.bx); S.tile_start = TST; S.expert_stride = (size_t)2048 * DM;
                pg8::EpiSwiGLUF8 E{fws(F) + WS_HID, DEXP, (const float*)(fws(F) + WS_GUS) + l * 2 * NEXP, TST};
                pg8::gemm_phase<pg8::EpiSwiGLUF8, pg8::MoeOrder, true>(F.lds, F.tid, g, S, E, (const int*)(fws(F) + WS_TOS));
            } else helper_convert(F, Gw, helper_items_a(F.G), helper_items_bc(F.G, ntile * 8, HQ_B), false);
        }
        SEAM(p0 + 6);
        if (IN(p0 + 7) && PHM(11)) REP(11) {
            const int* TST = (const int*)(fws(F) + WS_TST);
            const int ntile = __builtin_amdgcn_readfirstlane(TST[16]); const int Gw = (l == 0) ? gemm_workers(F.G, ntile * 8) : F.G;
            if (F.bx < Gw) {
                pg8::Gemm g{(const bf16*)(fws(F) + WS_HID), (const bf16*)(fws(F) + (size_t)l * WS_WSET + WS_WD), DEXP / 2}; pg8::MoeOrder S; S.init(ntile, 8, Gw, F.bx); S.tile_start = TST; S.expert_stride = (size_t)DM * DEXP;
                pg8::EpiF8Out E{fws(F) + WS_YS, DM, (const float*)(fws(F) + WS_WDS) + l * NEXP, TST};
                pg8::gemm_phase<pg8::EpiF8Out, pg8::MoeOrder, false>(F.lds, F.tid, g, S, E, nullptr);
            } else helper_convert(F, Gw, helper_items_a(F.G) + helper_items_bc(F.G, ntile * 8, HQ_B), helper_items_bc(F.G, ntile * 8, HQ_C), false);
        }
        SEAM(p0 + 7);
        if (IN(p0 + 8)) { if (PHM(12)) { if ((PH_DUP >> 12) & 1u) combine_ln2_phase(F, l, false, true); combine_ln2_phase(F, l, l == DEPTH - 1); } if (PHM(13) && l + 1 < DEPTH) { __syncthreads();
            const int nt8 = ((const int*)(fws(F) + WS_TST))[16] * 8; const int done = helper_items_a(F.G) + helper_items_bc(F.G, nt8, HQ_B) + helper_items_bc(F.G, nt8, HQ_C);
            convert_weights(F, l + 1, done < CV_N ? done : CV_N); } }
        if (l + 1 < DEPTH) SEAM(p0 + 8);
    }
#undef IN
#undef SEAM
}

extern "C" void kernel_launch(void* const* d_in, const int* in_sizes, int n_in, void* d_out, int out_size, void* d_ws, size_t ws_size, hipStream_t stream) {
    static int grid = 0;
    if (grid == 0) {
        if (n_in != 20 || out_size != T_TOK * DM || ws_size < WS_END) { fprintf(stderr, "kernel_launch: unexpected shapes (n_in %d out %d ws %zu)\n", n_in, out_size, ws_size); grid = -1; return; }
        int dev = 0, cus = 0;
        if (hipGetDevice(&dev) != hipSuccess || hipDeviceGetAttribute(&cus, hipDeviceAttributeMultiprocessorCount, dev) != hipSuccess) { grid = -1; return; }
        if (hipFuncSetAttribute((const void*)mk_fwd, hipFuncAttributeMaxDynamicSharedMemorySize, LDS_BYTES) != hipSuccess) { fprintf(stderr, "kernel_launch: hipFuncSetAttribute failed\n"); grid = -1; return; }
        int per_cu = 0;
        if (hipOccupancyMaxActiveBlocksPerMultiprocessor(&per_cu, (const void*)mk_fwd, 512, LDS_BYTES) != hipSuccess || per_cu < 1) fprintf(stderr, "kernel_launch: occupancy query reports %d\n", per_cu);
        (void)hipGetLastError();
        grid = cus;
    }
    if (grid < 0) return;
    (void)hipMemsetAsync((char*)d_ws + WS_CTL, 0, CTL_ZERO_BYTES, stream);
    Args a{};
    for (int i = 0; i < 20; ++i) a.in[i] = (const float*)d_in[i];
    a.out = (float*)d_out; a.ws = (unsigned char*)d_ws;
#if MK_ONE_LAUNCH
    a.ph_lo = 0; a.ph_hi = N_PHASES;
    hipLaunchKernelGGL(mk_fwd, dim3(grid), dim3(512), LDS_BYTES, stream, a);
#else
    for (int p = 0; p < N_PHASES; ++p) { a.ph_lo = p; a.ph_hi = p + 1; hipLaunchKernelGGL(mk_fwd, dim3(grid), dim3(512), LDS_BYTES, stream, a); }
#endif
}
```

```cpp
#include <hip/hip_runtime.h>
#ifndef PH_DUP
#define PH_DUP 0u
#endif
#include <cstdio>
#include <cstdint>

#ifndef MK_ONE_LAUNCH
#define MK_ONE_LAUNCH 1
#endif

#define LAS __attribute__((address_space(3)))
#define GAS __attribute__((address_space(1)))
typedef unsigned short bf16;
typedef short bf16x8 __attribute__((ext_vector_type(8)));
typedef short s16x4 __attribute__((ext_vector_type(4)));
typedef float f32x2 __attribute__((ext_vector_type(2)));
typedef float f32x4 __attribute__((ext_vector_type(4)));
typedef float f32x16 __attribute__((ext_vector_type(16)));
typedef unsigned u32x2 __attribute__((ext_vector_type(2)));
typedef unsigned u32x4 __attribute__((ext_vector_type(4)));
#define DI __device__ __forceinline__

constexpr int T_TOK = 32768, DM = 2048, SEQ = 4096, NBATCH = 8, NPROJ = 6912, NEXP = 16, DEXP = 1024, DEPTH = 2;
constexpr int SLOT_CAP = 69632;
constexpr float LN_EPS = 1e-5f, HN_EPS = 1e-6f, ALPHA = 1.41421356237f;
constexpr int C_AQ = 0, C_AK = 512, C_AV = 640, C_CB = 768, C_CC = 1280, C_CH = 1792, C_GQ = 2304, C_GZF = 2816, C_GZB = 3328, C_GI = 3840, C_GO = 4352,
              C_RQ = 4864, C_RK = 5376, C_RV = 5888, C_RG = 6400;

constexpr size_t MiB = 1u << 20, KiB = 1u << 10;
constexpr size_t WS_CTL = 0, CTL_ZERO_BYTES = 1 * MiB;
constexpr size_t WS_EID = 1 * MiB, WS_EW = WS_EID + 256 * KiB, WS_SOT = WS_EW + 256 * KiB, WS_TOS = WS_SOT + 256 * KiB, WS_CNT = WS_TOS + 272 * KiB, WS_TST = WS_CNT + 16 * KiB;
constexpr size_t WS_WDS = WS_TST + 3072;
constexpr size_t WS_GUS = WS_WDS + 128;
constexpr size_t WS_HS = 3 * MiB, WS_YSC = WS_HS + 128 * KiB;
constexpr size_t WS_WIN = 8 * MiB, WS_WOUT = 22 * MiB, WS_WGU = 26 * MiB, WS_WD = 90 * MiB;
constexpr size_t WS_H8 = 154 * MiB;
constexpr size_t WS_H = 235 * MiB, WS_PROJ = 363 * MiB, WS_OB1 = 795 * MiB, WS_Y8 = 923 * MiB, WS_END = 987 * MiB;
constexpr size_t WS_MIX = WS_PROJ, WS_MSC = WS_PROJ + 64 * MiB, WS_HID = WS_PROJ, WS_YS = WS_PROJ + 136 * MiB, WS_YSS = WS_YS + 136 * MiB;
static_assert(WS_TST + 4096 <= WS_HS && WS_YSC + 128 * KiB <= WS_WIN, "ws map");
static_assert(WS_WIN + (size_t)NPROJ * DM <= WS_WOUT && WS_WOUT + (size_t)DM * DM <= WS_WGU && WS_WGU + (size_t)NEXP * 2048 * DM <= WS_WD && WS_WD + (size_t)NEXP * DM * DEXP * 2 <= WS_H8 && WS_H8 + (size_t)T_TOK * DM <= WS_H, "ws map");
static_assert(WS_H + (size_t)T_TOK * DM * 2 <= WS_PROJ && WS_PROJ + (size_t)T_TOK * NPROJ * 2 <= WS_OB1 && WS_YSS + (size_t)SLOT_CAP * 8 * 4 <= WS_OB1 && WS_YS + (size_t)SLOT_CAP * DM <= WS_YSS && WS_MSC + (size_t)T_TOK * 8 * 4 <= WS_YS && WS_HID + (size_t)SLOT_CAP * DEXP * 2 <= WS_YS, "ws map");
constexpr size_t CTL_ABS = 64 * KiB; constexpr int ABS_IN = 0, ABS_OUT = NPROJ, ABS_GU = NPROJ + DM, ABS_PER_LAYER = NPROJ + DM + NEXP * 2048;
static_assert(CTL_ABS + (size_t)2 * ABS_PER_LAYER * 4 <= CTL_ZERO_BYTES, "ctl map");
constexpr size_t DO_Y = 0, DO_OB = 128 * MiB;
constexpr int CW_BAR = 4096;

constexpr int RING_BYTES = 131072, LDSCTL_OFF = 147456, MISC_OFF = LDSCTL_OFF + 320, LDS_BYTES = 148480;

typedef __bf16 bf16x2_t __attribute__((ext_vector_type(2)));
DI unsigned cvt_pk_bf16(float lo, float hi) { const f32x2 v = {lo, hi}; const bf16x2_t b = __builtin_convertvector(v, bf16x2_t); return __builtin_bit_cast(unsigned, b); }
DI float bf_lo(unsigned w) { return __uint_as_float(w << 16); }
DI float bf_hi(unsigned w) { return __uint_as_float(w & 0xffff0000u); }
DI float bf2f(bf16 b) { return __uint_as_float(((unsigned)b) << 16); }
DI bf16 f2bf(float f) { return (bf16)(cvt_pk_bf16(f, 0.f) & 0xffffu); }
DI int lane_fresh() { unsigned z = 0u; asm volatile("" : "+s"(z)); int ln = (int)__builtin_amdgcn_mbcnt_hi(~0u, __builtin_amdgcn_mbcnt_lo(~0u, z)); return ln; }
DI float shfl_idx(float v, int src_lane) { return __builtin_bit_cast(float, __builtin_amdgcn_ds_bpermute(src_lane << 2, __builtin_bit_cast(int, v))); }
template <int M> DI float sx(float v) { static_assert(M >= 1 && M < 32, "swizzle mask"); return __builtin_bit_cast(float, __builtin_amdgcn_ds_swizzle(__builtin_bit_cast(int, v), (M << 10) | 0x1f)); }
DI float sum32(float v) { return v + __builtin_bit_cast(float, __builtin_amdgcn_ds_bpermute((lane_fresh() ^ 32) << 2, __builtin_bit_cast(int, v))); }
DI float max32(float v) { return fmaxf(v, __builtin_bit_cast(float, __builtin_amdgcn_ds_bpermute((lane_fresh() ^ 32) << 2, __builtin_bit_cast(int, v)))); }
DI float sx32(float v, int lane) { return __builtin_bit_cast(float, __builtin_amdgcn_ds_bpermute((lane ^ 32) << 2, __builtin_bit_cast(int, v))); }
DI float wave_sum(float v) { v += sx<1>(v); v += sx<2>(v); v += sx<4>(v); v += sx<8>(v); v += sx<16>(v); return sum32(v); }
DI float wave_max(float v) { v = fmaxf(v, sx<1>(v)); v = fmaxf(v, sx<2>(v)); v = fmaxf(v, sx<4>(v)); v = fmaxf(v, sx<8>(v)); v = fmaxf(v, sx<16>(v)); return max32(v); }
DI float sigmoidf_(float z) { return __builtin_amdgcn_rcpf(1.0f + __expf(-z)); }
DI float siluf_(float z) { return z * __builtin_amdgcn_rcpf(1.0f + __expf(-z)); }
DI void unpack8(const u32x4 w, float (&f)[8]) { f[0] = bf_lo(w.x); f[1] = bf_hi(w.x); f[2] = bf_lo(w.y); f[3] = bf_hi(w.y); f[4] = bf_lo(w.z); f[5] = bf_hi(w.z); f[6] = bf_lo(w.w); f[7] = bf_hi(w.w); }
DI void unpack_i8(const u32x2 w, float sc, float (&f)[8]) {
#pragma unroll
    for (int k = 0; k < 4; ++k) { f[k] = (float)((int)(w.x << (24 - 8 * k)) >> 24) * sc; f[4 + k] = (float)((int)(w.y << (24 - 8 * k)) >> 24) * sc; }
}
DI u32x4 pack8(const float (&f)[8]) { u32x4 w; w.x = cvt_pk_bf16(f[0], f[1]); w.y = cvt_pk_bf16(f[2], f[3]); w.z = cvt_pk_bf16(f[4], f[5]); w.w = cvt_pk_bf16(f[6], f[7]); return w; }
DI int crow(int i, int h) { return (i & 3) + 8 * (i >> 2) + 4 * h; }
#define LDS_WAIT() asm volatile("s_waitcnt lgkmcnt(0)" ::: "memory")
#define VM_WAIT() asm volatile("s_waitcnt vmcnt(0)" ::: "memory")
#define MFMA32(a, b, c) __builtin_amdgcn_mfma_f32_32x32x16_bf16((a), (b), (c), 0, 0, 0)

namespace pg8 {
typedef unsigned short bf16_t;
constexpr int BM = 256, BK = 64, HALF = 128, HTB = HALF * BK * 2, STAGE_BYTES = 8 * HTB, NXCD = 8, WGM = 8;
__host__ __device__ __forceinline__ int lds_byte(int r, int c) { const int st = (r >> 4) * 2 + (c >> 5), rr = r & 15, cc = c & 31, ob = rr * 64 + cc * 2; return st * 1024 + (ob ^ (((ob >> 9) & 1) << 5)); }
__host__ __device__ __forceinline__ void stage_rc(int b, int& R, int& C) { const int st = b / 1024, sb = b % 1024, swz = sb ^ (((sb >> 9) & 1) << 5); R = (st >> 1) * 16 + swz / 64; C = (st & 1) * 32 + (swz % 64) / 2; }
__host__ __device__ __forceinline__ int perm32(int rho) { const int n = rho >> 4, i = rho & 15; return 8 * (i >> 2) + 4 * n + (i & 3); }

struct Unit { int pm, pn; };
struct Gemm { const bf16_t* A; const bf16_t* Bt; int K; };

struct StaticOrder {
    int nM, nN, nwg, G, c;
    DI void init(int nM_, int nN_, int G_, int c_) { nM = nM_; nN = nN_; nwg = nM * nN; G = G_; c = c_; }
    DI bool next(int i, Unit& u) const {
        const long L = (long)i * G + c; if (L >= nwg) return false;
        int wgid = (int)L; { const int q = nwg / NXCD, r = nwg % NXCD, xcd = wgid % NXCD, off = wgid / NXCD; wgid = (xcd < r ? xcd * (q + 1) : r * (q + 1) + (xcd - r) * q) + off; }
        const int nig = WGM * nN, gid = wgid / nig, fm = gid * WGM, gsz = (nM - fm) < WGM ? (nM - fm) : WGM;
        u.pm = fm + ((wgid % nig) % gsz); u.pn = (wgid % nig) / gsz; return true;
    }
    DI size_t b_off(const Unit& u, size_t tstep) const { return (size_t)u.pn * tstep; }
};
struct MoeOrder : StaticOrder {
    const int* tile_start; size_t expert_stride;
    DI bool next(int i, Unit& u) const { Unit t; const bool ok = StaticOrder::next(i, t); u.pm = __builtin_amdgcn_readfirstlane(t.pm); u.pn = __builtin_amdgcn_readfirstlane(t.pn); return ok; }
    DI size_t b_off(const Unit& u, size_t tstep) const {
        int e = 0;
#pragma unroll
        for (int j = 1; j < 16; ++j) e += (u.pm >= tile_start[j]) ? 1 : 0;
        e = __builtin_amdgcn_readfirstlane(e);
        return (size_t)e * expert_stride + (size_t)u.pn * tstep;
    }
};

typedef int i32x4 __attribute__((ext_vector_type(4)));
DI unsigned q8f(float x) { return (unsigned)(int)__builtin_rintf(x) & 0xffu; }
struct EpiBf16Q {
    static constexpr bool PERM = true, I8 = true, F8 = false;
    bf16_t* O; int ldc; const float* sa; const float* sb;
    DI void operator()(const f32x4 (&acc)[2][2][4][2], const Unit& u, int wr, int wc, int fr, int fq) const {
        const int row0 = u.pm * BM + wr * 64 + fr; const int col0 = u.pn * BM + wc * 32 + 8 * fq;
        f32x4 bv[2][2];
#pragma unroll
        for (int bj = 0; bj < 2; ++bj)
#pragma unroll
            for (int n = 0; n < 2; ++n) bv[bj][n] = *(const f32x4*)(sb + col0 + bj * HALF + 4 * n) * (1.0f / 127.0f);
#pragma unroll
        for (int ai = 0; ai < 2; ++ai)
#pragma unroll
            for (int m = 0; m < 4; ++m) { const int row = row0 + ai * HALF + m * 16; const float ra = sa[row]; bf16_t* rowp = O + (size_t)row * ldc + col0;
#pragma unroll
                for (int bj = 0; bj < 2; ++bj) { const f32x4 v0 = __builtin_convertvector(__builtin_bit_cast(i32x4, acc[ai][bj][m][0]), f32x4) * (bv[bj][0] * ra), v1 = __builtin_convertvector(__builtin_bit_cast(i32x4, acc[ai][bj][m][1]), f32x4) * (bv[bj][1] * ra);
                    u32x4 w; w.x = cvt_pk_bf16(v0[0], v0[1]); w.y = cvt_pk_bf16(v0[2], v0[3]); w.z = cvt_pk_bf16(v1[0], v1[1]); w.w = cvt_pk_bf16(v1[2], v1[3]);
                    *(u32x4*)(rowp + bj * HALF) = w; } }
    }
};
typedef int i32x8 __attribute__((ext_vector_type(8)));
constexpr float ACT_SCALE = 16.0f;
constexpr float HID_SCALE = 8.0f;
DI unsigned pk_fp8x4(float a, float b, float c, float d) {
    a = __builtin_amdgcn_fmed3f(a, -448.f, 448.f); b = __builtin_amdgcn_fmed3f(b, -448.f, 448.f); c = __builtin_amdgcn_fmed3f(c, -448.f, 448.f); d = __builtin_amdgcn_fmed3f(d, -448.f, 448.f);
    int w = __builtin_amdgcn_cvt_pk_fp8_f32(a, b, 0, false); w = __builtin_amdgcn_cvt_pk_fp8_f32(c, d, w, true); return (unsigned)w; }
struct EpiSwiGLUF8 {
    static constexpr bool PERM = true, I8 = false, F8 = true;
    unsigned char* O; int ldc; const float* gus; const int* tile_start;
    DI void operator()(const f32x4 (&acc)[2][2][4][2], const Unit& u, int wr, int wc, int fr, int fq) const {
        int e = 0;
#pragma unroll
        for (int j = 1; j < 16; ++j) e += (u.pm >= tile_start[j]) ? 1 : 0;
        const float mg = gus[2 * e], mu = gus[2 * e + 1] * HID_SCALE;
        const int row0 = u.pm * BM + wr * 64 + fr; const int col0 = u.pn * HALF + wc * 32 + 8 * fq;
#pragma unroll
        for (int ai = 0; ai < 2; ++ai)
#pragma unroll
            for (int m = 0; m < 4; ++m) { unsigned char* rowp = O + (size_t)(row0 + ai * HALF + m * 16) * ldc + col0;
                float o[8];
#pragma unroll
                for (int n = 0; n < 2; ++n)
#pragma unroll
                    for (int j = 0; j < 4; ++j) { const float g = acc[ai][0][m][n][j] * mg; o[n * 4 + j] = g * __builtin_amdgcn_rcpf(1.0f + __expf(-g)) * (acc[ai][1][m][n][j] * mu); }
                u32x2 w; w.x = pk_fp8x4(o[0], o[1], o[2], o[3]); w.y = pk_fp8x4(o[4], o[5], o[6], o[7]);
                *(u32x2*)rowp = w; }
    }
};
struct EpiSwiGLUQ {
    static constexpr bool PERM = true, I8 = true, F8 = false;
    unsigned char* O; int ldc; const float* sa; const float* sb; const int* rowmap; const int* tile_start;
    DI void operator()(const f32x4 (&acc)[2][2][4][2], const Unit& u, int wr, int wc, int fr, int fq) const {
        int e = 0;
#pragma unroll
        for (int j = 1; j < 16; ++j) e += (u.pm >= tile_start[j]) ? 1 : 0;
        const int row0 = u.pm * BM + wr * 64 + fr; const int col0 = u.pn * HALF + wc * 32 + 8 * fq, bcol0 = e * 2048 + u.pn * BM + wc * 32 + 8 * fq;
        f32x4 bv[2][2];
#pragma unroll
        for (int bj = 0; bj < 2; ++bj)
#pragma unroll
            for (int n = 0; n < 2; ++n) bv[bj][n] = *(const f32x4*)(sb + bcol0 + bj * HALF + 4 * n) * (1.0f / 127.0f);
#pragma unroll
        for (int ai = 0; ai < 2; ++ai)
#pragma unroll
            for (int m = 0; m < 4; ++m) { const int row = row0 + ai * HALF + m * 16; const float ra = sa[rowmap[row]]; unsigned char* rowp = O + (size_t)row * ldc + col0;
                float o[8];
#pragma unroll
                for (int n = 0; n < 2; ++n) { const f32x4 gv = __builtin_convertvector(__builtin_bit_cast(i32x4, acc[ai][0][m][n]), f32x4) * (bv[0][n] * ra), uv = __builtin_convertvector(__builtin_bit_cast(i32x4, acc[ai][1][m][n]), f32x4) * (bv[1][n] * ra);
#pragma unroll
                    for (int j = 0; j < 4; ++j) { const float g = gv[j]; o[n * 4 + j] = g * __builtin_amdgcn_rcpf(1.0f + __expf(-g)) * (uv[j] * HID_SCALE); } }
                u32x2 w; w.x = pk_fp8x4(o[0], o[1], o[2], o[3]); w.y = pk_fp8x4(o[4], o[5], o[6], o[7]);
                *(u32x2*)rowp = w; }
    }
};
template <bool QIN, bool F8IN = false> struct EpiI8Tile {
    static constexpr bool PERM = true, I8 = QIN, F8 = F8IN;
    unsigned char* O8; int ldc; float* SC; int ntile; const float* sa; const float* sb; LAS float* xch; const float* wds; const int* tile_start;
    DI void operator()(const f32x4 (&acc)[2][2][4][2], const Unit& u, int wr, int wc, int fr, int fq) const {
        const int row0 = u.pm * BM + wr * 64 + fr; const int col0 = u.pn * BM + wc * 32 + 8 * fq;
        float mul = 1.0f / 127.0f;
        if constexpr (F8IN) { int e = 0;
#pragma unroll
            for (int j = 1; j < 16; ++j) e += (u.pm >= tile_start[j]) ? 1 : 0;
            mul *= wds[e]; }
        f32x4 bv[2][2];
        if constexpr (QIN) {
#pragma unroll
            for (int bj = 0; bj < 2; ++bj)
#pragma unroll
                for (int n = 0; n < 2; ++n) bv[bj][n] = *(const f32x4*)(sb + col0 + bj * HALF + 4 * n) * (1.0f / 127.0f); }
        f32x4 v[2][4][2][2]; float lmax[2][4];
#pragma unroll
        for (int ai = 0; ai < 2; ++ai)
#pragma unroll
            for (int m = 0; m < 4; ++m) { float ra = 1.f; if constexpr (QIN) ra = sa[row0 + ai * HALF + m * 16]; float mx = 0.f;
#pragma unroll
                for (int bj = 0; bj < 2; ++bj)
#pragma unroll
                    for (int n = 0; n < 2; ++n) { f32x4 x; if constexpr (QIN) x = __builtin_convertvector(__builtin_bit_cast(i32x4, acc[ai][bj][m][n]), f32x4) * (bv[bj][n] * ra); else x = acc[ai][bj][m][n];
                        v[ai][m][bj][n] = x; mx = fmaxf(mx, fmaxf(fmaxf(fabsf(x[0]), fabsf(x[1])), fmaxf(fabsf(x[2]), fabsf(x[3])))); }
                mx = fmaxf(mx, sx<16>(mx)); mx = max32(mx);
                lmax[ai][m] = mx;
                if (fq == 0) xch[(ai * HALF + wr * 64 + m * 16 + fr) * 4 + wc] = mx; }
        asm volatile("s_waitcnt lgkmcnt(0)\n\ts_barrier" ::: "memory");
#pragma unroll
        for (int ai = 0; ai < 2; ++ai)
#pragma unroll
            for (int m = 0; m < 4; ++m) { const int rl = ai * HALF + wr * 64 + m * 16 + fr; const f32x4 q4 = *(const LAS f32x4*)(xch + rl * 4);
                const float rmax = fmaxf(fmaxf(q4[0], q4[1]), fmaxf(q4[2], q4[3])); const float inv = rmax > 0.f ? 127.0f * __builtin_amdgcn_rcpf(rmax) : 0.f;
                const int row = row0 + ai * HALF + m * 16;
                if (wc == 0 && fq == 0) SC[(size_t)row * ntile + u.pn] = rmax * mul;
                unsigned char* rowp = O8 + (size_t)row * ldc + col0;
#pragma unroll
                for (int bj = 0; bj < 2; ++bj) { const f32x4 x0 = v[ai][m][bj][0] * inv, x1 = v[ai][m][bj][1] * inv;
                    u32x2 w2; w2.x = q8f(x0[0]) | (q8f(x0[1]) << 8) | (q8f(x0[2]) << 16) | (q8f(x0[3]) << 24); w2.y = q8f(x1[0]) | (q8f(x1[1]) << 8) | (q8f(x1[2]) << 16) | (q8f(x1[3]) << 24);
                    *(u32x2*)(rowp + bj * HALF) = w2; } }
    }
};
constexpr float YS_SCALE = 64.0f;
struct EpiF8Out {
    static constexpr bool PERM = true, I8 = false, F8 = true;
    unsigned char* O8; int ldc; const float* wds; const int* tile_start;
    DI void operator()(const f32x4 (&acc)[2][2][4][2], const Unit& u, int wr, int wc, int fr, int fq) const {
        int e = 0;
#pragma unroll
        for (int j = 1; j < 16; ++j) e += (u.pm >= tile_start[j]) ? 1 : 0;
        const float mul = wds[e] * YS_SCALE;
        const int row0 = u.pm * BM + wr * 64 + fr; const int col0 = u.pn * BM + wc * 32 + 8 * fq;
#pragma unroll
        for (int ai = 0; ai < 2; ++ai)
#pragma unroll
            for (int m = 0; m < 4; ++m) { unsigned char* rowp = O8 + (size_t)(row0 + ai * HALF + m * 16) * ldc + col0;
#pragma unroll
                for (int bj = 0; bj < 2; ++bj) { const f32x4 x0 = acc[ai][bj][m][0] * mul, x1 = acc[ai][bj][m][1] * mul;
                    u32x2 w2; w2.x = pk_fp8x4(x0[0], x0[1], x0[2], x0[3]); w2.y = pk_fp8x4(x1[0], x1[1], x1[2], x1[3]);
                    *(u32x2*)(rowp + bj * HALF) = w2; } }
    }
};
struct EpiBf16 {
    static constexpr bool PERM = true, I8 = false, F8 = false;
    bf16_t* O; int ldc;
    DI void operator()(const f32x4 (&acc)[2][2][4][2], const Unit& u, int wr, int wc, int fr, int fq) const {
        const int row0 = u.pm * BM + wr * 64 + fr; const int col0 = u.pn * BM + wc * 32 + 8 * fq;
#pragma unroll
        for (int ai = 0; ai < 2; ++ai)
#pragma unroll
            for (int m = 0; m < 4; ++m) { bf16_t* rowp = O + (size_t)(row0 + ai * HALF + m * 16) * ldc + col0;
#pragma unroll
                for (int bj = 0; bj < 2; ++bj) { const f32x4 v0 = acc[ai][bj][m][0], v1 = acc[ai][bj][m][1];
                    u32x4 w; w.x = cvt_pk_bf16(v0[0], v0[1]); w.y = cvt_pk_bf16(v0[2], v0[3]); w.z = cvt_pk_bf16(v1[0], v1[1]); w.w = cvt_pk_bf16(v1[2], v1[3]);
                    *(u32x4*)(rowp + bj * HALF) = w; } }
    }
};
struct EpiSwiGLU {
    static constexpr bool PERM = true, I8 = false, F8 = false;
    bf16_t* O; int ldc;
    DI void operator()(const f32x4 (&acc)[2][2][4][2], const Unit& u, int wr, int wc, int fr, int fq) const {
        const int row0 = u.pm * BM + wr * 64 + fr; const int col0 = u.pn * HALF + wc * 32 + 8 * fq;
#pragma unroll
        for (int ai = 0; ai < 2; ++ai)
#pragma unroll
            for (int m = 0; m < 4; ++m) { bf16_t* rowp = O + (size_t)(row0 + ai * HALF + m * 16) * ldc + col0;
                float o[8];
#pragma unroll
                for (int n = 0; n < 2; ++n)
#pragma unroll
                    for (int j = 0; j < 4; ++j) { const float g = acc[ai][0][m][n][j], up = acc[ai][1][m][n][j]; o[n * 4 + j] = g * __builtin_amdgcn_rcpf(1.0f + __expf(-g)) * up; }
                u32x4 w; w.x = cvt_pk_bf16(o[0], o[1]); w.y = cvt_pk_bf16(o[2], o[3]); w.z = cvt_pk_bf16(o[4], o[5]); w.w = cvt_pk_bf16(o[6], o[7]);
                *(u32x4*)rowp = w; }
    }
};

template <class Epi, class Sched, bool GATHER>
DI void gemm_phase(LAS unsigned char* lds, const int tid, const Gemm g, const Sched& S, const Epi& E, const int* rowmap) {
    const int wid = __builtin_amdgcn_readfirstlane(tid >> 6), lane = tid & 63, wr = wid >> 2, wc = wid & 3, fr = lane & 15, fq = lane >> 4;
    const int K = g.K, nt = K / BK;
    unsigned voffA[2], voffB[2];
#pragma unroll
    for (int i = 0; i < 2; ++i) { int R, C; stage_rc(tid * 16 + i * 8192, R, C); const int Rb = Epi::PERM ? ((R & ~31) + perm32(R & 31)) : R;
        voffA[i] = (unsigned)(R * K + C) * 2u; voffB[i] = (unsigned)(Rb * K + C) * 2u; }
    const size_t kstep = (size_t)(BK * 2);
    const size_t hstep = (size_t)HALF * K * 2;
    const size_t tstep = 2 * hstep;
    const unsigned ldsw = (unsigned)wid * 1024u;
    const int aoff = lds_byte(wr * 64 + fr, fq * 8), boff = lds_byte(wc * 32 + fr, fq * 8);
#define PG8_SA(b, h) (((b) * 2 + (h)) * HTB)
#define PG8_SB(b, h) ((4 + (b) * 2 + (h)) * HTB)
#define PG8_STAGE(bufoff, gbase, voff) do { _Pragma("unroll") for (int _i = 0; _i < 2; ++_i) { unsigned vo_ = (voff)[_i]; asm volatile("" : "+v"(vo_)); \
        __builtin_amdgcn_global_load_lds((const unsigned*)((const char*)(gbase) + vo_), (LAS unsigned*)(lds + (bufoff) + ldsw + _i * 8192), 16, 0, 0); } } while (0)
#define PG8_LDA(dst, b, h) do { _Pragma("unroll") for (int m = 0; m < 4; ++m) { if constexpr (Epi::F8) { const i32x4 lo_ = *(const LAS i32x4*)(lds + PG8_SA(b, h) + aoff + m * 2048), hi_ = *(const LAS i32x4*)(lds + PG8_SA(b, h) + aoff + m * 2048 + 1024); \
            dst##8[m] = __builtin_shufflevector(lo_, hi_, 0, 1, 2, 3, 4, 5, 6, 7); } else { _Pragma("unroll") for (int k = 0; k < 2; ++k) dst[m][k] = *(const LAS bf16x8*)(lds + PG8_SA(b, h) + aoff + m * 2048 + k * 1024); } } } while (0)
#define PG8_LDB(dst, b, h) do { _Pragma("unroll") for (int n = 0; n < 2; ++n) { if constexpr (Epi::F8) { const i32x4 lo_ = *(const LAS i32x4*)(lds + PG8_SB(b, h) + boff + n * 2048), hi_ = *(const LAS i32x4*)(lds + PG8_SB(b, h) + boff + n * 2048 + 1024); \
            dst##8[n] = __builtin_shufflevector(lo_, hi_, 0, 1, 2, 3, 4, 5, 6, 7); } else { _Pragma("unroll") for (int k = 0; k < 2; ++k) dst[n][k] = *(const LAS bf16x8*)(lds + PG8_SB(b, h) + boff + n * 2048 + k * 1024); } } } while (0)
#define PG8_MMA(ai, bj, At, Bt) do { __builtin_amdgcn_s_setprio(1); _Pragma("unroll") for (int m = 0; m < 4; ++m) _Pragma("unroll") for (int n = 0; n < 2; ++n) _Pragma("unroll") for (int k = 0; k < 2; ++k) { \
        if constexpr (Epi::F8) { if (k == 0) acc[ai][bj][m][n] = __builtin_amdgcn_mfma_scale_f32_16x16x128_f8f6f4(Bt##8[n], At##8[m], acc[ai][bj][m][n], 0, 0, 0, 0, 0, 0); } \
        else if constexpr (Epi::I8) acc[ai][bj][m][n] = __builtin_bit_cast(f32x4, __builtin_amdgcn_mfma_i32_16x16x64_i8(__builtin_bit_cast(i32x4, Bt[n][k]), __builtin_bit_cast(i32x4, At[m][k]), __builtin_bit_cast(i32x4, acc[ai][bj][m][n]), 0, 0, 0)); \
        else acc[ai][bj][m][n] = __builtin_amdgcn_mfma_f32_16x16x32_bf16(Bt[n][k], At[m][k], acc[ai][bj][m][n], 0, 0, 0); } __builtin_amdgcn_s_setprio(0); } while (0)
#define PG8_WAIT_V(n) asm volatile("s_waitcnt vmcnt(" #n ")" ::: "memory")
#define PG8_WAIT_L(n) asm volatile("s_waitcnt lgkmcnt(" #n ")" ::: "memory")
#define PG8_BAR __builtin_amdgcn_s_barrier()
#define PG8_SCHED __builtin_amdgcn_sched_barrier(0)
    Unit cur, nxt; int ui = 0;
    if (!S.next(0, cur)) return;
    f32x4 acc[2][2][4][2];
#pragma unroll
    for (int a = 0; a < 2; ++a)
#pragma unroll
        for (int b = 0; b < 2; ++b)
#pragma unroll
            for (int m = 0; m < 4; ++m)
#pragma unroll
                for (int n = 0; n < 2; ++n) acc[a][b][m][n] = (f32x4){0.f, 0.f, 0.f, 0.f};
    bf16x8 At[4][2], B0[2][2], B1[2][2];
    i32x8 At8[4], B08[2], B18[2];
    unsigned cvA[2][2];
    const char* cA = (const char*)g.A + (GATHER ? (size_t)0 : (size_t)cur.pm * tstep);
#define PG8_LOAD_ROWS(unit) do { _Pragma("unroll") for (int h = 0; h < 2; ++h) _Pragma("unroll") for (int i = 0; i < 2; ++i) { int R, C; stage_rc(tid * 16 + i * 8192, R, C); \
        cvA[h][i] = (unsigned)(rowmap[(unit).pm * BM + h * HALF + R] * K + C) * 2u; } } while (0)
    if constexpr (GATHER) { PG8_LOAD_ROWS(cur); }
    const char* cB = (const char*)g.Bt + S.b_off(cur, tstep);
#define PG8_STAGE_A(bufoff, base_direct, koff_gather, h, usenext) do { if constexpr (GATHER) { PG8_STAGE(bufoff, (const char*)g.A + (koff_gather), cvA[h]); } \
        else { PG8_STAGE(bufoff, (base_direct), voffA); } } while (0)
    PG8_STAGE(PG8_SB(0, 0), cB, voffB); PG8_STAGE(PG8_SB(0, 1), cB + hstep, voffB); PG8_STAGE_A(PG8_SA(0, 0), cA, 0, 0, false); PG8_STAGE_A(PG8_SA(0, 1), cA + hstep, 0, 1, false);
    if (wr == 1) PG8_BAR;
    PG8_WAIT_V(2); PG8_BAR;
    PG8_STAGE(PG8_SB(1, 0), cB + kstep, voffB); PG8_STAGE_A(PG8_SA(1, 0), cA + kstep, kstep, 0, false); PG8_STAGE(PG8_SB(1, 1), cB + hstep + kstep, voffB);
    PG8_WAIT_V(6); PG8_BAR;
    for (;;) {
        const bool has_next = S.next(ui + 1, nxt);
        const char* nA = has_next ? (const char*)g.A + (GATHER ? (size_t)0 : (size_t)nxt.pm * tstep) : cA; const char* nB = has_next ? (const char*)g.Bt + S.b_off(nxt, tstep) : cB;
        for (int t = 0; t < nt; t += 2) {
            const bool last = (t == nt - 2);
            const char* a1 = cA + (size_t)(t + 1) * kstep;
            const char* a2 = last ? nA : cA + (size_t)(t + 2) * kstep; const char* b2 = last ? nB : cB + (size_t)(t + 2) * kstep;
            const char* a3 = a2 + kstep; const char* b3 = b2 + kstep;
            const size_t k1 = (size_t)(t + 1) * kstep, k2 = last ? (size_t)0 : (size_t)(t + 2) * kstep, k3 = k2 + kstep;
            PG8_LDB(B0, 0, 0); PG8_LDB(B1, 0, 1); PG8_SCHED; PG8_LDA(At, 0, 0); PG8_STAGE_A(PG8_SA(1, 1), a1 + hstep, k1, 1, false);
            if constexpr (GATHER) { if (last && has_next) { PG8_LOAD_ROWS(nxt); } }
            PG8_WAIT_V(8); PG8_WAIT_L(0); PG8_BAR; PG8_MMA(0, 0, At, B0); PG8_MMA(0, 1, At, B1); PG8_BAR; PG8_SCHED;
            PG8_LDA(At, 0, 1); PG8_STAGE(PG8_SB(0, 0), b2, voffB); PG8_STAGE(PG8_SB(0, 1), b2 + hstep, voffB); PG8_STAGE_A(PG8_SA(0, 0), a2, k2, 0, last);
            PG8_WAIT_V(8); PG8_WAIT_L(0); PG8_BAR; PG8_MMA(1, 0, At, B0); PG8_MMA(1, 1, At, B1); PG8_BAR; PG8_SCHED;
            PG8_LDB(B0, 1, 0); PG8_LDB(B1, 1, 1); PG8_SCHED; PG8_LDA(At, 1, 0); PG8_STAGE_A(PG8_SA(0, 1), a2 + hstep, k2, 1, last);
            PG8_WAIT_V(8); PG8_WAIT_L(0); PG8_BAR; PG8_MMA(0, 0, At, B0); PG8_MMA(0, 1, At, B1); PG8_BAR; PG8_SCHED;
            PG8_LDA(At, 1, 1); PG8_STAGE(PG8_SB(1, 0), b3, voffB); PG8_STAGE(PG8_SB(1, 1), b3 + hstep, voffB); PG8_STAGE_A(PG8_SA(1, 0), a3, k3, 0, last);
            PG8_WAIT_V(8); PG8_WAIT_L(0); PG8_BAR; PG8_MMA(1, 0, At, B0); PG8_MMA(1, 1, At, B1); PG8_BAR; PG8_SCHED;
        }
        if (wr == 0) PG8_BAR;
        { const int ln_ = lane_fresh(); int fr_ = ln_ & 15, fq_ = ln_ >> 4; asm volatile("" : "+v"(fr_), "+v"(fq_));
          E(acc, cur, wr, wc, fr_, fq_); }
        if (!has_next) break;
#pragma unroll
        for (int a = 0; a < 2; ++a)
#pragma unroll
            for (int b = 0; b < 2; ++b)
#pragma unroll
                for (int m = 0; m < 4; ++m)
#pragma unroll
                    for (int n = 0; n < 2; ++n) acc[a][b][m][n] = (f32x4){0.f, 0.f, 0.f, 0.f};
        cur = nxt; cA = nA; cB = nB; ++ui;
        if (wr == 1) PG8_BAR;
    }
    PG8_WAIT_V(0);
    PG8_BAR;
#undef PG8_SA
#undef PG8_SB
#undef PG8_STAGE
#undef PG8_STAGE_A
#undef PG8_LOAD_ROWS
#undef PG8_LDA
#undef PG8_LDB
#undef PG8_MMA
#undef PG8_WAIT_V
#undef PG8_WAIT_L
#undef PG8_BAR
#undef PG8_SCHED
}
}

#define XB_TMO      128
#define XB_XCNT(j)  (256  + 64 * (j))
#define XB_XSUB(j)  (1280 + 64 * (j))
#define XB_XGEN(j)  (2304 + 64 * (j))
#define XB_TOP      3328
#define XB_TOPGEN   3392
#define XCD_BAR_WORDS 3456
#define XB_SPIN_CAP (1u << 18)
__device__ __forceinline__ unsigned xb_ld(unsigned* p)              { return __hip_atomic_load(p, __ATOMIC_RELAXED, __HIP_MEMORY_SCOPE_AGENT); }
__device__ __forceinline__ unsigned xb_add(unsigned* p, unsigned v) { return __hip_atomic_fetch_add(p, v, __ATOMIC_RELAXED, __HIP_MEMORY_SCOPE_AGENT); }
__device__ __forceinline__ unsigned xb_xcc_id() { return (unsigned)__builtin_amdgcn_s_getreg((3 << 11) | 20) & 0xFu; }
#define XB_SPIN(cond, bar) do { unsigned _sp = 0; while (cond) { __builtin_amdgcn_s_sleep(1); \
    if ((++_sp & 255u) == 0u) { if (xb_ld(&(bar)[XB_TMO])) break; if (_sp > XB_SPIN_CAP) { atomicAdd(&(bar)[XB_TMO], 1u); break; } } } } while (0)
struct XcdBarrier { unsigned* bar; unsigned x; volatile LAS unsigned* st; };
__device__ __forceinline__ XcdBarrier xcd_barrier_post(unsigned* bar, volatile LAS unsigned* st) {
    XcdBarrier b; b.bar = bar; b.x = xb_xcc_id(); b.st = st;
    if (threadIdx.x == 0) (void)xb_add(&bar[XB_XCNT(b.x)], 1u);
    return b;
}
__device__ __forceinline__ void xcd_barrier_complete(unsigned* bar, unsigned x, unsigned& nloc, unsigned& nx) {
    const unsigned G = gridDim.x * gridDim.y * gridDim.z;
    unsigned sum, cnt, mine, sp = 0u;
    for (;;) {
        sum = 0u; cnt = 0u; mine = 0u;
#pragma unroll
        for (unsigned j = 0; j < 16; ++j) { const unsigned c = xb_ld(&bar[XB_XCNT(j)]); sum += c; cnt += (c > 0u) ? 1u : 0u; mine = (j == x) ? c : mine; }
        if (sum == G) break;
        __builtin_amdgcn_s_sleep(1);
        if ((++sp & 255u) == 0u) { if (xb_ld(&bar[XB_TMO])) break; if (sp > XB_SPIN_CAP) { atomicAdd(&bar[XB_TMO], 1u); break; } }
    }
    nloc = mine > 0u ? mine : 1u; nx = cnt > 0u ? cnt : 1u;
}
__device__ __forceinline__ void xcd_barrier(const XcdBarrier& b) {
    asm volatile("s_waitcnt vmcnt(0)" ::: "memory");
    __syncthreads();
    if (threadIdx.x == 0) {
        unsigned* bar = b.bar;
        __builtin_amdgcn_s_waitcnt(0);
        unsigned nloc = b.st[0], nx = b.st[1];
        if (nloc == 0u) { xcd_barrier_complete(bar, b.x, nloc, nx); b.st[0] = nloc; b.st[1] = nx; }
        const unsigned old = xb_add(&bar[XB_XSUB(b.x)], 1u);
        const unsigned gen = old / nloc;
        if (old + 1u == (gen + 1u) * nloc) {
            __builtin_amdgcn_fence(__ATOMIC_RELEASE, "agent");
            asm volatile("s_waitcnt vmcnt(0)" ::: "memory");
            const unsigned og = xb_add(&bar[XB_TOP], 1u);
            const unsigned tg = og / nx;
            if (og + 1u == (tg + 1u) * nx) xb_add(&bar[XB_TOPGEN], 1u);
            else XB_SPIN(xb_ld(&bar[XB_TOPGEN]) == tg, bar);
            __builtin_amdgcn_fence(__ATOMIC_ACQUIRE, "agent");
            xb_add(&bar[XB_XGEN(b.x)], 1u);
            asm volatile("s_waitcnt vmcnt(0)" ::: "memory");
        } else {
            XB_SPIN(xb_ld(&bar[XB_XGEN(b.x)]) == gen, bar);
            __builtin_amdgcn_fence(__ATOMIC_ACQUIRE, "agent");
            asm volatile("s_waitcnt vmcnt(0)" ::: "memory");
        }
    }
    __syncthreads();
}

struct Args { const float* in[20]; float* out; unsigned char* ws; int ph_lo, ph_hi; };
typedef __attribute__((address_space(4))) const unsigned char* kptr_t;
struct Frame {
    LAS unsigned char* lds;
    int tid, lane, wave, vcu, G, bx;
    int wave0;
    kptr_t ka;
};
DI void frame_refresh(Frame& F) {
    int wv = F.wave0; asm volatile("" : "+s"(wv)); int ln = lane_fresh(); asm volatile("" : "+v"(ln));
    F.lane = ln; F.wave = wv; F.tid = wv * 64 + ln;
    int g = gridDim.x; asm volatile("" : "+s"(g)); F.G = g; int bx = blockIdx.x; asm volatile("" : "+s"(bx)); F.bx = bx;
    F.vcu = (g % 8 == 0) ? (bx % 8) * (g / 8) + bx / 8 : bx;
    kptr_t p = (kptr_t)__builtin_amdgcn_kernarg_segment_ptr(); asm volatile("" : "+s"(p)); F.ka = p;
}
DI kptr_t karg_fresh() { kptr_t p = (kptr_t)__builtin_amdgcn_kernarg_segment_ptr(); asm volatile("" : "+s"(p)); return p; }
DI const float* fin(const Frame& F, int i) { return (const float*)(*(const GAS float* const __attribute__((address_space(4)))*)(F.ka + 8 * i)); }
DI unsigned char* fout(const Frame& F) { return (unsigned char*)(*(GAS unsigned char* const __attribute__((address_space(4)))*)(F.ka + 160)); }
DI unsigned char* fws(const Frame& F) { return (unsigned char*)(*(GAS unsigned char* const __attribute__((address_space(4)))*)(F.ka + 168)); }

typedef short v4i16_t __attribute__((ext_vector_type(4)));
DI s16x4 lds_tr(const LAS bf16* p) { return __builtin_bit_cast(s16x4, __builtin_amdgcn_ds_read_tr16_b64_v4i16((LAS v4i16_t*)p)); }
DI bf16x8 tr_frag(const LAS bf16* img, int stride, int row_lo, int row_hi, int colbase, int lane) {
    const int q = (lane & 15) >> 2, p = lane & 3, blk = (lane >> 4) & 1;
    const s16x4 lo = lds_tr(img + (row_lo + q) * stride + colbase + 16 * blk + 4 * p);
    const s16x4 hi = lds_tr(img + (row_hi + q) * stride + colbase + 16 * blk + 4 * p);
    return (bf16x8){lo[0], lo[1], lo[2], lo[3], hi[0], hi[1], hi[2], hi[3]};
}
DI void transpose_item(const float* W, int N, int K, int k0, int n0, bf16* WT, int dst_row0, LAS bf16* img, int lane) {
    const int kk = lane >> 4, n4 = (lane & 15) * 4;
    f32x4 v[16];
#pragma unroll
    for (int i = 0; i < 16; ++i) v[i] = __builtin_nontemporal_load((const f32x4*)(W + (size_t)(k0 + 4 * i + kk) * N + n0 + n4));
#pragma unroll
    for (int i = 0; i < 16; ++i) { u32x2 w2; w2.x = cvt_pk_bf16(v[i].x, v[i].y); w2.y = cvt_pk_bf16(v[i].z, v[i].w); *(LAS u32x2*)(img + (4 * i + kk) * 72 + n4) = w2; }
    LDS_WAIT(); asm volatile("" ::: "memory");
    const int r = lane & 31, h = lane >> 5;
#pragma unroll
    for (int cb = 0; cb < 2; ++cb)
#pragma unroll
        for (int kb = 0; kb < 4; ++kb) { const bf16x8 f = tr_frag(img, 72, 16 * kb + 8 * h, 16 * kb + 8 * h + 4, 32 * cb, lane);
            *(bf16x8*)(WT + (size_t)(dst_row0 + 32 * cb + r) * K + k0 + 16 * kb + 8 * h) = f; }
    LDS_WAIT(); asm volatile("" ::: "memory");
}
constexpr int WABS_ROWS = 32, WABS_KR = DM / WABS_ROWS;
DI void wabs_item(const float* W, int N, int k0, int n0, unsigned* dst, int lane) {
    const float* p = W + (size_t)k0 * N + n0 + lane * 4;
    f32x4 m = (f32x4){0.f, 0.f, 0.f, 0.f};
#pragma unroll 8
    for (int k = 0; k < WABS_ROWS; ++k) { const f32x4 v = __builtin_nontemporal_load((const f32x4*)(p + (size_t)k * N)); m.x = fmaxf(m.x, fabsf(v.x)); m.y = fmaxf(m.y, fabsf(v.y)); m.z = fmaxf(m.z, fabsf(v.z)); m.w = fmaxf(m.w, fabsf(v.w)); }
    unsigned* d = dst + lane * 4;
    __hip_atomic_fetch_max(d + 0, __float_as_uint(m.x), __ATOMIC_RELAXED, __HIP_MEMORY_SCOPE_AGENT); __hip_atomic_fetch_max(d + 1, __float_as_uint(m.y), __ATOMIC_RELAXED, __HIP_MEMORY_SCOPE_AGENT);
    __hip_atomic_fetch_max(d + 2, __float_as_uint(m.z), __ATOMIC_RELAXED, __HIP_MEMORY_SCOPE_AGENT); __hip_atomic_fetch_max(d + 3, __float_as_uint(m.w), __ATOMIC_RELAXED, __HIP_MEMORY_SCOPE_AGENT);
}
constexpr int WABS_I_IN = (NPROJ / 256) * WABS_KR, WABS_I_OUT = (DM / 256) * WABS_KR, WABS_I_G1 = (DEXP / 256) * 16, WABS_I_GU = NEXP * 2 * WABS_I_G1, WABS_PER_L = WABS_I_IN + WABS_I_OUT;
DI void wabs_layer_item(Frame& F, int l, int r) {
    unsigned* A = (unsigned*)(fws(F) + WS_CTL + CTL_ABS) + (size_t)l * ABS_PER_LAYER;
    if (r < WABS_I_IN) { const int nb = r / WABS_KR, kr = r % WABS_KR; wabs_item(fin(F, 3) + (size_t)l * DM * NPROJ, NPROJ, WABS_ROWS * kr, 256 * nb, A + ABS_IN + 256 * nb, F.lane); return; } r -= WABS_I_IN;
    if (r < WABS_I_OUT) { const int nb = r / WABS_KR, kr = r % WABS_KR; wabs_item(fin(F, 10) + (size_t)l * DM * DM, DM, WABS_ROWS * kr, 256 * nb, A + ABS_OUT + 256 * nb, F.lane); return; } r -= WABS_I_OUT;
    { const int e = r / (2 * WABS_I_G1), r2 = r % (2 * WABS_I_G1), isup = r2 / WABS_I_G1, r3 = r2 % WABS_I_G1, nb = r3 >> 4, kr = r3 & 15;
      const float* W = (isup ? fin(F, 16) : fin(F, 15)) + ((size_t)l * NEXP + e) * DM * DEXP;
      const int n0 = 256 * nb; unsigned* dst = A + ABS_GU + e * 2048;
      const float* p = W + (size_t)(128 * kr) * DEXP + n0 + F.lane * 4;
      f32x4 m = (f32x4){0.f, 0.f, 0.f, 0.f};
#pragma unroll 8
      for (int k = 0; k < 128; ++k) { const f32x4 v = __builtin_nontemporal_load((const f32x4*)(p + (size_t)k * DEXP)); m.x = fmaxf(m.x, fabsf(v.x)); m.y = fmaxf(m.y, fabsf(v.y)); m.z = fmaxf(m.z, fabsf(v.z)); m.w = fmaxf(m.w, fabsf(v.w)); }
      const int n = n0 + F.lane * 4; unsigned* d = dst + 256 * (n >> 7) + 128 * isup + (n & 127);
      __hip_atomic_fetch_max(d + 0, __float_as_uint(m.x), __ATOMIC_RELAXED, __HIP_MEMORY_SCOPE_AGENT); __hip_atomic_fetch_max(d + 1, __float_as_uint(m.y), __ATOMIC_RELAXED, __HIP_MEMORY_SCOPE_AGENT);
      __hip_atomic_fetch_max(d + 2, __float_as_uint(m.z), __ATOMIC_RELAXED, __HIP_MEMORY_SCOPE_AGENT); __hip_atomic_fetch_max(d + 3, __float_as_uint(m.w), __ATOMIC_RELAXED, __HIP_MEMORY_SCOPE_AGENT); }
}
DI void wabs_phase(Frame& F, int l) {
    const int gw = F.vcu * 8 + F.wave, NGW = F.G * 8;
    for (int it = gw; it < WABS_PER_L; it += NGW) wabs_layer_item(F, l, it);
}
constexpr int WABS_T1 = WABS_PER_L;
DI int wabs_t2(int G, int nunits) { const int nfull = nunits % G, nidle = nfull ? G - nfull : G; const int t2 = WABS_T1 + nidle * 8; return t2 < WABS_PER_L ? t2 : WABS_PER_L; }
DI void wabs_tail(Frame& F, int nunits, int lo, int hi) {
    const int nfull = nunits % F.G; const int nidle = nfull ? F.G - nfull : F.G; const int fi = nfull ? F.bx - nfull : F.bx;
    if (fi < 0) return;
    for (int it = lo + fi * 8 + F.wave; it < hi; it += nidle * 8) wabs_layer_item(F, 1, it);
}
DI unsigned q8(float x) { return (unsigned)(int)__builtin_rintf(x) & 0xffu; }
DI void transpose_item_q(const float* W, int N, int K8, int k0, int n0, unsigned char* WT8, int dst_row0, const float* amax, LAS bf16* img, int lane) {
    const int kk2 = lane >> 4, n4 = (lane & 15) * 4;
    const f32x4 am = *(const f32x4*)(amax + dst_row0 + n4);
    const f32x4 inv = (f32x4){am.x > 0.f ? 127.0f / am.x : 0.f, am.y > 0.f ? 127.0f / am.y : 0.f, am.z > 0.f ? 127.0f / am.z : 0.f, am.w > 0.f ? 127.0f / am.w : 0.f};
    f32x4 va[8], vb[8];
#pragma unroll
    for (int i = 0; i < 8; ++i) { const float* p = W + (size_t)(k0 + 8 * i + 2 * kk2) * N + n0 + n4; va[i] = __builtin_nontemporal_load((const f32x4*)p); vb[i] = __builtin_nontemporal_load((const f32x4*)(p + N)); }
#pragma unroll
    for (int i = 0; i < 8; ++i) { const f32x4 a = va[i] * inv, b2 = vb[i] * inv;
        const unsigned e0 = q8(a.x) | (q8(b2.x) << 8), e1 = q8(a.y) | (q8(b2.y) << 8), e2 = q8(a.z) | (q8(b2.z) << 8), e3 = q8(a.w) | (q8(b2.w) << 8);
        u32x2 w2; w2.x = e0 | (e1 << 16); w2.y = e2 | (e3 << 16); *(LAS u32x2*)(img + (4 * i + kk2) * 72 + n4) = w2; }
    LDS_WAIT(); asm volatile("" ::: "memory");
    const int r = lane & 31, h = lane >> 5;
#pragma unroll
    for (int cb = 0; cb < 2; ++cb)
#pragma unroll
        for (int kb = 0; kb < 2; ++kb) { const bf16x8 f = tr_frag(img, 72, 16 * kb + 8 * h, 16 * kb + 8 * h + 4, 32 * cb, lane);
            *(bf16x8*)(WT8 + (size_t)(dst_row0 + 32 * cb + r) * K8 + k0 + 32 * kb + 16 * h) = f; }
    LDS_WAIT(); asm volatile("" ::: "memory");
}
DI void transpose_item_f8(const float* W, int N, int K8, int k0, int n0, unsigned char* WT8, int dst_row0, const float scale, LAS bf16* img, int lane) {
    const int kk2 = lane >> 4, n4 = (lane & 15) * 4;
    f32x4 va[8], vb[8];
#pragma unroll
    for (int i = 0; i < 8; ++i) { const float* p = W + (size_t)(k0 + 8 * i + 2 * kk2) * N + n0 + n4; va[i] = __builtin_nontemporal_load((const f32x4*)p); vb[i] = __builtin_nontemporal_load((const f32x4*)(p + N)); }
#pragma unroll
    for (int i = 0; i < 8; ++i) { const f32x4 a = va[i] * scale, b2 = vb[i] * scale;
        u32x2 w2; w2.x = pg8::pk_fp8x4(a.x, b2.x, a.y, b2.y); w2.y = pg8::pk_fp8x4(a.z, b2.z, a.w, b2.w); *(LAS u32x2*)(img + (4 * i + kk2) * 72 + n4) = w2; }
    LDS_WAIT(); asm volatile("" ::: "memory");
    const int r = lane & 31, h = lane >> 5;
#pragma unroll
    for (int cb = 0; cb < 2; ++cb)
#pragma unroll
        for (int kb = 0; kb < 2; ++kb) { const bf16x8 f = tr_frag(img, 72, 16 * kb + 8 * h, 16 * kb + 8 * h + 4, 32 * cb, lane);
            *(bf16x8*)(WT8 + (size_t)(dst_row0 + 32 * cb + r) * K8 + k0 + 32 * kb + 16 * h) = f; }
    LDS_WAIT(); asm volatile("" ::: "memory");
}
DI void convert_weights(Frame& F, int l) {
    LAS bf16* img = (LAS bf16*)(F.lds + F.wave * 9216);
    const int gw = F.vcu * 8 + F.wave, NGW = F.G * 8;
    const float* w_in = fin(F, 3) + (size_t)l * DM * NPROJ; const float* w_out = fin(F, 10) + (size_t)l * DM * DM;
    const float* w_gate = fin(F, 15) + (size_t)l * NEXP * DM * DEXP; const float* w_up = fin(F, 16) + (size_t)l * NEXP * DM * DEXP; const float* w_down = fin(F, 17) + (size_t)l * NEXP * DEXP * DM;
    unsigned char* WIN = fws(F) + WS_WIN; unsigned char* WOUT = fws(F) + WS_WOUT; unsigned char* WGU = fws(F) + WS_WGU; unsigned char* WD = fws(F) + WS_WD;
    const float* ABS = (const float*)(fws(F) + WS_CTL + CTL_ABS) + (size_t)l * ABS_PER_LAYER;
    LAS float* wred = (LAS float*)(F.lds + 81920); LAS float* wsc = wred + 384;
    __syncthreads();
#pragma unroll 1
    for (int eb = 0; eb < 3 * NEXP; eb += 16) {
        f32x4 v[16];
#pragma unroll
        for (int i = 0; i < 16; ++i) { const int e = eb + i; const float* src = e < NEXP ? w_down + (size_t)e * DEXP * DM : ((e & 1) ? w_up : w_gate) + (size_t)((e - NEXP) >> 1) * DM * DEXP;
            v[i] = *(const f32x4*)(src + 4 * F.tid); }
#pragma unroll
        for (int i = 0; i < 16; ++i) { const float m = wave_max(fmaxf(fmaxf(fabsf(v[i].x), fabsf(v[i].y)), fmaxf(fabsf(v[i].z), fabsf(v[i].w)))); if (F.lane == 0) wred[(eb + i) * 8 + F.wave] = m; } }
    __syncthreads();
    if (F.tid < 3 * NEXP) { float m = 1e-30f;
#pragma unroll
        for (int j = 0; j < 8; ++j) m = fmaxf(m, wred[F.tid * 8 + j]);
        const float sc = exp2f(floorf(log2f(64.0f / m))); wsc[F.tid] = sc;
        if (F.bx == 0) { if (F.tid < NEXP) ((float*)(fws(F) + WS_WDS))[l * NEXP + F.tid] = 1.0f / (pg8::HID_SCALE * sc); else ((float*)(fws(F) + WS_GUS))[l * 2 * NEXP + F.tid - NEXP] = 1.0f / (pg8::ACT_SCALE * sc); } }
    __syncthreads();
    constexpr int I_IN = (DM / 64) * (NPROJ / 64), I_OUT = (DM / 64) * (DM / 64), I_G1 = (DM / 64) * (DEXP / 64), I_GU = NEXP * 2 * I_G1, I_D1 = (DEXP / 64) * (DM / 64), I_D = NEXP * I_D1;
    constexpr int NITEMS = I_IN + I_OUT + I_GU + I_D;
    for (int it = gw; it < NITEMS; it += NGW) {
        int r = it;
        if (r < I_IN) { const int nblk = NPROJ / 64, kb = r / nblk, nb = r % nblk; transpose_item_q(w_in, NPROJ, DM, 64 * kb, 64 * nb, WIN, 64 * nb, ABS + ABS_IN, img, F.lane); continue; } r -= I_IN;
        if (r < I_OUT) { const int nblk = DM / 64, kb = r / nblk, nb = r % nblk; transpose_item_q(w_out, DM, DM, 64 * kb, 64 * nb, WOUT, 64 * nb, ABS + ABS_OUT, img, F.lane); continue; } r -= I_OUT;
        if (r < I_GU) { const int e = r / (2 * I_G1), r2 = r % (2 * I_G1), isup = r2 / I_G1, r3 = r2 % I_G1; const int nblk = DEXP / 64, kb = r3 / nblk, nb = r3 % nblk, n0 = 64 * nb;
            const float* W = (isup ? w_up : w_gate) + (size_t)e * DM * DEXP;
            transpose_item_f8(W, DEXP, DM, 64 * kb, n0, WGU + (size_t)e * 2048 * DM, 256 * (n0 >> 7) + 128 * isup + (n0 & 127), wsc[NEXP + 2 * e + isup], img, F.lane); continue; } r -= I_GU;
        { const int e = r / I_D1, r3 = r % I_D1; const int nblk = DM / 64, kb = r3 / nblk, nb = r3 % nblk;
            transpose_item_f8(w_down + (size_t)e * DEXP * DM, DM, DEXP, 64 * kb, 64 * nb, WD + (size_t)e * DM * DEXP, 64 * nb, wsc[e], img, F.lane); }
    }
}
DI void stage_gb(Frame& F, const float* g, const float* bb, LAS float* gl, LAS float* bl) {
    const f32x4 gv = *(const f32x4*)(g + 4 * F.tid), bv = *(const f32x4*)(bb + 4 * F.tid);
    *(LAS f32x4*)(gl + 4 * F.tid) = gv; *(LAS f32x4*)(bl + 4 * F.tid) = bv;
}
DI void ln_emb(Frame& F) {
    const int gw = F.vcu * 8 + F.wave, NGW = F.G * 8;
    const float* x = fin(F, 0); const float* g = fin(F, 1); const float* bb = fin(F, 2); bf16* H = (bf16*)(fws(F) + WS_H); unsigned char* H8 = fws(F) + WS_H8; float* HS = (float*)(fws(F) + WS_HS);
    LAS float* gl = (LAS float*)F.lds; LAS float* bl = gl + DM;
    __syncthreads(); stage_gb(F, g, bb, gl, bl); __syncthreads();
    f32x4 pre[8];
    if (gw < T_TOK) { const f32x4* xr = (const f32x4*)(x + (size_t)gw * DM) + F.lane;
#pragma unroll
        for (int j = 0; j < 8; ++j) pre[j] = __builtin_nontemporal_load(xr + 64 * j); }
    for (int m = gw; m < T_TOK; m += NGW) {
        f32x4 v[8]; float s = 0.f;
#pragma unroll
        for (int j = 0; j < 8; ++j) { v[j] = pre[j]; s += (v[j].x + v[j].y) + (v[j].z + v[j].w); }
        if (m + NGW < T_TOK) { const f32x4* xr = (const f32x4*)(x + (size_t)(m + NGW) * DM) + F.lane;
#pragma unroll
            for (int j = 0; j < 8; ++j) pre[j] = __builtin_nontemporal_load(xr + 64 * j); }
        const float mean = wave_sum(s) * (1.f / DM); float s2 = 0.f;
#pragma unroll
        for (int j = 0; j < 8; ++j) { v[j] = v[j] - mean; s2 += (v[j].x * v[j].x + v[j].y * v[j].y) + (v[j].z * v[j].z + v[j].w * v[j].w); }
        const float rstd = 1.f / sqrtf(wave_sum(s2) * (1.f / DM) + LN_EPS);
        u32x2* o8 = (u32x2*)(H + (size_t)m * DM) + F.lane; float am = 0.f;
#pragma unroll
        for (int j = 0; j < 8; ++j) { const f32x4 gg = ((const LAS f32x4*)gl)[F.lane + 64 * j], bv = ((const LAS f32x4*)bl)[F.lane + 64 * j];
            v[j] = v[j] * rstd * gg + bv; am = fmaxf(fmaxf(am, fmaxf(fabsf(v[j].x), fabsf(v[j].y))), fmaxf(fabsf(v[j].z), fabsf(v[j].w)));
            u32x2 w; w.x = cvt_pk_bf16(v[j].x, v[j].y); w.y = cvt_pk_bf16(v[j].z, v[j].w); o8[64 * j] = w; }
        am = wave_max(am); const float inv = am > 0.f ? 127.0f / am : 0.f;
        unsigned* q4 = (unsigned*)(H8 + (size_t)m * DM) + F.lane;
#pragma unroll
        for (int j = 0; j < 8; ++j) q4[64 * j] = q8(v[j].x * inv) | (q8(v[j].y * inv) << 8) | (q8(v[j].z * inv) << 16) | (q8(v[j].w * inv) << 24);
        if (F.lane == 0) HS[m] = am * (1.0f / 127.0f);
    }
}

constexpr int AT_KS = 72, AT_VS = 392;
DI void attn_phase(Frame& F, int l) {
    const bf16* P = (const bf16*)(fws(F) + WS_PROJ); bf16* Y = (bf16*)(fout(F) + DO_Y);
    LAS bf16* Ks = (LAS bf16*)F.lds; LAS bf16* Vt = (LAS bf16*)(F.lds + 384 * AT_KS * 2);
    const int tid = F.tid, lane = F.lane, w = F.wave, r = lane & 31, h = lane >> 5;
    const float* sinkp = fin(F, 4) + l * 8;
    const bool deal = (F.G == 256);
    const int u_first = deal ? (F.vcu >= 128 ? (F.vcu - 128) * 4 : F.vcu * 4 + 3) : F.vcu, u_step = deal ? 1 : F.G, u_end = deal ? (F.vcu >= 128 ? (F.vcu - 128) * 4 + 3 : F.vcu * 4 + 4) : NBATCH * 32 * 2;
    for (int u = u_first; u < u_end; u += u_step) {
        const int kvh = u & 1, n = (u >> 1) & 31, b = u >> 6;
        const size_t rowb = (size_t)b * SEQ;
        __syncthreads();
#pragma unroll
        for (int i = 0; i < 6; ++i) { const int idx = tid + 512 * i, row = idx >> 3, ch = idx & 7; const int tok = n * 128 - 128 + row;
            u32x4 kv = (u32x4){0u, 0u, 0u, 0u}, vv = (u32x4){0u, 0u, 0u, 0u};
            if (tok >= 0 && tok < SEQ) { const bf16* src = P + (rowb + tok) * NPROJ; kv = *(const u32x4*)(src + C_AK + kvh * 64 + ch * 8); vv = *(const u32x4*)(src + C_AV + kvh * 64 + ch * 8); }
            *(LAS u32x4*)(Ks + row * AT_KS + ch * 8) = kv;
            LAS bf16* vd = Vt + (ch * 8) * AT_VS + row;
            vd[0 * AT_VS] = (bf16)(vv.x & 0xffffu); vd[1 * AT_VS] = (bf16)(vv.x >> 16); vd[2 * AT_VS] = (bf16)(vv.y & 0xffffu); vd[3 * AT_VS] = (bf16)(vv.y >> 16);
            vd[4 * AT_VS] = (bf16)(vv.z & 0xffffu); vd[5 * AT_VS] = (bf16)(vv.z >> 16); vd[6 * AT_VS] = (bf16)(vv.w & 0xffffu); vd[7 * AT_VS] = (bf16)(vv.w >> 16); }
        __syncthreads();
        const int hq = kvh * 4 + (w >> 1);
        const float slope2 = exp2f(-(float)(hq + 1)) * 1.4426950408889634f; const float sink2 = sinkp[hq] * 1.4426950408889634f; const float c1 = 0.125f * 1.4426950408889634f;
        const bool edge = (n == 0) || (n == 31); const int jlo = (n == 0) ? 128 : 0, jhi = (n == 31) ? 256 : 384;
#pragma unroll 1
        for (int qi = 0; qi < 2; ++qi) {
            const int t0 = (w & 1) * 64 + 32 * qi;
            const bf16* qsrc = P + (rowb + n * 128 + t0 + r) * NPROJ + C_AQ + hq * 64 + 8 * h;
            bf16x8 qf[4];
#pragma unroll
            for (int ks = 0; ks < 4; ++ks) qf[ks] = *(const bf16x8*)(qsrc + ks * 16);
            float m = sink2, lsum = (h == 0) ? 1.0f : 0.0f;
            f32x16 O0, O1;
#pragma unroll
            for (int i = 0; i < 16; ++i) { O0[i] = 0.f; O1[i] = 0.f; }
#pragma unroll 1
            for (int kt = 0; kt < 9; ++kt) {
                const int j0 = t0 + 32 * kt;
                f32x16 s;
#pragma unroll
                for (int i = 0; i < 16; ++i) s[i] = 0.f;
#pragma unroll
                for (int ks = 0; ks < 4; ++ks) { const bf16x8 a = *(const LAS bf16x8*)(Ks + (j0 + r) * AT_KS + ks * 16 + 8 * h); s = MFMA32(a, qf[ks], s); }
                const float fbase = (float)(32 * kt - 128 - r + 4 * h);
#pragma unroll
                for (int i = 0; i < 16; ++i) { const float fd = fbase + (float)((i & 3) + 8 * (i >> 2)); s[i] = __builtin_fmaf(s[i], c1, -slope2 * __builtin_fabsf(fd)); }
                if (kt == 0 || kt == 8 || edge) {
#pragma unroll
                    for (int i = 0; i < 16; ++i) { const float fd = fbase + (float)((i & 3) + 8 * (i >> 2)); const int j = j0 + crow(i, h);
                        const bool ok = (__builtin_fabsf(fd) <= 128.f) && (j >= jlo) && (j < jhi); s[i] = ok ? s[i] : -INFINITY; } }
                float mx = -INFINITY;
#pragma unroll
                for (int i = 0; i < 16; ++i) mx = fmaxf(mx, s[i]);
                mx = max32(mx);
                const float mn = fmaxf(m, mx); const float sc = __builtin_amdgcn_exp2f(m - mn); m = mn;
                float ps = 0.f;
#pragma unroll
                for (int i = 0; i < 16; ++i) { const float p = __builtin_amdgcn_exp2f(s[i] - mn); s[i] = p; ps += p; }
                lsum = lsum * sc + ps;
#pragma unroll
                for (int i = 0; i < 16; ++i) { O0[i] *= sc; O1[i] *= sc; }
#pragma unroll
                for (int s2 = 0; s2 < 2; ++s2) {
                    u32x4 pw; pw.x = cvt_pk_bf16(s[8 * s2 + 0], s[8 * s2 + 1]); pw.y = cvt_pk_bf16(s[8 * s2 + 2], s[8 * s2 + 3]); pw.z = cvt_pk_bf16(s[8 * s2 + 4], s[8 * s2 + 5]); pw.w = cvt_pk_bf16(s[8 * s2 + 6], s[8 * s2 + 7]);
                    const bf16x8 pf = __builtin_bit_cast(bf16x8, pw);
                    const LAS bf16* vb = Vt + j0 + 16 * s2 + 4 * h;
                    { const u32x2 lo = *(const LAS u32x2*)(vb + r * AT_VS), hi = *(const LAS u32x2*)(vb + r * AT_VS + 8); const u32x4 aw = (u32x4){lo.x, lo.y, hi.x, hi.y}; O0 = MFMA32(__builtin_bit_cast(bf16x8, aw), pf, O0); }
                    { const u32x2 lo = *(const LAS u32x2*)(vb + (32 + r) * AT_VS), hi = *(const LAS u32x2*)(vb + (32 + r) * AT_VS + 8); const u32x4 aw = (u32x4){lo.x, lo.y, hi.x, hi.y}; O1 = MFMA32(__builtin_bit_cast(bf16x8, aw), pf, O1); }
                }
            }
            const float lt = sum32(lsum); const float inv = __builtin_amdgcn_rcpf(lt);
            bf16* yo = Y + (rowb + n * 128 + t0 + r) * DM + hq * 64 + 4 * h;
#pragma unroll
            for (int g4 = 0; g4 < 4; ++g4) {
                u32x2 w0; w0.x = cvt_pk_bf16(O0[4 * g4] * inv, O0[4 * g4 + 1] * inv); w0.y = cvt_pk_bf16(O0[4 * g4 + 2] * inv, O0[4 * g4 + 3] * inv); *(u32x2*)(yo + 8 * g4) = w0;
                u32x2 w1; w1.x = cvt_pk_bf16(O1[4 * g4] * inv, O1[4 * g4 + 1] * inv); w1.y = cvt_pk_bf16(O1[4 * g4 + 2] * inv, O1[4 * g4 + 3] * inv); *(u32x2*)(yo + 32 + 8 * g4) = w1; }
        }
    }
}

DI void conv_phase(Frame& F, int l) {
    const bf16* P = (const bf16*)(fws(F) + WS_PROJ); bf16* Y = (bf16*)(fout(F) + DO_Y);
    const float* cw = fin(F, 5) + (size_t)l * 3 * 512;
    const int nthr = F.G * 512;
    for (int it = F.vcu * 512 + F.tid; it < T_TOK * 64; it += nthr) {
        const int ch = it & 63, tok = it >> 6, tl = tok & (SEQ - 1);
        const bf16* src = P + (size_t)tok * NPROJ + ch * 8;
        float u0[8], u1[8], u2[8], bq[8], a[8], c[8];
        { const u32x4 cc = *(const u32x4*)(src + C_CC), hh = *(const u32x4*)(src + C_CH); unpack8(cc, a); unpack8(hh, c);
#pragma unroll
          for (int j = 0; j < 8; ++j) u1[j] = a[j] * c[j]; }
        if (tl > 0) { const u32x4 cc = *(const u32x4*)(src - NPROJ + C_CC), hh = *(const u32x4*)(src - NPROJ + C_CH); unpack8(cc, a); unpack8(hh, c);
#pragma unroll
          for (int j = 0; j < 8; ++j) u0[j] = a[j] * c[j]; }
        else {
#pragma unroll
          for (int j = 0; j < 8; ++j) u0[j] = 0.f; }
        if (tl < SEQ - 1) { const u32x4 cc = *(const u32x4*)(src + NPROJ + C_CC), hh = *(const u32x4*)(src + NPROJ + C_CH); unpack8(cc, a); unpack8(hh, c);
#pragma unroll
          for (int j = 0; j < 8; ++j) u2[j] = a[j] * c[j]; }
        else {
#pragma unroll
          for (int j = 0; j < 8; ++j) u2[j] = 0.f; }
        { const u32x4 bw = *(const u32x4*)(src + C_CB); unpack8(bw, bq); }
        float o[8];
#pragma unroll
        for (int j = 0; j < 8; ++j) { const int cidx = ch * 8 + j; o[j] = bq[j] * (cw[cidx] * u0[j] + cw[512 + cidx] * u1[j] + cw[1024 + cidx] * u2[j]); }
        *(u32x4*)(Y + (size_t)tok * DM + 512 + ch * 8) = pack8(o);
    }
}

constexpr int GL_RS = 72;
constexpr int GL_VS = 136;
constexpr int GL_QH_OFF = 0;
constexpr int GL_KD_OFF = GL_QH_OFF + 64 * GL_RS * 2;
constexpr int GL_KT_OFF = GL_KD_OFF + 64 * GL_RS * 2;
constexpr int GL_QT_OFF = GL_KT_OFF + 64 * GL_RS * 2;
constexpr int GL_KO_OFF = GL_QT_OFF + 32 * GL_RS * 2;
constexpr int GL_V_OFF = GL_KO_OFF + 32 * GL_RS * 2;
constexpr int GL_RZ_OFF = GL_V_OFF + 2 * 64 * GL_VS * 2;
constexpr int GL_RQ_OFF = GL_RZ_OFF + 64 * GL_RS * 2;
constexpr int GL_OB_OFF = GL_RQ_OFF + 64 * GL_RS * 2;
constexpr int GL_SX_OFF = GL_OB_OFF + 64 * GL_VS * 2;
constexpr int GL_DEC_OFF = GL_SX_OFF + 2 * 128 * GL_RS * 2;
constexpr int GL_END = GL_DEC_OFF + 64 * 4;
static_assert(GL_END <= LDSCTL_OFF, "GLA LDS");
#define LDS_BARRIER() asm volatile("s_waitcnt lgkmcnt(0)\n\ts_barrier" ::: "memory")

template <int N> DI float dpp_row_shr(float x) { return __builtin_bit_cast(float, __builtin_amdgcn_update_dpp(0, __builtin_bit_cast(int, x), 0x110 + N, 0xf, 0xf, true)); }
DI float wave_scan_incl(float x, int lane) {
    x += dpp_row_shr<1>(x); x += dpp_row_shr<2>(x); x += dpp_row_shr<4>(x); x += dpp_row_shr<8>(x);
    x += __builtin_bit_cast(float, __builtin_amdgcn_update_dpp(0, __builtin_bit_cast(int, x), 0x142, 0xa, 0xf, false));
    x += __builtin_bit_cast(float, __builtin_amdgcn_update_dpp(0, __builtin_bit_cast(int, x), 0x143, 0xc, 0xf, false));
    (void)lane;
    return x;
}
DI float gla_lgamma(Frame& F, int l, int dir, int hh) { const float dl = fin(F, 8)[(l * 2 + dir) * 4 + hh]; return -__logf(1.0f + __expf(-dl)); }
DI bf16* gla_partial(Frame& F, int mixer, int dir, int dkh) {
    unsigned char* base = mixer == 0 ? (fout(F) + DO_OB) : (fws(F) + WS_OB1);
    return (bf16*)base + (size_t)(dir * 2 + dkh) * T_TOK * 512;
}

template <int I>
DI void gla_out_tile(const LAS bf16* Sc, const LAS bf16* Qh, const LAS bf16* Qt, const LAS bf16* Kd, const LAS bf16* Ko, const LAS bf16* Vc, LAS bf16* Ob, const int dvt, const int r, const int h, const int lane) {
    const LAS bf16* Qi = (I == 0) ? Qh : Qt;
    f32x16 acc;
#pragma unroll
    for (int i = 0; i < 16; ++i) acc[i] = 0.f;
#pragma unroll
    for (int ks = 0; ks < 4; ++ks) { const bf16x8 a = tr_frag(Sc, GL_VS, 16 * ks + 8 * h, 16 * ks + 8 * h + 4, 32 * dvt, lane), bb = *(const LAS bf16x8*)(Qi + r * GL_RS + ks * 16 + 8 * h); acc = MFMA32(a, bb, acc); }
    bf16x8 qb[4];
#pragma unroll
    for (int ks = 0; ks < 4; ++ks) qb[ks] = *(const LAS bf16x8*)(Qh + (32 * I + r) * GL_RS + ks * 16 + 8 * h);
#pragma unroll
    for (int J = 0; J <= I; ++J) {
        const LAS bf16* Ksrc = (J == I) ? (Kd + (32 * J) * GL_RS) : Ko;
        f32x16 s;
#pragma unroll
        for (int i = 0; i < 16; ++i) s[i] = 0.f;
#pragma unroll
        for (int ks = 0; ks < 4; ++ks) { const bf16x8 a = *(const LAS bf16x8*)(Ksrc + r * GL_RS + ks * 16 + 8 * h); s = MFMA32(a, qb[ks], s); }
        if (J == I) {
#pragma unroll
            for (int i = 0; i < 16; ++i) s[i] = (crow(i, h) <= r) ? s[i] : 0.f; }
#pragma unroll
        for (int s2 = 0; s2 < 2; ++s2) {
            u32x4 pw; pw.x = cvt_pk_bf16(s[8 * s2 + 0], s[8 * s2 + 1]); pw.y = cvt_pk_bf16(s[8 * s2 + 2], s[8 * s2 + 3]); pw.z = cvt_pk_bf16(s[8 * s2 + 4], s[8 * s2 + 5]); pw.w = cvt_pk_bf16(s[8 * s2 + 6], s[8 * s2 + 7]);
            const int rl = 32 * J + 16 * s2 + 4 * h;
            const bf16x8 a = tr_frag(Vc, GL_VS, rl, rl + 8, 32 * dvt, lane);
            acc = MFMA32(a, __builtin_bit_cast(bf16x8, pw), acc); }
    }
    LAS bf16* yo = Ob + (32 * I + r) * GL_VS + 32 * dvt + 4 * h;
#pragma unroll
    for (int g4 = 0; g4 < 4; ++g4) { u32x2 w0; w0.x = cvt_pk_bf16(acc[4 * g4], acc[4 * g4 + 1]); w0.y = cvt_pk_bf16(acc[4 * g4 + 2], acc[4 * g4 + 3]); *(LAS u32x2*)(yo + 8 * g4) = w0; }
}

DI void gla_seq_phase(Frame& F, int l, const float* lbp) {
    const bf16* P = (const bf16*)(fws(F) + WS_PROJ);
    const int tid = F.tid, lane = F.lane, w = F.wave, r = lane & 31, h = lane >> 5;
    LAS bf16* Qh = (LAS bf16*)(F.lds + GL_QH_OFF); LAS bf16* Kd = (LAS bf16*)(F.lds + GL_KD_OFF); LAS bf16* Qt = (LAS bf16*)(F.lds + GL_QT_OFF); LAS bf16* Kt = (LAS bf16*)(F.lds + GL_KT_OFF);
    LAS bf16* Ko = (LAS bf16*)(F.lds + GL_KO_OFF); LAS bf16* Vs = (LAS bf16*)(F.lds + GL_V_OFF); LAS bf16* Sx = (LAS bf16*)(F.lds + GL_SX_OFF); LAS float* dec = (LAS float*)(F.lds + GL_DEC_OFF);
    LAS bf16* Rz = (LAS bf16*)(F.lds + GL_RZ_OFF); LAS bf16* Rq = (LAS bf16*)(F.lds + GL_RQ_OFF); LAS bf16* Ob = (LAS bf16*)(F.lds + GL_OB_OFF);
    const int zrow = tid >> 3, zch = tid & 7, vrow0 = tid >> 4, vch = tid & 15;
    for (int unit = F.vcu; unit < 256; unit += F.G)
#pragma unroll 1
    for (int rp_ = 0; rp_ < 1 + (int)((((PH_DUP >> 17) & 1u) && unit < 128) || (((PH_DUP >> 18) & 1u) && unit >= 128)); ++rp_) {
        const int dkh = unit & 1, dir = (unit >> 1) & 1, hh = (unit >> 2) & 3, b = (unit >> 4) & 7, mixer = unit >> 7;
        const int qcol = mixer == 0 ? C_GQ : C_RQ, zcol = mixer == 0 ? (dir ? C_GZB : C_GZF) : C_RK, vcol = mixer == 0 ? C_GI : C_RV;
        const float lg = mixer == 1 ? gla_lgamma(F, l, dir, hh) : 0.f;
        const float rbu = (float)(lane + 1) * lg, rbeta = (lane >= 32) ? 32.f * lg : 0.f;
        const float rfa = __expf(rbu - rbeta), rfna = __expf(fminf(rbeta - rbu, 80.f)), rfkt = __expf(64.f * lg - rbu), re31 = __expf(32.f * lg), rdec = __expf(64.f * lg);
        const size_t rowb = (size_t)b * SEQ;
        bf16* ob = gla_partial(F, mixer, dir, dkh);
        const int dch = hh * 128 + 64 * dkh;
        float lbv[8];
#pragma unroll
        for (int j = 0; j < 8; ++j) lbv[j] = (mixer == 0 && lbp) ? lbp[dch + 8 * w + j] : 0.f;
        __syncthreads();
        for (int i = tid; i < 64 * GL_VS / 2; i += 512) ((LAS unsigned*)Sx)[i] = 0u;
        f32x16 st0, st1;
#pragma unroll
        for (int i = 0; i < 16; ++i) { st0[i] = 0.f; st1[i] = 0.f; }
        u32x4 zr, qr, vr0, vr1;
#define GLA_LOAD(cc) do { const int c_ = (cc); const bf16* s0_ = P + (rowb + c_ * 64 + (dir ? 63 - zrow : zrow)) * NPROJ; zr = *(const u32x4*)(s0_ + zcol + dch + 8 * zch); qr = *(const u32x4*)(s0_ + qcol + dch + 8 * zch); \
        const bf16* s1_ = P + (rowb + c_ * 64 + (dir ? 63 - vrow0 : vrow0)) * NPROJ + vcol + hh * 128 + 8 * vch; const bf16* s2_ = P + (rowb + c_ * 64 + (dir ? 63 - (vrow0 + 32) : (vrow0 + 32))) * NPROJ + vcol + hh * 128 + 8 * vch; \
        vr0 = *(const u32x4*)s1_; vr1 = *(const u32x4*)s2_; } while (0)
#define GLA_STASH(vb) do { *(LAS u32x4*)(Rz + zrow * GL_RS + 8 * zch) = zr; *(LAS u32x4*)(Rq + zrow * GL_RS + 8 * zch) = qr; \
        *(LAS u32x4*)(Vs + (vb) * (64 * GL_VS) + vrow0 * GL_VS + 8 * vch) = vr0; *(LAS u32x4*)(Vs + (vb) * (64 * GL_VS) + (vrow0 + 32) * GL_VS + 8 * vch) = vr1; } while (0)
        GLA_LOAD(dir ? 63 : 0);
        GLA_STASH(0);
        GLA_LOAD(dir ? 62 : 1);
        LDS_BARRIER();
#pragma unroll 1
        for (int cs = 0; cs < 64; ++cs) {
            const int c = dir ? 63 - cs : cs;
            if (cs > 0) { const int cp = dir ? 64 - cs : cs - 1;
#pragma unroll
                for (int k2 = 0; k2 < 2; ++k2) { const int u = vrow0 + 32 * k2; const u32x4 ov = *(const LAS u32x4*)(Ob + u * GL_VS + 8 * vch);
                    *(u32x4*)(ob + (rowb + cp * 64 + (dir ? 63 - u : u)) * 512 + hh * 128 + 8 * vch) = ov; } }
            float kk[8], bq[8], qv[8];
            unpack8(*(const LAS u32x4*)(Rz + lane * GL_RS + 8 * w), kk); unpack8(*(const LAS u32x4*)(Rq + lane * GL_RS + 8 * w), qv);
            float qh[8], kd[8], kq[8], kt[8];
            if (mixer == 1) {
#pragma unroll
                for (int j = 0; j < 8; ++j) { const float k2 = kk[j] * 0.08838834764831845f; qh[j] = qv[j] * rfa; kd[j] = k2 * rfna; kt[j] = k2 * rfkt; kq[j] = (lane >= 32 ? qh[j] : kd[j]) * re31; }
                if (lane < 8) dec[8 * w + lane] = rdec;
            } else {
#pragma unroll
            for (int j = 0; j < 8; ++j) { const float f = lbv[j] + (1.0f - lbv[j]) * __builtin_amdgcn_rcpf(1.0f + __builtin_amdgcn_exp2f(kk[j] * -1.4426950408889634f)); kk[j] = 1.0f - f; bq[j] = __builtin_amdgcn_logf(f); }
#pragma unroll
            for (int j = 0; j < 8; ++j) bq[j] = wave_scan_incl(bq[j], lane);
#pragma unroll
            for (int j = 0; j < 8; ++j) {
                const float b31 = __builtin_bit_cast(float, __builtin_amdgcn_readlane(__builtin_bit_cast(int, bq[j]), 31));
                const float bl = __builtin_bit_cast(float, __builtin_amdgcn_readlane(__builtin_bit_cast(int, bq[j]), 63));
                const bool up = lane >= 32; const float beta = up ? b31 : 0.f; const float a = bq[j] - beta;
                const float e31 = __builtin_amdgcn_exp2f(b31);
                qh[j] = qv[j] * __builtin_amdgcn_exp2f(a); kd[j] = kk[j] * __builtin_amdgcn_exp2f(fminf(-a, 115.f)); kt[j] = kk[j] * __builtin_amdgcn_exp2f(bl - bq[j]);
                kq[j] = (up ? qh[j] : kd[j]) * e31;
            }
            if (lane == 63) {
                *(LAS f32x4*)(dec + 8 * w) = (f32x4){__builtin_amdgcn_exp2f(bq[0]), __builtin_amdgcn_exp2f(bq[1]), __builtin_amdgcn_exp2f(bq[2]), __builtin_amdgcn_exp2f(bq[3])};
                *(LAS f32x4*)(dec + 8 * w + 4) = (f32x4){__builtin_amdgcn_exp2f(bq[4]), __builtin_amdgcn_exp2f(bq[5]), __builtin_amdgcn_exp2f(bq[6]), __builtin_amdgcn_exp2f(bq[7])}; }
            }
            { const int off = lane * GL_RS + 8 * w;
              *(LAS u32x4*)(Qh + off) = pack8(qh); *(LAS u32x4*)(Kd + off) = pack8(kd); *(LAS u32x4*)(Kt + off) = pack8(kt);
              if (lane < 32) *(LAS u32x4*)(Ko + off) = pack8(kq); else *(LAS u32x4*)(Qt + (lane - 32) * GL_RS + 8 * w) = pack8(kq); }
            LDS_BARRIER();
            if (cs + 1 < 64) { GLA_STASH((cs + 1) & 1); if (cs + 2 < 64) GLA_LOAD(dir ? 61 - cs : cs + 2); }
            const LAS bf16* Vc = Vs + (cs & 1) * (64 * GL_VS);
            if (w < 4) {
                gla_out_tile<0>(Sx + (cs & 1) * (64 * GL_VS), Qh, Qt, Kd, Ko, Vc, Ob, w, r, h, lane);
                const float dl0 = dec[r], dl1 = dec[32 + r];
                LAS bf16* Sn = Sx + ((cs + 1) & 1) * (64 * GL_VS);
#pragma unroll
                for (int i = 0; i < 16; ++i) { st0[i] *= dl0; st1[i] *= dl1; }
#pragma unroll
                for (int ks = 0; ks < 4; ++ks) {
                    const bf16x8 a = tr_frag(Vc, GL_VS, 16 * ks + 8 * h, 16 * ks + 8 * h + 4, 32 * w, lane);
                    const bf16x8 b0 = tr_frag(Kt, GL_RS, 16 * ks + 8 * h, 16 * ks + 8 * h + 4, 0, lane), b1 = tr_frag(Kt, GL_RS, 16 * ks + 8 * h, 16 * ks + 8 * h + 4, 32, lane);
                    st0 = MFMA32(a, b0, st0); st1 = MFMA32(a, b1, st1); }
#pragma unroll
                for (int g4 = 0; g4 < 4; ++g4) {
                    u32x2 w0; w0.x = cvt_pk_bf16(st0[4 * g4], st0[4 * g4 + 1]); w0.y = cvt_pk_bf16(st0[4 * g4 + 2], st0[4 * g4 + 3]); *(LAS u32x2*)(Sn + r * GL_VS + 32 * w + 8 * g4 + 4 * h) = w0;
                    u32x2 w1; w1.x = cvt_pk_bf16(st1[4 * g4], st1[4 * g4 + 1]); w1.y = cvt_pk_bf16(st1[4 * g4 + 2], st1[4 * g4 + 3]); *(LAS u32x2*)(Sn + (32 + r) * GL_VS + 32 * w + 8 * g4 + 4 * h) = w1; }
            } else gla_out_tile<1>(Sx + (cs & 1) * (64 * GL_VS), Qh, Qt, Kd, Ko, Vc, Ob, w & 3, r, h, lane);
            LDS_BARRIER();
        }
        { const int cp = dir ? 0 : 63;
#pragma unroll
          for (int k2 = 0; k2 < 2; ++k2) { const int u = vrow0 + 32 * k2; const u32x4 ov = *(const LAS u32x4*)(Ob + u * GL_VS + 8 * vch);
              *(u32x4*)(ob + (rowb + cp * 64 + (dir ? 63 - u : u)) * 512 + hh * 128 + 8 * vch) = ov; } }
#undef GLA_LOAD
#undef GLA_STASH
    }
}
DI void gla_norm_phase(Frame& F, int l) {
    const bf16* P = (const bf16*)(fws(F) + WS_PROJ); const bf16* Y = (const bf16*)(fout(F) + DO_Y); unsigned char* Y8 = fws(F) + WS_Y8; float* YSC = (float*)(fws(F) + WS_YSC);
    const int gw = F.vcu * 8 + F.wave, NGW = F.G * 8, lane = F.lane;
    const bf16* p0 = gla_partial(F, 0, 0, 0); const bf16* p1 = gla_partial(F, 1, 0, 0);
    const float* ng0 = fin(F, 7) + (size_t)l * 512 + lane * 8; const float* ng1 = fin(F, 9) + (size_t)l * 512 + lane * 8;
    float cwv[3][8];
    { const float* cw = fin(F, 5) + (size_t)l * 3 * 512 + lane * 8;
#pragma unroll
      for (int t3 = 0; t3 < 3; ++t3) { const f32x4 c0 = *(const f32x4*)(cw + t3 * 512), c1 = *(const f32x4*)(cw + t3 * 512 + 4); cwv[t3][0] = c0.x; cwv[t3][1] = c0.y; cwv[t3][2] = c0.z; cwv[t3][3] = c0.w; cwv[t3][4] = c1.x; cwv[t3][5] = c1.y; cwv[t3][6] = c1.z; cwv[t3][7] = c1.w; } }
    for (int tok = gw; tok < T_TOK; tok += NGW) {
        float v[32];
        const u32x4 ya = __builtin_nontemporal_load((const u32x4*)(Y + (size_t)tok * DM + lane * 8));
        const int tl = tok & (SEQ - 1); const bf16* cs = P + (size_t)tok * NPROJ + lane * 8;
        const u32x4 z4 = (u32x4){0u, 0u, 0u, 0u};
        const u32x4 cbw = *(const u32x4*)(cs + C_CB), cc1 = *(const u32x4*)(cs + C_CC), ch1 = *(const u32x4*)(cs + C_CH);
        const u32x4 cc0 = tl > 0 ? *(const u32x4*)(cs - NPROJ + C_CC) : z4, ch0 = tl > 0 ? *(const u32x4*)(cs - NPROJ + C_CH) : z4;
        const u32x4 cc2 = tl < SEQ - 1 ? *(const u32x4*)(cs + NPROJ + C_CC) : z4, ch2 = tl < SEQ - 1 ? *(const u32x4*)(cs + NPROJ + C_CH) : z4;
        u32x4 pa[4], pb[4];
#pragma unroll
        for (int part = 0; part < 4; ++part) { pa[part] = __builtin_nontemporal_load((const u32x4*)(p0 + ((size_t)part * T_TOK + tok) * 512 + lane * 8)); pb[part] = __builtin_nontemporal_load((const u32x4*)(p1 + ((size_t)part * T_TOK + tok) * 512 + lane * 8)); }
        const u32x4 g0 = __builtin_nontemporal_load((const u32x4*)(P + (size_t)tok * NPROJ + C_GO + lane * 8)), g1 = __builtin_nontemporal_load((const u32x4*)(P + (size_t)tok * NPROJ + C_RG + lane * 8));
        { float t8[8]; unpack8(ya, t8);
#pragma unroll
          for (int q = 0; q < 8; ++q) v[q] = t8[q];
          float a0[8], h0[8], a1[8], h1[8], a2[8], h2[8], bq8[8]; unpack8(cc0, a0); unpack8(ch0, h0); unpack8(cc1, a1); unpack8(ch1, h1); unpack8(cc2, a2); unpack8(ch2, h2); unpack8(cbw, bq8);
#pragma unroll
          for (int q = 0; q < 8; ++q) v[8 + q] = bq8[q] * (cwv[0][q] * (a0[q] * h0[q]) + cwv[1][q] * (a1[q] * h1[q]) + cwv[2][q] * (a2[q] * h2[q])); }
#pragma unroll
        for (int mixer = 0; mixer < 2; ++mixer) {
            float o[8];
#pragma unroll
            for (int q = 0; q < 8; ++q) o[q] = 0.f;
#pragma unroll
            for (int part = 0; part < 4; ++part) { float t8[8]; unpack8(mixer == 0 ? pa[part] : pb[part], t8);
#pragma unroll
                for (int q = 0; q < 8; ++q) o[q] += t8[q]; }
            float s1 = 0.f, s2 = 0.f;
#pragma unroll
            for (int q = 0; q < 8; ++q) { s1 += o[q]; s2 += o[q] * o[q]; }
            s1 += sx<1>(s1); s2 += sx<1>(s2); s1 += sx<2>(s1); s2 += sx<2>(s2); s1 += sx<4>(s1); s2 += sx<4>(s2); s1 += sx<8>(s1); s2 += sx<8>(s2);
            float mean = 0.f, rstd;
            if (mixer == 0) rstd = __builtin_amdgcn_rsqf(s2 * (1.f / 128.f) + HN_EPS);
            else { mean = s1 * (1.f / 128.f); const float var = fmaxf(s2 * (1.f / 128.f) - mean * mean, 0.f); rstd = __builtin_amdgcn_rsqf(var + HN_EPS); }
            const float* ng = mixer == 0 ? ng0 : ng1; const f32x4 n0 = *(const f32x4*)ng, n1 = *(const f32x4*)(ng + 4); const float nn[8] = {n0.x, n0.y, n0.z, n0.w, n1.x, n1.y, n1.z, n1.w};
            float gate[8]; unpack8(mixer == 0 ? g0 : g1, gate);
#pragma unroll
            for (int q = 0; q < 8; ++q) v[16 + 8 * mixer + q] = (o[q] - mean) * rstd * nn[q] * siluf_(gate[q]);
        }
        float am = 0.f;
#pragma unroll
        for (int q = 0; q < 32; ++q) am = fmaxf(am, fabsf(v[q]));
        am = wave_max(am); const float inv = am > 0.f ? 127.0f / am : 0.f;
#pragma unroll
        for (int j = 0; j < 4; ++j) { u32x2 w2; w2.x = q8(v[j * 8] * inv) | (q8(v[j * 8 + 1] * inv) << 8) | (q8(v[j * 8 + 2] * inv) << 16) | (q8(v[j * 8 + 3] * inv) << 24);
            w2.y = q8(v[j * 8 + 4] * inv) | (q8(v[j * 8 + 5] * inv) << 8) | (q8(v[j * 8 + 6] * inv) << 16) | (q8(v[j * 8 + 7] * inv) << 24); *(u32x2*)(Y8 + (size_t)tok * DM + lane * 8 + 512 * j) = w2; }
        if (lane == 0) YSC[tok] = am * (1.0f / 127.0f);
    }
}

DI float reduce16(const float (&v)[16], int lane) {
    float a[8];
#pragma unroll
    for (int e = 0; e < 8; ++e) { const bool up = (lane & 32) != 0; const float keep = up ? v[e + 8] : v[e], give = up ? v[e] : v[e + 8]; a[e] = keep + sx32(give, lane); }
    float b4[4];
#pragma unroll
    for (int e = 0; e < 4; ++e) { const bool up = (lane & 16) != 0; const float keep = up ? a[e + 4] : a[e], give = up ? a[e] : a[e + 4]; b4[e] = keep + sx<16>(give); }
    float c2[2];
#pragma unroll
    for (int e = 0; e < 2; ++e) { const bool up = (lane & 8) != 0; const float keep = up ? b4[e + 2] : b4[e], give = up ? b4[e] : b4[e + 2]; c2[e] = keep + sx<8>(give); }
    float d; { const bool up = (lane & 4) != 0; const float keep = up ? c2[1] : c2[0], give = up ? c2[0] : c2[1]; d = keep + sx<4>(give); }
    d += sx<2>(d); d += sx<1>(d);
    return d;
}
constexpr int RW_RS = 2056;
DI void ln1_router_phase(Frame& F, int l, bool dry = false) {
    bf16* H = (bf16*)(fws(F) + WS_H); const unsigned char* MIX = fws(F) + WS_MIX; const float* MSC = (const float*)(fws(F) + WS_MSC);
    const float* g = fin(F, 11) + (size_t)l * DM; const float* bb = fin(F, 12) + (size_t)l * DM; const float* rw = fin(F, 13); const float* rb = fin(F, 14);
    int* EID = (int*)(fws(F) + WS_EID); float* EW = (float*)(fws(F) + WS_EW); int* CNT = (int*)(fws(F) + WS_CNT); unsigned char* H8 = fws(F) + WS_H8; float* HS = (float*)(fws(F) + WS_HS);
    bf16* HO = H; if (dry) { HO = (bf16*)(fws(F) + WS_OB1); H8 = fout(F) + DO_OB; EID = (int*)(fws(F) + WS_Y8); EW = (float*)(fws(F) + WS_Y8 + MiB); CNT = (int*)(fws(F) + WS_Y8 + 2 * MiB); HS = (float*)(fws(F) + WS_Y8 + 3 * MiB); }
    LAS bf16* rwb = (LAS bf16*)F.lds;
    LAS float* gl = (LAS float*)(F.lds + 16 * RW_RS * 2); LAS float* bl = gl + DM;
    LAS int* cnt = (LAS int*)(F.lds + LDSCTL_OFF + 64);
    const int lane = F.lane;
    const float rbe = rb[lane & 15];
    __syncthreads();
    stage_gb(F, g, bb, gl, bl);
    { f32x4 rv[16];
#pragma unroll
      for (int it = 0; it < 16; ++it) rv[it] = *(const f32x4*)(rw + 4 * (F.tid + 512 * it));
#pragma unroll
      for (int it = 0; it < 16; ++it) { const int i = 4 * (F.tid + 512 * it), k = i >> 4, e = i & 15; rwb[e * RW_RS + k] = f2bf(rv[it].x); rwb[(e + 1) * RW_RS + k] = f2bf(rv[it].y); rwb[(e + 2) * RW_RS + k] = f2bf(rv[it].z); rwb[(e + 3) * RW_RS + k] = f2bf(rv[it].w); } }
    for (int ch = F.vcu; ch < 256; ch += F.G) {
        if (F.tid < 16) cnt[F.tid] = 0;
        __syncthreads();
        const int tok0 = ch * 128 + F.wave * 16;
        u32x4 ph[4]; u32x2 pm[4]; float psc[4];
#pragma unroll
        for (int j = 0; j < 4; ++j) { ph[j] = *(const u32x4*)(H + (size_t)tok0 * DM + lane * 8 + 512 * j); pm[j] = __builtin_nontemporal_load((const u32x2*)(MIX + (size_t)tok0 * DM + lane * 8 + 512 * j)); psc[j] = MSC[(size_t)tok0 * 8 + (lane >> 5) + 2 * j]; }
#pragma unroll 1
        for (int ti = 0; ti < 16; ++ti) {
            const int tok = tok0 + ti;
            float v[32]; float s = 0.f;
#pragma unroll
            for (int j = 0; j < 4; ++j) { float a[8], m8[8]; unpack8(ph[j], a); unpack_i8(pm[j], psc[j], m8);
#pragma unroll
                for (int q = 0; q < 8; ++q) { v[j * 8 + q] = ALPHA * a[q] + m8[q]; s += v[j * 8 + q]; } }
            if (ti + 1 < 16) {
#pragma unroll
                for (int j = 0; j < 4; ++j) { ph[j] = *(const u32x4*)(H + (size_t)(tok + 1) * DM + lane * 8 + 512 * j); pm[j] = __builtin_nontemporal_load((const u32x2*)(MIX + (size_t)(tok + 1) * DM + lane * 8 + 512 * j)); psc[j] = MSC[(size_t)(tok + 1) * 8 + (lane >> 5) + 2 * j]; } }
            const float mean = wave_sum(s) * (1.f / DM); float s2 = 0.f;
#pragma unroll
            for (int q = 0; q < 32; ++q) { v[q] -= mean; s2 += v[q] * v[q]; }
            const float rstd = 1.f / sqrtf(wave_sum(s2) * (1.f / DM) + LN_EPS);
            float am = 0.f;
#pragma unroll
            for (int j = 0; j < 4; ++j) { const int c0 = lane * 8 + 512 * j; const f32x4 g0 = *(const LAS f32x4*)(gl + c0), g1 = *(const LAS f32x4*)(gl + c0 + 4), b0 = *(const LAS f32x4*)(bl + c0), b1 = *(const LAS f32x4*)(bl + c0 + 4);
                const float gg[8] = {g0.x, g0.y, g0.z, g0.w, g1.x, g1.y, g1.z, g1.w}, bv[8] = {b0.x, b0.y, b0.z, b0.w, b1.x, b1.y, b1.z, b1.w};
                float o[8];
#pragma unroll
                for (int q = 0; q < 8; ++q) { o[q] = v[j * 8 + q] * rstd * gg[q] + bv[q]; v[j * 8 + q] = o[q]; am = fmaxf(am, fabsf(o[q])); }
                *(u32x4*)(HO + (size_t)tok * DM + c0) = pack8(o); }
            (void)am; (void)HS;
#pragma unroll
            for (int j = 0; j < 4; ++j) { u32x2 w2; w2.x = pg8::pk_fp8x4(v[j * 8] * pg8::ACT_SCALE, v[j * 8 + 1] * pg8::ACT_SCALE, v[j * 8 + 2] * pg8::ACT_SCALE, v[j * 8 + 3] * pg8::ACT_SCALE);
                w2.y = pg8::pk_fp8x4(v[j * 8 + 4] * pg8::ACT_SCALE, v[j * 8 + 5] * pg8::ACT_SCALE, v[j * 8 + 6] * pg8::ACT_SCALE, v[j * 8 + 7] * pg8::ACT_SCALE); *(u32x2*)(H8 + (size_t)tok * DM + lane * 8 + 512 * j) = w2; }
        }
        asm volatile("s_waitcnt vmcnt(0)" ::: "memory");
        f32x4 acc = (f32x4){0.f, 0.f, 0.f, 0.f};
        { const bf16* hrow = HO + (size_t)(tok0 + (lane & 15)) * DM + 8 * (lane >> 4); const LAS bf16* wrow = rwb + (lane & 15) * RW_RS + 8 * (lane >> 4);
#pragma unroll 16
          for (int st = 0; st < 64; ++st) { const bf16x8 a = *(const bf16x8*)(hrow + 32 * st), bq = *(const LAS bf16x8*)(wrow + 32 * st); acc = __builtin_amdgcn_mfma_f32_16x16x32_bf16(a, bq, acc, 0, 0, 0); } }
#pragma unroll
        for (int reg = 0; reg < 4; ++reg) {
            const int tok = tok0 + 4 * (lane >> 4) + reg; const int rowb = lane & 48;
            const float x = acc[reg] + rbe;
            float mx = x;
            mx = fmaxf(mx, sx<1>(mx)); mx = fmaxf(mx, sx<2>(mx)); mx = fmaxf(mx, sx<4>(mx)); mx = fmaxf(mx, sx<8>(mx));
            const float p = __expf(x - mx);
            float qa = -1.f, qc = -1.f;
#pragma unroll
            for (int q = 0; q < 4; ++q) { const float y = shfl_idx(p, (lane & ~3) + q); if (y > qa) { qc = qa; qa = y; } else if (y > qc) qc = y; }
            const float gs = qa + qc;
            int gsel = 0; float gbest = -1.f;
#pragma unroll
            for (int gi = 0; gi < 4; ++gi) { const float y = shfl_idx(gs, rowb + 4 * gi); if (y > gbest) { gbest = y; gsel = gi; } }
            int i1 = 0, i2 = 0; float p1 = -1.f, p2 = -1.f;
#pragma unroll
            for (int q = 0; q < 4; ++q) { const float y = shfl_idx(p, rowb + 4 * gsel + q); if (y > p1) { p2 = p1; i2 = i1; p1 = y; i1 = q; } else if (y > p2) { p2 = y; i2 = q; } }
            if ((lane & 15) == 0) { const float inv = 1.f / (p1 + p2); const int e1 = gsel * 4 + i1, e2 = gsel * 4 + i2;
                EID[tok * 2] = e1; EID[tok * 2 + 1] = e2; EW[tok * 2] = p1 * inv; EW[tok * 2 + 1] = p2 * inv;
                __hip_atomic_fetch_add(cnt + e1, 1, __ATOMIC_RELAXED, __HIP_MEMORY_SCOPE_WORKGROUP); __hip_atomic_fetch_add(cnt + e2, 1, __ATOMIC_RELAXED, __HIP_MEMORY_SCOPE_WORKGROUP); }
        }
        __syncthreads();
        if (F.tid < 16) CNT[ch * 16 + F.tid] = cnt[F.tid];
        __syncthreads();
    }
}
DI void assign_phase(Frame& F) {
    const int* EID = (const int*)(fws(F) + WS_EID); const int* CNT = (const int*)(fws(F) + WS_CNT);
    int* SOT = (int*)(fws(F) + WS_SOT); int* TOS = (int*)(fws(F) + WS_TOS); int* TST = (int*)(fws(F) + WS_TST);
    LAS int* tot = (LAS int*)F.lds;
    LAS int* base = tot + 16;
    LAS int* pre = base + 16;
    LAS int* eids = pre + 16;
    LAS int* part = eids + 256;
    const int tid = F.tid;
    const int e = tid & 15, pp = tid >> 4;
    int cv[8];
#pragma unroll
    for (int k = 0; k < 8; ++k) cv[k] = CNT[(pp * 8 + k) * 16 + e];
    __syncthreads();
    { int s = 0;
#pragma unroll
      for (int k = 0; k < 8; ++k) s += cv[k];
      part[pp * 16 + e] = s; }
    __syncthreads();
    if (tid < 16) { int s = 0; for (int q = 0; q < 32; ++q) s += part[q * 16 + tid]; tot[tid] = s; }
    __syncthreads();
    if (tid == 0) { int acc = 0; for (int q = 0; q < 16; ++q) { base[q] = acc; acc += (tot[q] + 255) & ~255; }
        if (F.bx == 0) { int tacc = 0; for (int q = 0; q < 16; ++q) { TST[q] = tacc; tacc += (tot[q] + 255) >> 8; } TST[16] = tacc; } }
    __syncthreads();
    if (F.bx == 0) { for (int q = 0; q < 16; ++q) { const int lo = base[q] + tot[q], hi = base[q] + ((tot[q] + 255) & ~255); for (int s = lo + tid; s < hi; s += 512) TOS[s] = 0; } }
    for (int ch = F.vcu; ch < 256; ch += F.G) {
        __syncthreads();
        { int s = 0;
#pragma unroll
          for (int k = 0; k < 8; ++k) s += (pp * 8 + k < ch) ? cv[k] : 0;
          part[pp * 16 + e] = s; }
        if (tid < 256) eids[tid] = EID[ch * 256 + tid];
        __syncthreads();
        if (tid < 16) { int s = 0; for (int q = 0; q < 32; ++q) s += part[q * 16 + tid]; pre[tid] = s; }
        __syncthreads();
        if (tid < 256) { const int ee = eids[tid]; int rank = 0; for (int j = 0; j < tid; ++j) rank += (eids[j] == ee) ? 1 : 0;
            const int pos = base[ee] + pre[ee] + rank; const int tok = ch * 128 + (tid >> 1);
            TOS[pos] = tok; SOT[ch * 256 + tid] = pos; }
    }
}
DI void unpack_f8(u32x2 w, float* o) {
    const f32x2 a = __builtin_amdgcn_cvt_pk_f32_fp8((int)w.x, false), b = __builtin_amdgcn_cvt_pk_f32_fp8((int)w.x, true), c = __builtin_amdgcn_cvt_pk_f32_fp8((int)w.y, false), d = __builtin_amdgcn_cvt_pk_f32_fp8((int)w.y, true);
    o[0] = a.x; o[1] = a.y; o[2] = b.x; o[3] = b.y; o[4] = c.x; o[5] = c.y; o[6] = d.x; o[7] = d.y; }
DI void combine_ln2_phase(Frame& F, int l, bool final_out, bool dry = false) {
    bf16* H = (bf16*)(fws(F) + WS_H); const unsigned char* YS = fws(F) + WS_YS;
    const float* g = fin(F, 18) + (size_t)l * DM; const float* bb = fin(F, 19) + (size_t)l * DM;
    const int* SOT = (const int*)(fws(F) + WS_SOT); const float* EW = (const float*)(fws(F) + WS_EW);
    float* OUT = (float*)fout(F); unsigned char* H8 = fws(F) + WS_H8; float* HS = (float*)(fws(F) + WS_HS);
    bf16* HO = H; if (dry) { HO = (bf16*)(fws(F) + WS_OB1); H8 = fws(F) + WS_Y8; HS = (float*)(fws(F) + WS_YSC); final_out = false; }
    const int gw = F.vcu * 8 + F.wave, NGW = F.G * 8, lane = F.lane;
    LAS float* gl = (LAS float*)F.lds; LAS float* bl = gl + DM;
    __syncthreads(); stage_gb(F, g, bb, gl, bl); __syncthreads();
    int s0n = 0, s1n = 0; float w0n = 0.f, w1n = 0.f;
    float w0c = 0.f, w1c = 0.f; u32x4 ph[4]; u32x2 py0[4], py1[4];
    if (gw < T_TOK) { const int s0 = SOT[gw * 2], s1 = SOT[gw * 2 + 1]; w0c = EW[gw * 2]; w1c = EW[gw * 2 + 1];
#pragma unroll
        for (int j = 0; j < 4; ++j) { const int c0 = lane * 8 + 512 * j; ph[j] = *(const u32x4*)(H + (size_t)gw * DM + c0); py0[j] = __builtin_nontemporal_load((const u32x2*)(YS + (size_t)s0 * DM + c0)); py1[j] = __builtin_nontemporal_load((const u32x2*)(YS + (size_t)s1 * DM + c0)); }
        if (gw + NGW < T_TOK) { const int t2 = gw + NGW; s0n = SOT[t2 * 2]; s1n = SOT[t2 * 2 + 1]; w0n = EW[t2 * 2]; w1n = EW[t2 * 2 + 1]; } }
    for (int tok = gw; tok < T_TOK; tok += NGW) {
        const float w0 = w0c * (1.0f / pg8::YS_SCALE), w1 = w1c * (1.0f / pg8::YS_SCALE);
        float v[32]; float s = 0.f;
#pragma unroll
        for (int j = 0; j < 4; ++j) { float a[8], y0[8], y1[8]; unpack8(ph[j], a); unpack_f8(py0[j], y0); unpack_f8(py1[j], y1);
#pragma unroll
            for (int q = 0; q < 8; ++q) { v[j * 8 + q] = ALPHA * a[q] + w0 * y0[q] + w1 * y1[q]; s += v[j * 8 + q]; } }
        if (tok + NGW < T_TOK) { const int t1 = tok + NGW; const int s0 = s0n, s1 = s1n; w0c = w0n; w1c = w1n;
#pragma unroll
            for (int j = 0; j < 4; ++j) { const int c0 = lane * 8 + 512 * j; ph[j] = *(const u32x4*)(H + (size_t)t1 * DM + c0); py0[j] = __builtin_nontemporal_load((const u32x2*)(YS + (size_t)s0 * DM + c0)); py1[j] = __builtin_nontemporal_load((const u32x2*)(YS + (size_t)s1 * DM + c0)); }
            if (t1 + NGW < T_TOK) { const int t2 = t1 + NGW; s0n = SOT[t2 * 2]; s1n = SOT[t2 * 2 + 1]; w0n = EW[t2 * 2]; w1n = EW[t2 * 2 + 1]; } }
        const float mean = wave_sum(s) * (1.f / DM); float s2 = 0.f;
#pragma unroll
        for (int q = 0; q < 32; ++q) { v[q] -= mean; s2 += v[q] * v[q]; }
        const float rstd = 1.f / sqrtf(wave_sum(s2) * (1.f / DM) + LN_EPS);
#pragma unroll
        for (int j = 0; j < 4; ++j) { const int c0 = lane * 8 + 512 * j; const f32x4 g0 = *(const LAS f32x4*)(gl + c0), g1 = *(const LAS f32x4*)(gl + c0 + 4), b0 = *(const LAS f32x4*)(bl + c0), b1 = *(const LAS f32x4*)(bl + c0 + 4);
            const float gg[8] = {g0.x, g0.y, g0.z, g0.w, g1.x, g1.y, g1.z, g1.w}, bv[8] = {b0.x, b0.y, b0.z, b0.w, b1.x, b1.y, b1.z, b1.w};
            float o[8];
#pragma unroll
            for (int q = 0; q < 8; ++q) { o[q] = v[j * 8 + q] * rstd * gg[q] + bv[q]; v[j * 8 + q] = o[q]; }
            if (final_out) { __builtin_nontemporal_store((f32x4){o[0], o[1], o[2], o[3]}, (f32x4*)(OUT + (size_t)tok * DM + c0)); __builtin_nontemporal_store((f32x4){o[4], o[5], o[6], o[7]}, (f32x4*)(OUT + (size_t)tok * DM + c0 + 4)); }
            else *(u32x4*)(HO + (size_t)tok * DM + c0) = pack8(o); }
        if (!final_out) { float am = 0.f;
#pragma unroll
            for (int q = 0; q < 32; ++q) am = fmaxf(am, fabsf(v[q]));
            am = wave_max(am); const float inv = am > 0.f ? 127.0f / am : 0.f;
#pragma unroll
            for (int j = 0; j < 4; ++j) { u32x2 w2; w2.x = q8(v[j * 8] * inv) | (q8(v[j * 8 + 1] * inv) << 8) | (q8(v[j * 8 + 2] * inv) << 16) | (q8(v[j * 8 + 3] * inv) << 24);
                w2.y = q8(v[j * 8 + 4] * inv) | (q8(v[j * 8 + 5] * inv) << 8) | (q8(v[j * 8 + 6] * inv) << 16) | (q8(v[j * 8 + 7] * inv) << 24); *(u32x2*)(H8 + (size_t)tok * DM + lane * 8 + 512 * j) = w2; }
            if (lane == 0) HS[tok] = am * (1.0f / 127.0f); }
    }
}

constexpr int PH_PER_LAYER = 9, N_PHASES = 2 + DEPTH * PH_PER_LAYER;
#ifndef PH_MASK
#define PH_MASK 0xFFFFFFFFu
#endif
#define PHM(b) ((PH_MASK >> (b)) & 1u)
#define REP(b) _Pragma("unroll") for (int rep_ = 0; rep_ < 1 + (int)((PH_DUP >> (b)) & 1u); ++rep_)
__global__ void __launch_bounds__(512, 2) mk_fwd(Args args) {
    extern __shared__ __attribute__((aligned(16))) unsigned char lds_raw[];
    Frame F;
    F.lds = (LAS unsigned char*)lds_raw;
    F.wave0 = __builtin_amdgcn_readfirstlane((int)threadIdx.x >> 6);
    frame_refresh(F);
    volatile LAS unsigned* MISC = (volatile LAS unsigned*)(F.lds + MISC_OFF);
    for (int u = F.tid; u < (LDS_BYTES - LDSCTL_OFF) / 4; u += 512) ((LAS unsigned*)(F.lds + LDSCTL_OFF))[u] = 0u;
    __syncthreads();
    unsigned* ctl = (unsigned*)(fws(F) + WS_CTL);
    XcdBarrier bar; bar.bar = ctl + CW_BAR; bar.x = 0; bar.st = nullptr;
    const int lo = args.ph_lo, hi = args.ph_hi;
    const bool multi = (hi - lo) > 1;
    if (multi) bar = xcd_barrier_post(ctl + CW_BAR, MISC + 8);
#define IN(k) (frame_refresh(F), (lo <= (k) && (k) < hi))
#define SEAM(k) do { if (lo <= (k) && (k) + 1 < hi) { _Pragma("unroll") for (int rb_ = 0; rb_ < 1 + (int)((PH_DUP >> 16) & 1u); ++rb_) { XcdBarrier b2_ = bar; asm volatile("" : "+s"(b2_.bar)); xcd_barrier(b2_); } } } while (0)
    if (IN(0) && PHM(0)) {
        REP(0) wabs_phase(F, 0);
        REP(14) ln_emb(F);
        if (F.bx == 0) { float* LB = (float*)(fws(F) + WS_TST + 128); const float* hl = fin(F, 6); for (int d = F.tid; d < 512; d += 512) LB[d] = 1.0f / (1.0f + __expf(hl[d] - hl[512 + d])); }
    }
    SEAM(0);
    if (IN(1) && PHM(0)) { REP(15) { convert_weights(F, 0); __syncthreads(); } }
    SEAM(1);
#pragma unroll 1
    for (int l = 0; l < DEPTH; ++l) {
        const int p0 = 2 + l * PH_PER_LAYER;
        const float* lbp = (l == 0) ? nullptr : (const float*)(fws(F) + WS_TST + 128);
        if (IN(p0 + 0) && PHM(1)) REP(1) {
            const float* ABS = (const float*)(fws(F) + WS_CTL + CTL_ABS) + (size_t)l * ABS_PER_LAYER;
            pg8::Gemm g{(const bf16*)(fws(F) + WS_H8), (const bf16*)(fws(F) + WS_WIN), DM / 2}; pg8::StaticOrder S; S.init(T_TOK / 256, NPROJ / 256, F.G, F.bx);
            pg8::EpiBf16Q E{(bf16*)(fws(F) + WS_PROJ), NPROJ, (const float*)(fws(F) + WS_HS), ABS + ABS_IN};
            pg8::gemm_phase<pg8::EpiBf16Q, pg8::StaticOrder, false>(F.lds, F.tid, g, S, E, nullptr);
            if (l == 0) { frame_refresh(F); wabs_tail(F, (T_TOK / 256) * (NPROJ / 256), 0, WABS_T1); }
        }
        SEAM(p0 + 0);
        if (IN(p0 + 1)) { if (PHM(4)) REP(4) gla_seq_phase(F, l, lbp); if (PHM(2)) REP(2) attn_phase(F, l); }
        SEAM(p0 + 1);
        if (IN(p0 + 2) && PHM(5)) REP(5) gla_norm_phase(F, l);
        SEAM(p0 + 2);
        if (IN(p0 + 3) && PHM(7)) REP(7) {
            __syncthreads();
            const float* ABS = (const float*)(fws(F) + WS_CTL + CTL_ABS) + (size_t)l * ABS_PER_LAYER;
            pg8::Gemm g{(const bf16*)(fws(F) + WS_Y8), (const bf16*)(fws(F) + WS_WOUT), DM / 2}; pg8::StaticOrder S; S.init(T_TOK / 256, DM / 256, F.G, F.bx);
            pg8::EpiI8Tile<true> E{fws(F) + WS_MIX, DM, (float*)(fws(F) + WS_MSC), 8, (const float*)(fws(F) + WS_YSC), ABS + ABS_OUT, (LAS float*)(F.lds + RING_BYTES)};
            pg8::gemm_phase<pg8::EpiI8Tile<true>, pg8::StaticOrder, false>(F.lds, F.tid, g, S, E, nullptr);
        }
        SEAM(p0 + 3);
        if (IN(p0 + 4) && PHM(8)) {
#pragma unroll 1
            for (int rep_ = 0; rep_ < 1 + (int)((PH_DUP >> 8) & 1u); ++rep_) ln1_router_phase(F, l, rep_ == 1); }
        SEAM(p0 + 4);
        if (IN(p0 + 5) && PHM(9)) REP(9) assign_phase(F);
        SEAM(p0 + 5);
        if (IN(p0 + 6) && PHM(10)) REP(10) {
            __syncthreads();
            const int* TST = (const int*)(fws(F) + WS_TST);
            const float* ABS = (const float*)(fws(F) + WS_CTL + CTL_ABS) + (size_t)l * ABS_PER_LAYER;
            pg8::Gemm g{(const bf16*)(fws(F) + WS_H8), (const bf16*)(fws(F) + WS_WGU), DM / 2}; pg8::MoeOrder S; S.init(__builtin_amdgcn_readfirstlane(TST[16]), 8, F.G, F.bx); S.tile_start = TST; S.expert_stride = (size_t)2048 * DM;
            pg8::EpiSwiGLUF8 E{fws(F) + WS_HID, DEXP, (const float*)(fws(F) + WS_GUS) + l * 2 * NEXP, TST}; (void)ABS;
            pg8::gemm_phase<pg8::EpiSwiGLUF8, pg8::MoeOrder, true>(F.lds, F.tid, g, S, E, (const int*)(fws(F) + WS_TOS));
            if (l == 0) { frame_refresh(F); const int nu = ((const int*)(fws(F) + WS_TST))[16] * 8; wabs_tail(F, nu, WABS_T1, wabs_t2(F.G, nu)); }
        }
        SEAM(p0 + 6);
        if (IN(p0 + 7) && PHM(11)) REP(11) {
            const int* TST = (const int*)(fws(F) + WS_TST);
            pg8::Gemm g{(const bf16*)(fws(F) + WS_HID), (const bf16*)(fws(F) + WS_WD), DEXP / 2}; pg8::MoeOrder S; S.init(__builtin_amdgcn_readfirstlane(TST[16]), 8, F.G, F.bx); S.tile_start = TST; S.expert_stride = (size_t)DM * DEXP;
            pg8::EpiF8Out E{fws(F) + WS_YS, DM, (const float*)(fws(F) + WS_WDS) + l * NEXP, TST};
            pg8::gemm_phase<pg8::EpiF8Out, pg8::MoeOrder, false>(F.lds, F.tid, g, S, E, nullptr);
            if (l == 0) { frame_refresh(F); const int nu = ((const int*)(fws(F) + WS_TST))[16] * 8; wabs_tail(F, nu, wabs_t2(F.G, nu), WABS_PER_L); }
        }
        SEAM(p0 + 7);
        if (IN(p0 + 8)) { if (PHM(12)) { if ((PH_DUP >> 12) & 1u) combine_ln2_phase(F, l, false, true); combine_ln2_phase(F, l, l == DEPTH - 1); } if (PHM(13) && l + 1 < DEPTH) { __syncthreads(); convert_weights(F, l + 1); } }
        if (l + 1 < DEPTH) SEAM(p0 + 8);
    }
#undef IN
#undef SEAM
}

extern "C" void kernel_launch(void* const* d_in, const int* in_sizes, int n_in, void* d_out, int out_size, void* d_ws, size_t ws_size, hipStream_t stream) {
    static int grid = 0;
    if (grid == 0) {
        if (n_in != 20 || out_size != T_TOK * DM || ws_size < WS_END) { fprintf(stderr, "kernel_launch: unexpected shapes (n_in %d out %d ws %zu)\n", n_in, out_size, ws_size); grid = -1; return; }
        int dev = 0, cus = 0;
        if (hipGetDevice(&dev) != hipSuccess || hipDeviceGetAttribute(&cus, hipDeviceAttributeMultiprocessorCount, dev) != hipSuccess) { grid = -1; return; }
        if (hipFuncSetAttribute((const void*)mk_fwd, hipFuncAttributeMaxDynamicSharedMemorySize, LDS_BYTES) != hipSuccess) { fprintf(stderr, "kernel_launch: hipFuncSetAttribute failed\n"); grid = -1; return; }
        int per_cu = 0;
        if (hipOccupancyMaxActiveBlocksPerMultiprocessor(&per_cu, (const void*)mk_fwd, 512, LDS_BYTES) != hipSuccess || per_cu < 1) fprintf(stderr, "kernel_launch: occupancy query reports %d\n", per_cu);
        (void)hipGetLastError();
        grid = cus;
    }
    if (grid < 0) return;
    (void)hipMemsetAsync((char*)d_ws + WS_CTL, 0, CTL_ZERO_BYTES, stream);
    Args a{};
    for (int i = 0; i < 20; ++i) a.in[i] = (const float*)d_in[i];
    a.out = (float*)d_out; a.ws = (unsigned char*)d_ws;
#if MK_ONE_LAUNCH
    a.ph_lo = 0; a.ph_hi = N_PHASES;
    hipLaunchKernelGGL(mk_fwd, dim3(grid), dim3(512), LDS_BYTES, stream, a);
#else
    for (int p = 0; p < N_PHASES; ++p) { a.ph_lo = p; a.ph_hi = p + 1; hipLaunchKernelGGL(mk_fwd, dim3(grid), dim3(512), LDS_BYTES, stream, a); }
#endif
}
```

```cpp
#include <hip/hip_runtime.h>
#ifndef PH_DUP
#define PH_DUP 0u
#endif
#include <cstdio>
#include <cstdint>

#ifndef MK_ONE_LAUNCH
#define MK_ONE_LAUNCH 1
#endif

#define LAS __attribute__((address_space(3)))
#define GAS __attribute__((address_space(1)))
typedef unsigned short bf16;
typedef short bf16x8 __attribute__((ext_vector_type(8)));
typedef short s16x4 __attribute__((ext_vector_type(4)));
typedef float f32x2 __attribute__((ext_vector_type(2)));
typedef float f32x4 __attribute__((ext_vector_type(4)));
typedef float f32x16 __attribute__((ext_vector_type(16)));
typedef unsigned u32x2 __attribute__((ext_vector_type(2)));
typedef unsigned u32x4 __attribute__((ext_vector_type(4)));
#define DI __device__ __forceinline__

constexpr int T_TOK = 32768, DM = 2048, SEQ = 4096, NBATCH = 8, NPROJ = 6912, NEXP = 16, DEXP = 1024, DEPTH = 2;
constexpr int SLOT_CAP = 69632;
constexpr float LN_EPS = 1e-5f, HN_EPS = 1e-6f, ALPHA = 1.41421356237f;
constexpr int C_AQ = 0, C_AK = 512, C_AV = 640, C_CB = 768, C_CC = 1280, C_CH = 1792, C_GQ = 2304, C_GZF = 2816, C_GZB = 3328, C_GI = 3840, C_GO = 4352,
              C_RQ = 4864, C_RK = 5376, C_RV = 5888, C_RG = 6400;

constexpr size_t MiB = 1u << 20, KiB = 1u << 10;
constexpr size_t WS_CTL = 0, CTL_ZERO_BYTES = 1 * MiB;
constexpr size_t WS_EID = 1 * MiB, WS_EW = WS_EID + 256 * KiB, WS_SOT = WS_EW + 256 * KiB, WS_TOS = WS_SOT + 256 * KiB, WS_CNT = WS_TOS + 272 * KiB, WS_TST = WS_CNT + 16 * KiB;
constexpr size_t WS_WDS = WS_TST + 3072;
constexpr size_t WS_GUS = WS_WDS + 128;
constexpr size_t WS_HS = 3 * MiB, WS_YSC = WS_HS + 128 * KiB;
constexpr size_t WS_WIN = 8 * MiB, WS_WOUT = 22 * MiB, WS_WGU = 26 * MiB, WS_WD = 90 * MiB;
constexpr size_t WS_H8 = 154 * MiB;
constexpr size_t WS_H = 235 * MiB, WS_PROJ = 363 * MiB, WS_OB1 = 795 * MiB, WS_Y8 = 923 * MiB, WS_END = 987 * MiB;
constexpr size_t WS_MIX = WS_PROJ, WS_MSC = WS_PROJ + 64 * MiB, WS_HID = WS_PROJ, WS_YS = WS_PROJ + 136 * MiB, WS_YSS = WS_YS + 136 * MiB;
static_assert(WS_TST + 4096 <= WS_HS && WS_YSC + 128 * KiB <= WS_WIN, "ws map");
static_assert(WS_WIN + (size_t)NPROJ * DM <= WS_WOUT && WS_WOUT + (size_t)DM * DM <= WS_WGU && WS_WGU + (size_t)NEXP * 2048 * DM <= WS_WD && WS_WD + (size_t)NEXP * DM * DEXP * 2 <= WS_H8 && WS_H8 + (size_t)T_TOK * DM <= WS_H, "ws map");
static_assert(WS_H + (size_t)T_TOK * DM * 2 <= WS_PROJ && WS_PROJ + (size_t)T_TOK * NPROJ * 2 <= WS_OB1 && WS_YSS + (size_t)SLOT_CAP * 8 * 4 <= WS_OB1 && WS_YS + (size_t)SLOT_CAP * DM <= WS_YSS && WS_MSC + (size_t)T_TOK * 8 * 4 <= WS_YS && WS_HID + (size_t)SLOT_CAP * DEXP * 2 <= WS_YS, "ws map");
constexpr size_t CTL_ABS = 64 * KiB; constexpr int ABS_IN = 0, ABS_OUT = NPROJ, ABS_GU = NPROJ + DM, ABS_PER_LAYER = NPROJ + DM + NEXP * 2048;
static_assert(CTL_ABS + (size_t)2 * ABS_PER_LAYER * 4 <= CTL_ZERO_BYTES, "ctl map");
constexpr size_t DO_Y = 0, DO_OB = 128 * MiB;
constexpr int CW_BAR = 4096;

constexpr int RING_BYTES = 131072, LDSCTL_OFF = 147456, MISC_OFF = LDSCTL_OFF + 320, LDS_BYTES = 148480;

typedef __bf16 bf16x2_t __attribute__((ext_vector_type(2)));
DI unsigned cvt_pk_bf16(float lo, float hi) { const f32x2 v = {lo, hi}; const bf16x2_t b = __builtin_convertvector(v, bf16x2_t); return __builtin_bit_cast(unsigned, b); }
DI float bf_lo(unsigned w) { return __uint_as_float(w << 16); }
DI float bf_hi(unsigned w) { return __uint_as_float(w & 0xffff0000u); }
DI float bf2f(bf16 b) { return __uint_as_float(((unsigned)b) << 16); }
DI bf16 f2bf(float f) { return (bf16)(cvt_pk_bf16(f, 0.f) & 0xffffu); }
DI int lane_fresh() { unsigned z = 0u; asm volatile("" : "+s"(z)); int ln = (int)__builtin_amdgcn_mbcnt_hi(~0u, __builtin_amdgcn_mbcnt_lo(~0u, z)); return ln; }
DI float shfl_idx(float v, int src_lane) { return __builtin_bit_cast(float, __builtin_amdgcn_ds_bpermute(src_lane << 2, __builtin_bit_cast(int, v))); }
template <int M> DI float sx(float v) { static_assert(M >= 1 && M < 32, "swizzle mask"); return __builtin_bit_cast(float, __builtin_amdgcn_ds_swizzle(__builtin_bit_cast(int, v), (M << 10) | 0x1f)); }
DI float sum32(float v) { return v + __builtin_bit_cast(float, __builtin_amdgcn_ds_bpermute((lane_fresh() ^ 32) << 2, __builtin_bit_cast(int, v))); }
DI float max32(float v) { return fmaxf(v, __builtin_bit_cast(float, __builtin_amdgcn_ds_bpermute((lane_fresh() ^ 32) << 2, __builtin_bit_cast(int, v)))); }
DI float sx32(float v, int lane) { return __builtin_bit_cast(float, __builtin_amdgcn_ds_bpermute((lane ^ 32) << 2, __builtin_bit_cast(int, v))); }
DI float wave_sum(float v) { v += sx<1>(v); v += sx<2>(v); v += sx<4>(v); v += sx<8>(v); v += sx<16>(v); return sum32(v); }
DI float wave_max(float v) { v = fmaxf(v, sx<1>(v)); v = fmaxf(v, sx<2>(v)); v = fmaxf(v, sx<4>(v)); v = fmaxf(v, sx<8>(v)); v = fmaxf(v, sx<16>(v)); return max32(v); }
DI float sigmoidf_(float z) { return __builtin_amdgcn_rcpf(1.0f + __expf(-z)); }
DI float siluf_(float z) { return z * __builtin_amdgcn_rcpf(1.0f + __expf(-z)); }
DI void unpack8(const u32x4 w, float (&f)[8]) { f[0] = bf_lo(w.x); f[1] = bf_hi(w.x); f[2] = bf_lo(w.y); f[3] = bf_hi(w.y); f[4] = bf_lo(w.z); f[5] = bf_hi(w.z); f[6] = bf_lo(w.w); f[7] = bf_hi(w.w); }
DI void unpack_i8(const u32x2 w, float sc, float (&f)[8]) {
#pragma unroll
    for (int k = 0; k < 4; ++k) { f[k] = (float)((int)(w.x << (24 - 8 * k)) >> 24) * sc; f[4 + k] = (float)((int)(w.y << (24 - 8 * k)) >> 24) * sc; }
}
DI u32x4 pack8(const float (&f)[8]) { u32x4 w; w.x = cvt_pk_bf16(f[0], f[1]); w.y = cvt_pk_bf16(f[2], f[3]); w.z = cvt_pk_bf16(f[4], f[5]); w.w = cvt_pk_bf16(f[6], f[7]); return w; }
DI int crow(int i, int h) { return (i & 3) + 8 * (i >> 2) + 4 * h; }
#define LDS_WAIT() asm volatile("s_waitcnt lgkmcnt(0)" ::: "memory")
#define VM_WAIT() asm volatile("s_waitcnt vmcnt(0)" ::: "memory")
#define MFMA32(a, b, c) __builtin_amdgcn_mfma_f32_32x32x16_bf16((a), (b), (c), 0, 0, 0)

namespace pg8 {
typedef unsigned short bf16_t;
constexpr int BM = 256, BK = 64, HALF = 128, HTB = HALF * BK * 2, STAGE_BYTES = 8 * HTB, NXCD = 8, WGM = 8;
__host__ __device__ __forceinline__ int lds_byte(int r, int c) { const int st = (r >> 4) * 2 + (c >> 5), rr = r & 15, cc = c & 31, ob = rr * 64 + cc * 2; return st * 1024 + (ob ^ (((ob >> 9) & 1) << 5)); }
__host__ __device__ __forceinline__ void stage_rc(int b, int& R, int& C) { const int st = b / 1024, sb = b % 1024, swz = sb ^ (((sb >> 9) & 1) << 5); R = (st >> 1) * 16 + swz / 64; C = (st & 1) * 32 + (swz % 64) / 2; }
__host__ __device__ __forceinline__ int perm32(int rho) { const int n = rho >> 4, i = rho & 15; return 8 * (i >> 2) + 4 * n + (i & 3); }

struct Unit { int pm, pn; };
struct Gemm { const bf16_t* A; const bf16_t* Bt; int K; };

struct StaticOrder {
    int nM, nN, nwg, G, c;
    DI void init(int nM_, int nN_, int G_, int c_) { nM = nM_; nN = nN_; nwg = nM * nN; G = G_; c = c_; }
    DI bool next(int i, Unit& u) const {
        const long L = (long)i * G + c; if (L >= nwg) return false;
        int wgid = (int)L; { const int q = nwg / NXCD, r = nwg % NXCD, xcd = wgid % NXCD, off = wgid / NXCD; wgid = (xcd < r ? xcd * (q + 1) : r * (q + 1) + (xcd - r) * q) + off; }
        const int nig = WGM * nN, gid = wgid / nig, fm = gid * WGM, gsz = (nM - fm) < WGM ? (nM - fm) : WGM;
        u.pm = fm + ((wgid % nig) % gsz); u.pn = (wgid % nig) / gsz; return true;
    }
    DI size_t b_off(const Unit& u, size_t tstep) const { return (size_t)u.pn * tstep; }
};
struct MoeOrder : StaticOrder {
    const int* tile_start; size_t expert_stride;
    DI bool next(int i, Unit& u) const { Unit t; const bool ok = StaticOrder::next(i, t); u.pm = __builtin_amdgcn_readfirstlane(t.pm); u.pn = __builtin_amdgcn_readfirstlane(t.pn); return ok; }
    DI size_t b_off(const Unit& u, size_t tstep) const {
        int e = 0;
#pragma unroll
        for (int j = 1; j < 16; ++j) e += (u.pm >= tile_start[j]) ? 1 : 0;
        e = __builtin_amdgcn_readfirstlane(e);
        return (size_t)e * expert_stride + (size_t)u.pn * tstep;
    }
};

typedef int i32x4 __attribute__((ext_vector_type(4)));
DI unsigned q8f(float x) { return (unsigned)(int)__builtin_rintf(x) & 0xffu; }
struct EpiBf16Q {
    static constexpr bool PERM = true, I8 = true, F8 = false;
    bf16_t* O; int ldc; const float* sa; const float* sb;
    DI void operator()(const f32x4 (&acc)[2][2][4][2], const Unit& u, int wr, int wc, int fr, int fq) const {
        const int row0 = u.pm * BM + wr * 64 + fr; const int col0 = u.pn * BM + wc * 32 + 8 * fq;
        f32x4 bv[2][2];
#pragma unroll
        for (int bj = 0; bj < 2; ++bj)
#pragma unroll
            for (int n = 0; n < 2; ++n) bv[bj][n] = *(const f32x4*)(sb + col0 + bj * HALF + 4 * n) * (1.0f / 127.0f);
#pragma unroll
        for (int ai = 0; ai < 2; ++ai)
#pragma unroll
            for (int m = 0; m < 4; ++m) { const int row = row0 + ai * HALF + m * 16; const float ra = sa[row]; bf16_t* rowp = O + (size_t)row * ldc + col0;
#pragma unroll
                for (int bj = 0; bj < 2; ++bj) { const f32x4 v0 = __builtin_convertvector(__builtin_bit_cast(i32x4, acc[ai][bj][m][0]), f32x4) * (bv[bj][0] * ra), v1 = __builtin_convertvector(__builtin_bit_cast(i32x4, acc[ai][bj][m][1]), f32x4) * (bv[bj][1] * ra);
                    u32x4 w; w.x = cvt_pk_bf16(v0[0], v0[1]); w.y = cvt_pk_bf16(v0[2], v0[3]); w.z = cvt_pk_bf16(v1[0], v1[1]); w.w = cvt_pk_bf16(v1[2], v1[3]);
                    *(u32x4*)(rowp + bj * HALF) = w; } }
    }
};
typedef int i32x8 __attribute__((ext_vector_type(8)));
constexpr float ACT_SCALE = 16.0f;
constexpr float HID_SCALE = 8.0f;
DI unsigned pk_fp8x4(float a, float b, float c, float d) {
    a = __builtin_amdgcn_fmed3f(a, -448.f, 448.f); b = __builtin_amdgcn_fmed3f(b, -448.f, 448.f); c = __builtin_amdgcn_fmed3f(c, -448.f, 448.f); d = __builtin_amdgcn_fmed3f(d, -448.f, 448.f);
    int w = __builtin_amdgcn_cvt_pk_fp8_f32(a, b, 0, false); w = __builtin_amdgcn_cvt_pk_fp8_f32(c, d, w, true); return (unsigned)w; }
struct EpiSwiGLUF8 {
    static constexpr bool PERM = true, I8 = false, F8 = true;
    unsigned char* O; int ldc; const float* gus; const int* tile_start;
    DI void operator()(const f32x4 (&acc)[2][2][4][2], const Unit& u, int wr, int wc, int fr, int fq) const {
        int e = 0;
#pragma unroll
        for (int j = 1; j < 16; ++j) e += (u.pm >= tile_start[j]) ? 1 : 0;
        const float mg = gus[2 * e], mu = gus[2 * e + 1] * HID_SCALE;
        const int row0 = u.pm * BM + wr * 64 + fr; const int col0 = u.pn * HALF + wc * 32 + 8 * fq;
#pragma unroll
        for (int ai = 0; ai < 2; ++ai)
#pragma unroll
            for (int m = 0; m < 4; ++m) { unsigned char* rowp = O + (size_t)(row0 + ai * HALF + m * 16) * ldc + col0;
                float o[8];
#pragma unroll
                for (int n = 0; n < 2; ++n)
#pragma unroll
                    for (int j = 0; j < 4; ++j) { const float g = acc[ai][0][m][n][j] * mg; o[n * 4 + j] = g * __builtin_amdgcn_rcpf(1.0f + __expf(-g)) * (acc[ai][1][m][n][j] * mu); }
                u32x2 w; w.x = pk_fp8x4(o[0], o[1], o[2], o[3]); w.y = pk_fp8x4(o[4], o[5], o[6], o[7]);
                *(u32x2*)rowp = w; }
    }
};
struct EpiSwiGLUQ {
    static constexpr bool PERM = true, I8 = true, F8 = false;
    unsigned char* O; int ldc; const float* sa; const float* sb; const int* rowmap; const int* tile_start;
    DI void operator()(const f32x4 (&acc)[2][2][4][2], const Unit& u, int wr, int wc, int fr, int fq) const {
        int e = 0;
#pragma unroll
        for (int j = 1; j < 16; ++j) e += (u.pm >= tile_start[j]) ? 1 : 0;
        const int row0 = u.pm * BM + wr * 64 + fr; const int col0 = u.pn * HALF + wc * 32 + 8 * fq, bcol0 = e * 2048 + u.pn * BM + wc * 32 + 8 * fq;
        f32x4 bv[2][2];
#pragma unroll
        for (int bj = 0; bj < 2; ++bj)
#pragma unroll
            for (int n = 0; n < 2; ++n) bv[bj][n] = *(const f32x4*)(sb + bcol0 + bj * HALF + 4 * n) * (1.0f / 127.0f);
#pragma unroll
        for (int ai = 0; ai < 2; ++ai)
#pragma unroll
            for (int m = 0; m < 4; ++m) { const int row = row0 + ai * HALF + m * 16; const float ra = sa[rowmap[row]]; unsigned char* rowp = O + (size_t)row * ldc + col0;
                float o[8];
#pragma unroll
                for (int n = 0; n < 2; ++n) { const f32x4 gv = __builtin_convertvector(__builtin_bit_cast(i32x4, acc[ai][0][m][n]), f32x4) * (bv[0][n] * ra), uv = __builtin_convertvector(__builtin_bit_cast(i32x4, acc[ai][1][m][n]), f32x4) * (bv[1][n] * ra);
#pragma unroll
                    for (int j = 0; j < 4; ++j) { const float g = gv[j]; o[n * 4 + j] = g * __builtin_amdgcn_rcpf(1.0f + __expf(-g)) * (uv[j] * HID_SCALE); } }
                u32x2 w; w.x = pk_fp8x4(o[0], o[1], o[2], o[3]); w.y = pk_fp8x4(o[4], o[5], o[6], o[7]);
                *(u32x2*)rowp = w; }
    }
};
template <bool QIN, bool F8IN = false> struct EpiI8Tile {
    static constexpr bool PERM = true, I8 = QIN, F8 = F8IN;
    unsigned char* O8; int ldc; float* SC; int ntile; const float* sa; const float* sb; LAS float* xch; const float* wds; const int* tile_start;
    DI void operator()(const f32x4 (&acc)[2][2][4][2], const Unit& u, int wr, int wc, int fr, int fq) const {
        const int row0 = u.pm * BM + wr * 64 + fr; const int col0 = u.pn * BM + wc * 32 + 8 * fq;
        float mul = 1.0f / 127.0f;
        if constexpr (F8IN) { int e = 0;
#pragma unroll
            for (int j = 1; j < 16; ++j) e += (u.pm >= tile_start[j]) ? 1 : 0;
            mul *= wds[e]; }
        f32x4 bv[2][2];
        if constexpr (QIN) {
#pragma unroll
            for (int bj = 0; bj < 2; ++bj)
#pragma unroll
                for (int n = 0; n < 2; ++n) bv[bj][n] = *(const f32x4*)(sb + col0 + bj * HALF + 4 * n) * (1.0f / 127.0f); }
        f32x4 v[2][4][2][2]; float lmax[2][4];
#pragma unroll
        for (int ai = 0; ai < 2; ++ai)
#pragma unroll
            for (int m = 0; m < 4; ++m) { float ra = 1.f; if constexpr (QIN) ra = sa[row0 + ai * HALF + m * 16]; float mx = 0.f;
#pragma unroll
                for (int bj = 0; bj < 2; ++bj)
#pragma unroll
                    for (int n = 0; n < 2; ++n) { f32x4 x; if constexpr (QIN) x = __builtin_convertvector(__builtin_bit_cast(i32x4, acc[ai][bj][m][n]), f32x4) * (bv[bj][n] * ra); else x = acc[ai][bj][m][n];
                        v[ai][m][bj][n] = x; mx = fmaxf(mx, fmaxf(fmaxf(fabsf(x[0]), fabsf(x[1])), fmaxf(fabsf(x[2]), fabsf(x[3])))); }
                mx = fmaxf(mx, sx<16>(mx)); mx = max32(mx);
                lmax[ai][m] = mx;
                if (fq == 0) xch[(ai * HALF + wr * 64 + m * 16 + fr) * 4 + wc] = mx; }
        asm volatile("s_waitcnt lgkmcnt(0)\n\ts_barrier" ::: "memory");
#pragma unroll
        for (int ai = 0; ai < 2; ++ai)
#pragma unroll
            for (int m = 0; m < 4; ++m) { const int rl = ai * HALF + wr * 64 + m * 16 + fr; const f32x4 q4 = *(const LAS f32x4*)(xch + rl * 4);
                const float rmax = fmaxf(fmaxf(q4[0], q4[1]), fmaxf(q4[2], q4[3])); const float inv = rmax > 0.f ? 127.0f * __builtin_amdgcn_rcpf(rmax) : 0.f;
                const int row = row0 + ai * HALF + m * 16;
                if (wc == 0 && fq == 0) SC[(size_t)row * ntile + u.pn] = rmax * mul;
                unsigned char* rowp = O8 + (size_t)row * ldc + col0;
#pragma unroll
                for (int bj = 0; bj < 2; ++bj) { const f32x4 x0 = v[ai][m][bj][0] * inv, x1 = v[ai][m][bj][1] * inv;
                    u32x2 w2; w2.x = q8f(x0[0]) | (q8f(x0[1]) << 8) | (q8f(x0[2]) << 16) | (q8f(x0[3]) << 24); w2.y = q8f(x1[0]) | (q8f(x1[1]) << 8) | (q8f(x1[2]) << 16) | (q8f(x1[3]) << 24);
                    *(u32x2*)(rowp + bj * HALF) = w2; } }
    }
};
constexpr float YS_SCALE = 64.0f;
struct EpiF8Out {
    static constexpr bool PERM = true, I8 = false, F8 = true;
    unsigned char* O8; int ldc; const float* wds; const int* tile_start;
    DI void operator()(const f32x4 (&acc)[2][2][4][2], const Unit& u, int wr, int wc, int fr, int fq) const {
        int e = 0;
#pragma unroll
        for (int j = 1; j < 16; ++j) e += (u.pm >= tile_start[j]) ? 1 : 0;
        const float mul = wds[e] * YS_SCALE;
        const int row0 = u.pm * BM + wr * 64 + fr; const int col0 = u.pn * BM + wc * 32 + 8 * fq;
#pragma unroll
        for (int ai = 0; ai < 2; ++ai)
#pragma unroll
            for (int m = 0; m < 4; ++m) { unsigned char* rowp = O8 + (size_t)(row0 + ai * HALF + m * 16) * ldc + col0;
#pragma unroll
                for (int bj = 0; bj < 2; ++bj) { const f32x4 x0 = acc[ai][bj][m][0] * mul, x1 = acc[ai][bj][m][1] * mul;
                    u32x2 w2; w2.x = pk_fp8x4(x0[0], x0[1], x0[2], x0[3]); w2.y = pk_fp8x4(x1[0], x1[1], x1[2], x1[3]);
                    *(u32x2*)(rowp + bj * HALF) = w2; } }
    }
};
struct EpiBf16 {
    static constexpr bool PERM = true, I8 = false, F8 = false;
    bf16_t* O; int ldc;
    DI void operator()(const f32x4 (&acc)[2][2][4][2], const Unit& u, int wr, int wc, int fr, int fq) const {
        const int row0 = u.pm * BM + wr * 64 + fr; const int col0 = u.pn * BM + wc * 32 + 8 * fq;
#pragma unroll
        for (int ai = 0; ai < 2; ++ai)
#pragma unroll
            for (int m = 0; m < 4; ++m) { bf16_t* rowp = O + (size_t)(row0 + ai * HALF + m * 16) * ldc + col0;
#pragma unroll
                for (int bj = 0; bj < 2; ++bj) { const f32x4 v0 = acc[ai][bj][m][0], v1 = acc[ai][bj][m][1];
                    u32x4 w; w.x = cvt_pk_bf16(v0[0], v0[1]); w.y = cvt_pk_bf16(v0[2], v0[3]); w.z = cvt_pk_bf16(v1[0], v1[1]); w.w = cvt_pk_bf16(v1[2], v1[3]);
                    *(u32x4*)(rowp + bj * HALF) = w; } }
    }
};
struct EpiSwiGLU {
    static constexpr bool PERM = true, I8 = false, F8 = false;
    bf16_t* O; int ldc;
    DI void operator()(const f32x4 (&acc)[2][2][4][2], const Unit& u, int wr, int wc, int fr, int fq) const {
        const int row0 = u.pm * BM + wr * 64 + fr; const int col0 = u.pn * HALF + wc * 32 + 8 * fq;
#pragma unroll
        for (int ai = 0; ai < 2; ++ai)
#pragma unroll
            for (int m = 0; m < 4; ++m) { bf16_t* rowp = O + (size_t)(row0 + ai * HALF + m * 16) * ldc + col0;
                float o[8];
#pragma unroll
                for (int n = 0; n < 2; ++n)
#pragma unroll
                    for (int j = 0; j < 4; ++j) { const float g = acc[ai][0][m][n][j], up = acc[ai][1][m][n][j]; o[n * 4 + j] = g * __builtin_amdgcn_rcpf(1.0f + __expf(-g)) * up; }
                u32x4 w; w.x = cvt_pk_bf16(o[0], o[1]); w.y = cvt_pk_bf16(o[2], o[3]); w.z = cvt_pk_bf16(o[4], o[5]); w.w = cvt_pk_bf16(o[6], o[7]);
                *(u32x4*)rowp = w; }
    }
};

template <class Epi, class Sched, bool GATHER>
DI void gemm_phase(LAS unsigned char* lds, const int tid, const Gemm g, const Sched& S, const Epi& E, const int* rowmap) {
    const int wid = __builtin_amdgcn_readfirstlane(tid >> 6), lane = tid & 63, wr = wid >> 2, wc = wid & 3, fr = lane & 15, fq = lane >> 4;
    const int K = g.K, nt = K / BK;
    unsigned voffA[2], voffB[2];
#pragma unroll
    for (int i = 0; i < 2; ++i) { int R, C; stage_rc(tid * 16 + i * 8192, R, C); const int Rb = Epi::PERM ? ((R & ~31) + perm32(R & 31)) : R;
        voffA[i] = (unsigned)(R * K + C) * 2u; voffB[i] = (unsigned)(Rb * K + C) * 2u; }
    const size_t kstep = (size_t)(BK * 2);
    const size_t hstep = (size_t)HALF * K * 2;
    const size_t tstep = 2 * hstep;
    const unsigned ldsw = (unsigned)wid * 1024u;
    const int aoff = lds_byte(wr * 64 + fr, fq * 8), boff = lds_byte(wc * 32 + fr, fq * 8);
#define PG8_SA(b, h) (((b) * 2 + (h)) * HTB)
#define PG8_SB(b, h) ((4 + (b) * 2 + (h)) * HTB)
#define PG8_STAGE(bufoff, gbase, voff) do { _Pragma("unroll") for (int _i = 0; _i < 2; ++_i) { unsigned vo_ = (voff)[_i]; asm volatile("" : "+v"(vo_)); \
        __builtin_amdgcn_global_load_lds((const unsigned*)((const char*)(gbase) + vo_), (LAS unsigned*)(lds + (bufoff) + ldsw + _i * 8192), 16, 0, 0); } } while (0)
#define PG8_LDA(dst, b, h) do { _Pragma("unroll") for (int m = 0; m < 4; ++m) { if constexpr (Epi::F8) { const i32x4 lo_ = *(const LAS i32x4*)(lds + PG8_SA(b, h) + aoff + m * 2048), hi_ = *(const LAS i32x4*)(lds + PG8_SA(b, h) + aoff + m * 2048 + 1024); \
            dst##8[m] = __builtin_shufflevector(lo_, hi_, 0, 1, 2, 3, 4, 5, 6, 7); } else { _Pragma("unroll") for (int k = 0; k < 2; ++k) dst[m][k] = *(const LAS bf16x8*)(lds + PG8_SA(b, h) + aoff + m * 2048 + k * 1024); } } } while (0)
#define PG8_LDB(dst, b, h) do { _Pragma("unroll") for (int n = 0; n < 2; ++n) { if constexpr (Epi::F8) { const i32x4 lo_ = *(const LAS i32x4*)(lds + PG8_SB(b, h) + boff + n * 2048), hi_ = *(const LAS i32x4*)(lds + PG8_SB(b, h) + boff + n * 2048 + 1024); \
            dst##8[n] = __builtin_shufflevector(lo_, hi_, 0, 1, 2, 3, 4, 5, 6, 7); } else { _Pragma("unroll") for (int k = 0; k < 2; ++k) dst[n][k] = *(const LAS bf16x8*)(lds + PG8_SB(b, h) + boff + n * 2048 + k * 1024); } } } while (0)
#define PG8_MMA(ai, bj, At, Bt) do { __builtin_amdgcn_s_setprio(1); _Pragma("unroll") for (int m = 0; m < 4; ++m) _Pragma("unroll") for (int n = 0; n < 2; ++n) _Pragma("unroll") for (int k = 0; k < 2; ++k) { \
        if constexpr (Epi::F8) { if (k == 0) acc[ai][bj][m][n] = __builtin_amdgcn_mfma_scale_f32_16x16x128_f8f6f4(Bt##8[n], At##8[m], acc[ai][bj][m][n], 0, 0, 0, 0, 0, 0); } \
        else if constexpr (Epi::I8) acc[ai][bj][m][n] = __builtin_bit_cast(f32x4, __builtin_amdgcn_mfma_i32_16x16x64_i8(__builtin_bit_cast(i32x4, Bt[n][k]), __builtin_bit_cast(i32x4, At[m][k]), __builtin_bit_cast(i32x4, acc[ai][bj][m][n]), 0, 0, 0)); \
        else acc[ai][bj][m][n] = __builtin_amdgcn_mfma_f32_16x16x32_bf16(Bt[n][k], At[m][k], acc[ai][bj][m][n], 0, 0, 0); } __builtin_amdgcn_s_setprio(0); } while (0)
#define PG8_WAIT_V(n) asm volatile("s_waitcnt vmcnt(" #n ")" ::: "memory")
#define PG8_WAIT_L(n) asm volatile("s_waitcnt lgkmcnt(" #n ")" ::: "memory")
#define PG8_BAR __builtin_amdgcn_s_barrier()
#define PG8_SCHED __builtin_amdgcn_sched_barrier(0)
    Unit cur, nxt; int ui = 0;
    if (!S.next(0, cur)) return;
    f32x4 acc[2][2][4][2];
#pragma unroll
    for (int a = 0; a < 2; ++a)
#pragma unroll
        for (int b = 0; b < 2; ++b)
#pragma unroll
            for (int m = 0; m < 4; ++m)
#pragma unroll
                for (int n = 0; n < 2; ++n) acc[a][b][m][n] = (f32x4){0.f, 0.f, 0.f, 0.f};
    bf16x8 At[4][2], B0[2][2], B1[2][2];
    i32x8 At8[4], B08[2], B18[2];
    unsigned cvA[2][2];
    const char* cA = (const char*)g.A + (GATHER ? (size_t)0 : (size_t)cur.pm * tstep);
#define PG8_LOAD_ROWS(unit) do { _Pragma("unroll") for (int h = 0; h < 2; ++h) _Pragma("unroll") for (int i = 0; i < 2; ++i) { int R, C; stage_rc(tid * 16 + i * 8192, R, C); \
        cvA[h][i] = (unsigned)(rowmap[(unit).pm * BM + h * HALF + R] * K + C) * 2u; } } while (0)
    if constexpr (GATHER) { PG8_LOAD_ROWS(cur); }
    const char* cB = (const char*)g.Bt + S.b_off(cur, tstep);
#define PG8_STAGE_A(bufoff, base_direct, koff_gather, h, usenext) do { if constexpr (GATHER) { PG8_STAGE(bufoff, (const char*)g.A + (koff_gather), cvA[h]); } \
        else { PG8_STAGE(bufoff, (base_direct), voffA); } } while (0)
    PG8_STAGE(PG8_SB(0, 0), cB, voffB); PG8_STAGE(PG8_SB(0, 1), cB + hstep, voffB); PG8_STAGE_A(PG8_SA(0, 0), cA, 0, 0, false); PG8_STAGE_A(PG8_SA(0, 1), cA + hstep, 0, 1, false);
    if (wr == 1) PG8_BAR;
    PG8_WAIT_V(2); PG8_BAR;
    PG8_STAGE(PG8_SB(1, 0), cB + kstep, voffB); PG8_STAGE_A(PG8_SA(1, 0), cA + kstep, kstep, 0, false); PG8_STAGE(PG8_SB(1, 1), cB + hstep + kstep, voffB);
    PG8_WAIT_V(6); PG8_BAR;
    for (;;) {
        const bool has_next = S.next(ui + 1, nxt);
        const char* nA = has_next ? (const char*)g.A + (GATHER ? (size_t)0 : (size_t)nxt.pm * tstep) : cA; const char* nB = has_next ? (const char*)g.Bt + S.b_off(nxt, tstep) : cB;
        for (int t = 0; t < nt; t += 2) {
            const bool last = (t == nt - 2);
            const char* a1 = cA + (size_t)(t + 1) * kstep;
            const char* a2 = last ? nA : cA + (size_t)(t + 2) * kstep; const char* b2 = last ? nB : cB + (size_t)(t + 2) * kstep;
            const char* a3 = a2 + kstep; const char* b3 = b2 + kstep;
            const size_t k1 = (size_t)(t + 1) * kstep, k2 = last ? (size_t)0 : (size_t)(t + 2) * kstep, k3 = k2 + kstep;
            PG8_LDB(B0, 0, 0); PG8_LDB(B1, 0, 1); PG8_SCHED; PG8_LDA(At, 0, 0); PG8_STAGE_A(PG8_SA(1, 1), a1 + hstep, k1, 1, false);
            if constexpr (GATHER) { if (last && has_next) { PG8_LOAD_ROWS(nxt); } }
            PG8_WAIT_V(8); PG8_WAIT_L(0); PG8_BAR; PG8_MMA(0, 0, At, B0); PG8_MMA(0, 1, At, B1); PG8_BAR; PG8_SCHED;
            PG8_LDA(At, 0, 1); PG8_STAGE(PG8_SB(0, 0), b2, voffB); PG8_STAGE(PG8_SB(0, 1), b2 + hstep, voffB); PG8_STAGE_A(PG8_SA(0, 0), a2, k2, 0, last);
            PG8_WAIT_V(8); PG8_WAIT_L(0); PG8_BAR; PG8_MMA(1, 0, At, B0); PG8_MMA(1, 1, At, B1); PG8_BAR; PG8_SCHED;
            PG8_LDB(B0, 1, 0); PG8_LDB(B1, 1, 1); PG8_SCHED; PG8_LDA(At, 1, 0); PG8_STAGE_A(PG8_SA(0, 1), a2 + hstep, k2, 1, last);
            PG8_WAIT_V(8); PG8_WAIT_L(0); PG8_BAR; PG8_MMA(0, 0, At, B0); PG8_MMA(0, 1, At, B1); PG8_BAR; PG8_SCHED;
            PG8_LDA(At, 1, 1); PG8_STAGE(PG8_SB(1, 0), b3, voffB); PG8_STAGE(PG8_SB(1, 1), b3 + hstep, voffB); PG8_STAGE_A(PG8_SA(1, 0), a3, k3, 0, last);
            PG8_WAIT_V(8); PG8_WAIT_L(0); PG8_BAR; PG8_MMA(1, 0, At, B0); PG8_MMA(1, 1, At, B1); PG8_BAR; PG8_SCHED;
        }
        if (wr == 0) PG8_BAR;
        { const int ln_ = lane_fresh(); int fr_ = ln_ & 15, fq_ = ln_ >> 4; asm volatile("" : "+v"(fr_), "+v"(fq_));
          E(acc, cur, wr, wc, fr_, fq_); }
        if (!has_next) break;
#pragma unroll
        for (int a = 0; a < 2; ++a)
#pragma unroll
            for (int b = 0; b < 2; ++b)
#pragma unroll
                for (int m = 0; m < 4; ++m)
#pragma unroll
                    for (int n = 0; n < 2; ++n) acc[a][b][m][n] = (f32x4){0.f, 0.f, 0.f, 0.f};
        cur = nxt; cA = nA; cB = nB; ++ui;
        if (wr == 1) PG8_BAR;
    }
    PG8_WAIT_V(0);
    PG8_BAR;
#undef PG8_SA
#undef PG8_SB
#undef PG8_STAGE
#undef PG8_STAGE_A
#undef PG8_LOAD_ROWS
#undef PG8_LDA
#undef PG8_LDB
#undef PG8_MMA
#undef PG8_WAIT_V
#undef PG8_WAIT_L
#undef PG8_BAR
#undef PG8_SCHED
}
}

#define XB_TMO      128
#define XB_XCNT(j)  (256  + 64 * (j))
#define XB_XSUB(j)  (1280 + 64 * (j))
#define XB_XGEN(j)  (2304 + 64 * (j))
#define XB_TOP      3328
#define XB_TOPGEN   3392
#define XCD_BAR_WORDS 3456
#define XB_SPIN_CAP (1u << 18)
__device__ __forceinline__ unsigned xb_ld(unsigned* p)              { return __hip_atomic_load(p, __ATOMIC_RELAXED, __HIP_MEMORY_SCOPE_AGENT); }
__device__ __forceinline__ unsigned xb_add(unsigned* p, unsigned v) { return __hip_atomic_fetch_add(p, v, __ATOMIC_RELAXED, __HIP_MEMORY_SCOPE_AGENT); }
__device__ __forceinline__ unsigned xb_xcc_id() { return (unsigned)__builtin_amdgcn_s_getreg((3 << 11) | 20) & 0xFu; }
#define XB_SPIN(cond, bar) do { unsigned _sp = 0; while (cond) { __builtin_amdgcn_s_sleep(1); \
    if ((++_sp & 255u) == 0u) { if (xb_ld(&(bar)[XB_TMO])) break; if (_sp > XB_SPIN_CAP) { atomicAdd(&(bar)[XB_TMO], 1u); break; } } } } while (0)
struct XcdBarrier { unsigned* bar; unsigned x; volatile LAS unsigned* st; };
__device__ __forceinline__ XcdBarrier xcd_barrier_post(unsigned* bar, volatile LAS unsigned* st) {
    XcdBarrier b; b.bar = bar; b.x = xb_xcc_id(); b.st = st;
    if (threadIdx.x == 0) (void)xb_add(&bar[XB_XCNT(b.x)], 1u);
    return b;
}
__device__ __forceinline__ void xcd_barrier_complete(unsigned* bar, unsigned x, unsigned& nloc, unsigned& nx) {
    const unsigned G = gridDim.x * gridDim.y * gridDim.z;
    unsigned sum, cnt, mine, sp = 0u;
    for (;;) {
        sum = 0u; cnt = 0u; mine = 0u;
#pragma unroll
        for (unsigned j = 0; j < 16; ++j) { const unsigned c = xb_ld(&bar[XB_XCNT(j)]); sum += c; cnt += (c > 0u) ? 1u : 0u; mine = (j == x) ? c : mine; }
        if (sum == G) break;
        __builtin_amdgcn_s_sleep(1);
        if ((++sp & 255u) == 0u) { if (xb_ld(&bar[XB_TMO])) break; if (sp > XB_SPIN_CAP) { atomicAdd(&bar[XB_TMO], 1u); break; } }
    }
    nloc = mine > 0u ? mine : 1u; nx = cnt > 0u ? cnt : 1u;
}
__device__ __forceinline__ void xcd_barrier(const XcdBarrier& b) {
    asm volatile("s_waitcnt vmcnt(0)" ::: "memory");
    __syncthreads();
    if (threadIdx.x == 0) {
        unsigned* bar = b.bar;
        __builtin_amdgcn_s_waitcnt(0);
        unsigned nloc = b.st[0], nx = b.st[1];
        if (nloc == 0u) { xcd_barrier_complete(bar, b.x, nloc, nx); b.st[0] = nloc; b.st[1] = nx; }
        const unsigned old = xb_add(&bar[XB_XSUB(b.x)], 1u);
        const unsigned gen = old / nloc;
        if (old + 1u == (gen + 1u) * nloc) {
            __builtin_amdgcn_fence(__ATOMIC_RELEASE, "agent");
            asm volatile("s_waitcnt vmcnt(0)" ::: "memory");
            const unsigned og = xb_add(&bar[XB_TOP], 1u);
            const unsigned tg = og / nx;
            if (og + 1u == (tg + 1u) * nx) xb_add(&bar[XB_TOPGEN], 1u);
            else XB_SPIN(xb_ld(&bar[XB_TOPGEN]) == tg, bar);
            __builtin_amdgcn_fence(__ATOMIC_ACQUIRE, "agent");
            xb_add(&bar[XB_XGEN(b.x)], 1u);
            asm volatile("s_waitcnt vmcnt(0)" ::: "memory");
        } else {
            XB_SPIN(xb_ld(&bar[XB_XGEN(b.x)]) == gen, bar);
            __builtin_amdgcn_fence(__ATOMIC_ACQUIRE, "agent");
            asm volatile("s_waitcnt vmcnt(0)" ::: "memory");
        }
    }
    __syncthreads();
}

struct Args { const float* in[20]; float* out; unsigned char* ws; int ph_lo, ph_hi; };
typedef __attribute__((address_space(4))) const unsigned char* kptr_t;
struct Frame {
    LAS unsigned char* lds;
    int tid, lane, wave, vcu, G, bx;
    int wave0;
    kptr_t ka;
};
DI void frame_refresh(Frame& F) {
    int wv = F.wave0; asm volatile("" : "+s"(wv)); int ln = lane_fresh(); asm volatile("" : "+v"(ln));
    F.lane = ln; F.wave = wv; F.tid = wv * 64 + ln;
    int g = gridDim.x; asm volatile("" : "+s"(g)); F.G = g; int bx = blockIdx.x; asm volatile("" : "+s"(bx)); F.bx = bx;
    F.vcu = (g % 8 == 0) ? (bx % 8) * (g / 8) + bx / 8 : bx;
    kptr_t p = (kptr_t)__builtin_amdgcn_kernarg_segment_ptr(); asm volatile("" : "+s"(p)); F.ka = p;
}
DI kptr_t karg_fresh() { kptr_t p = (kptr_t)__builtin_amdgcn_kernarg_segment_ptr(); asm volatile("" : "+s"(p)); return p; }
DI const float* fin(const Frame& F, int i) { return (const float*)(*(const GAS float* const __attribute__((address_space(4)))*)(F.ka + 8 * i)); }
DI unsigned char* fout(const Frame& F) { return (unsigned char*)(*(GAS unsigned char* const __attribute__((address_space(4)))*)(F.ka + 160)); }
DI unsigned char* fws(const Frame& F) { return (unsigned char*)(*(GAS unsigned char* const __attribute__((address_space(4)))*)(F.ka + 168)); }

typedef short v4i16_t __attribute__((ext_vector_type(4)));
DI s16x4 lds_tr(const LAS bf16* p) { return __builtin_bit_cast(s16x4, __builtin_amdgcn_ds_read_tr16_b64_v4i16((LAS v4i16_t*)p)); }
DI bf16x8 tr_frag(const LAS bf16* img, int stride, int row_lo, int row_hi, int colbase, int lane) {
    const int q = (lane & 15) >> 2, p = lane & 3, blk = (lane >> 4) & 1;
    const s16x4 lo = lds_tr(img + (row_lo + q) * stride + colbase + 16 * blk + 4 * p);
    const s16x4 hi = lds_tr(img + (row_hi + q) * stride + colbase + 16 * blk + 4 * p);
    return (bf16x8){lo[0], lo[1], lo[2], lo[3], hi[0], hi[1], hi[2], hi[3]};
}
DI void transpose_item(const float* W, int N, int K, int k0, int n0, bf16* WT, int dst_row0, LAS bf16* img, int lane) {
    const int kk = lane >> 4, n4 = (lane & 15) * 4;
    f32x4 v[16];
#pragma unroll
    for (int i = 0; i < 16; ++i) v[i] = __builtin_nontemporal_load((const f32x4*)(W + (size_t)(k0 + 4 * i + kk) * N + n0 + n4));
#pragma unroll
    for (int i = 0; i < 16; ++i) { u32x2 w2; w2.x = cvt_pk_bf16(v[i].x, v[i].y); w2.y = cvt_pk_bf16(v[i].z, v[i].w); *(LAS u32x2*)(img + (4 * i + kk) * 72 + n4) = w2; }
    LDS_WAIT(); asm volatile("" ::: "memory");
    const int r = lane & 31, h = lane >> 5;
#pragma unroll
    for (int cb = 0; cb < 2; ++cb)
#pragma unroll
        for (int kb = 0; kb < 4; ++kb) { const bf16x8 f = tr_frag(img, 72, 16 * kb + 8 * h, 16 * kb + 8 * h + 4, 32 * cb, lane);
            *(bf16x8*)(WT + (size_t)(dst_row0 + 32 * cb + r) * K + k0 + 16 * kb + 8 * h) = f; }
    LDS_WAIT(); asm volatile("" ::: "memory");
}
DI void wabs_item(const float* W, int N, int k0, int n0, unsigned* dst, int lane) {
    const float* p = W + (size_t)k0 * N + n0 + lane * 4;
    f32x4 m = (f32x4){0.f, 0.f, 0.f, 0.f};
#pragma unroll 8
    for (int k = 0; k < 128; ++k) { const f32x4 v = __builtin_nontemporal_load((const f32x4*)(p + (size_t)k * N)); m.x = fmaxf(m.x, fabsf(v.x)); m.y = fmaxf(m.y, fabsf(v.y)); m.z = fmaxf(m.z, fabsf(v.z)); m.w = fmaxf(m.w, fabsf(v.w)); }
    unsigned* d = dst + lane * 4;
    __hip_atomic_fetch_max(d + 0, __float_as_uint(m.x), __ATOMIC_RELAXED, __HIP_MEMORY_SCOPE_AGENT); __hip_atomic_fetch_max(d + 1, __float_as_uint(m.y), __ATOMIC_RELAXED, __HIP_MEMORY_SCOPE_AGENT);
    __hip_atomic_fetch_max(d + 2, __float_as_uint(m.z), __ATOMIC_RELAXED, __HIP_MEMORY_SCOPE_AGENT); __hip_atomic_fetch_max(d + 3, __float_as_uint(m.w), __ATOMIC_RELAXED, __HIP_MEMORY_SCOPE_AGENT);
}
constexpr int WABS_I_IN = (NPROJ / 256) * 16, WABS_I_OUT = (DM / 256) * 16, WABS_I_G1 = (DEXP / 256) * 16, WABS_I_GU = NEXP * 2 * WABS_I_G1, WABS_PER_L = WABS_I_IN + WABS_I_OUT;
DI void wabs_layer_item(Frame& F, int l, int r) {
    unsigned* A = (unsigned*)(fws(F) + WS_CTL + CTL_ABS) + (size_t)l * ABS_PER_LAYER;
    if (r < WABS_I_IN) { const int nb = r >> 4, kr = r & 15; wabs_item(fin(F, 3) + (size_t)l * DM * NPROJ, NPROJ, 128 * kr, 256 * nb, A + ABS_IN + 256 * nb, F.lane); return; } r -= WABS_I_IN;
    if (r < WABS_I_OUT) { const int nb = r >> 4, kr = r & 15; wabs_item(fin(F, 10) + (size_t)l * DM * DM, DM, 128 * kr, 256 * nb, A + ABS_OUT + 256 * nb, F.lane); return; } r -= WABS_I_OUT;
    { const int e = r / (2 * WABS_I_G1), r2 = r % (2 * WABS_I_G1), isup = r2 / WABS_I_G1, r3 = r2 % WABS_I_G1, nb = r3 >> 4, kr = r3 & 15;
      const float* W = (isup ? fin(F, 16) : fin(F, 15)) + ((size_t)l * NEXP + e) * DM * DEXP;
      const int n0 = 256 * nb; unsigned* dst = A + ABS_GU + e * 2048;
      const float* p = W + (size_t)(128 * kr) * DEXP + n0 + F.lane * 4;
      f32x4 m = (f32x4){0.f, 0.f, 0.f, 0.f};
#pragma unroll 8
      for (int k = 0; k < 128; ++k) { const f32x4 v = __builtin_nontemporal_load((const f32x4*)(p + (size_t)k * DEXP)); m.x = fmaxf(m.x, fabsf(v.x)); m.y = fmaxf(m.y, fabsf(v.y)); m.z = fmaxf(m.z, fabsf(v.z)); m.w = fmaxf(m.w, fabsf(v.w)); }
      const int n = n0 + F.lane * 4; unsigned* d = dst + 256 * (n >> 7) + 128 * isup + (n & 127);
      __hip_atomic_fetch_max(d + 0, __float_as_uint(m.x), __ATOMIC_RELAXED, __HIP_MEMORY_SCOPE_AGENT); __hip_atomic_fetch_max(d + 1, __float_as_uint(m.y), __ATOMIC_RELAXED, __HIP_MEMORY_SCOPE_AGENT);
      __hip_atomic_fetch_max(d + 2, __float_as_uint(m.z), __ATOMIC_RELAXED, __HIP_MEMORY_SCOPE_AGENT); __hip_atomic_fetch_max(d + 3, __float_as_uint(m.w), __ATOMIC_RELAXED, __HIP_MEMORY_SCOPE_AGENT); }
}
DI void wabs_phase(Frame& F, int l) {
    const int gw = F.vcu * 8 + F.wave, NGW = F.G * 8;
    for (int it = gw; it < WABS_PER_L; it += NGW) wabs_layer_item(F, l, it);
}
constexpr int WABS_T1 = WABS_PER_L < 1024 ? WABS_PER_L : 1024;
DI int wabs_t2(int G, int nunits) { const int nfull = nunits % G, nidle = nfull ? G - nfull : G; const int t2 = WABS_T1 + nidle * 8; return t2 < WABS_PER_L ? t2 : WABS_PER_L; }
DI void wabs_tail(Frame& F, int nunits, int lo, int hi) {
    const int nfull = nunits % F.G; const int nidle = nfull ? F.G - nfull : F.G; const int fi = nfull ? F.bx - nfull : F.bx;
    if (fi < 0) return;
    for (int it = lo + fi * 8 + F.wave; it < hi; it += nidle * 8) wabs_layer_item(F, 1, it);
}
DI unsigned q8(float x) { return (unsigned)(int)__builtin_rintf(x) & 0xffu; }
DI void transpose_item_q(const float* W, int N, int K8, int k0, int n0, unsigned char* WT8, int dst_row0, const float* amax, LAS bf16* img, int lane) {
    const int kk2 = lane >> 4, n4 = (lane & 15) * 4;
    const f32x4 am = *(const f32x4*)(amax + dst_row0 + n4);
    const f32x4 inv = (f32x4){am.x > 0.f ? 127.0f / am.x : 0.f, am.y > 0.f ? 127.0f / am.y : 0.f, am.z > 0.f ? 127.0f / am.z : 0.f, am.w > 0.f ? 127.0f / am.w : 0.f};
    f32x4 va[8], vb[8];
#pragma unroll
    for (int i = 0; i < 8; ++i) { const float* p = W + (size_t)(k0 + 8 * i + 2 * kk2) * N + n0 + n4; va[i] = __builtin_nontemporal_load((const f32x4*)p); vb[i] = __builtin_nontemporal_load((const f32x4*)(p + N)); }
#pragma unroll
    for (int i = 0; i < 8; ++i) { const f32x4 a = va[i] * inv, b2 = vb[i] * inv;
        const unsigned e0 = q8(a.x) | (q8(b2.x) << 8), e1 = q8(a.y) | (q8(b2.y) << 8), e2 = q8(a.z) | (q8(b2.z) << 8), e3 = q8(a.w) | (q8(b2.w) << 8);
        u32x2 w2; w2.x = e0 | (e1 << 16); w2.y = e2 | (e3 << 16); *(LAS u32x2*)(img + (4 * i + kk2) * 72 + n4) = w2; }
    LDS_WAIT(); asm volatile("" ::: "memory");
    const int r = lane & 31, h = lane >> 5;
#pragma unroll
    for (int cb = 0; cb < 2; ++cb)
#pragma unroll
        for (int kb = 0; kb < 2; ++kb) { const bf16x8 f = tr_frag(img, 72, 16 * kb + 8 * h, 16 * kb + 8 * h + 4, 32 * cb, lane);
            *(bf16x8*)(WT8 + (size_t)(dst_row0 + 32 * cb + r) * K8 + k0 + 32 * kb + 16 * h) = f; }
    LDS_WAIT(); asm volatile("" ::: "memory");
}
DI void transpose_item_f8(const float* W, int N, int K8, int k0, int n0, unsigned char* WT8, int dst_row0, const float scale, LAS bf16* img, int lane) {
    const int kk2 = lane >> 4, n4 = (lane & 15) * 4;
    f32x4 va[8], vb[8];
#pragma unroll
    for (int i = 0; i < 8; ++i) { const float* p = W + (size_t)(k0 + 8 * i + 2 * kk2) * N + n0 + n4; va[i] = __builtin_nontemporal_load((const f32x4*)p); vb[i] = __builtin_nontemporal_load((const f32x4*)(p + N)); }
#pragma unroll
    for (int i = 0; i < 8; ++i) { const f32x4 a = va[i] * scale, b2 = vb[i] * scale;
        u32x2 w2; w2.x = pg8::pk_fp8x4(a.x, b2.x, a.y, b2.y); w2.y = pg8::pk_fp8x4(a.z, b2.z, a.w, b2.w); *(LAS u32x2*)(img + (4 * i + kk2) * 72 + n4) = w2; }
    LDS_WAIT(); asm volatile("" ::: "memory");
    const int r = lane & 31, h = lane >> 5;
#pragma unroll
    for (int cb = 0; cb < 2; ++cb)
#pragma unroll
        for (int kb = 0; kb < 2; ++kb) { const bf16x8 f = tr_frag(img, 72, 16 * kb + 8 * h, 16 * kb + 8 * h + 4, 32 * cb, lane);
            *(bf16x8*)(WT8 + (size_t)(dst_row0 + 32 * cb + r) * K8 + k0 + 32 * kb + 16 * h) = f; }
    LDS_WAIT(); asm volatile("" ::: "memory");
}
DI void convert_weights(Frame& F, int l) {
    LAS bf16* img = (LAS bf16*)(F.lds + F.wave * 9216);
    const int gw = F.vcu * 8 + F.wave, NGW = F.G * 8;
    const float* w_in = fin(F, 3) + (size_t)l * DM * NPROJ; const float* w_out = fin(F, 10) + (size_t)l * DM * DM;
    const float* w_gate = fin(F, 15) + (size_t)l * NEXP * DM * DEXP; const float* w_up = fin(F, 16) + (size_t)l * NEXP * DM * DEXP; const float* w_down = fin(F, 17) + (size_t)l * NEXP * DEXP * DM;
    unsigned char* WIN = fws(F) + WS_WIN; unsigned char* WOUT = fws(F) + WS_WOUT; unsigned char* WGU = fws(F) + WS_WGU; unsigned char* WD = fws(F) + WS_WD;
    const float* ABS = (const float*)(fws(F) + WS_CTL + CTL_ABS) + (size_t)l * ABS_PER_LAYER;
    LAS float* wred = (LAS float*)(F.lds + 81920); LAS float* wsc = wred + 384;
    __syncthreads();
#pragma unroll 1
    for (int eb = 0; eb < 3 * NEXP; eb += 16) {
        f32x4 v[16];
#pragma unroll
        for (int i = 0; i < 16; ++i) { const int e = eb + i; const float* src = e < NEXP ? w_down + (size_t)e * DEXP * DM : ((e & 1) ? w_up : w_gate) + (size_t)((e - NEXP) >> 1) * DM * DEXP;
            v[i] = *(const f32x4*)(src + 4 * F.tid); }
#pragma unroll
        for (int i = 0; i < 16; ++i) { const float m = wave_max(fmaxf(fmaxf(fabsf(v[i].x), fabsf(v[i].y)), fmaxf(fabsf(v[i].z), fabsf(v[i].w)))); if (F.lane == 0) wred[(eb + i) * 8 + F.wave] = m; } }
    __syncthreads();
    if (F.tid < 3 * NEXP) { float m = 1e-30f;
#pragma unroll
        for (int j = 0; j < 8; ++j) m = fmaxf(m, wred[F.tid * 8 + j]);
        const float sc = exp2f(floorf(log2f(64.0f / m))); wsc[F.tid] = sc;
        if (F.bx == 0) { if (F.tid < NEXP) ((float*)(fws(F) + WS_WDS))[l * NEXP + F.tid] = 1.0f / (pg8::HID_SCALE * sc); else ((float*)(fws(F) + WS_GUS))[l * 2 * NEXP + F.tid - NEXP] = 1.0f / (pg8::ACT_SCALE * sc); } }
    __syncthreads();
    constexpr int I_IN = (DM / 64) * (NPROJ / 64), I_OUT = (DM / 64) * (DM / 64), I_G1 = (DM / 64) * (DEXP / 64), I_GU = NEXP * 2 * I_G1, I_D1 = (DEXP / 64) * (DM / 64), I_D = NEXP * I_D1;
    constexpr int NITEMS = I_IN + I_OUT + I_GU + I_D;
    for (int it = gw; it < NITEMS; it += NGW) {
        int r = it;
        if (r < I_IN) { const int nblk = NPROJ / 64, kb = r / nblk, nb = r % nblk; transpose_item_q(w_in, NPROJ, DM, 64 * kb, 64 * nb, WIN, 64 * nb, ABS + ABS_IN, img, F.lane); continue; } r -= I_IN;
        if (r < I_OUT) { const int nblk = DM / 64, kb = r / nblk, nb = r % nblk; transpose_item_q(w_out, DM, DM, 64 * kb, 64 * nb, WOUT, 64 * nb, ABS + ABS_OUT, img, F.lane); continue; } r -= I_OUT;
        if (r < I_GU) { const int e = r / (2 * I_G1), r2 = r % (2 * I_G1), isup = r2 / I_G1, r3 = r2 % I_G1; const int nblk = DEXP / 64, kb = r3 / nblk, nb = r3 % nblk, n0 = 64 * nb;
            const float* W = (isup ? w_up : w_gate) + (size_t)e * DM * DEXP;
            transpose_item_f8(W, DEXP, DM, 64 * kb, n0, WGU + (size_t)e * 2048 * DM, 256 * (n0 >> 7) + 128 * isup + (n0 & 127), wsc[NEXP + 2 * e + isup], img, F.lane); continue; } r -= I_GU;
        { const int e = r / I_D1, r3 = r % I_D1; const int nblk = DM / 64, kb = r3 / nblk, nb = r3 % nblk;
            transpose_item_f8(w_down + (size_t)e * DEXP * DM, DM, DEXP, 64 * kb, 64 * nb, WD + (size_t)e * DM * DEXP, 64 * nb, wsc[e], img, F.lane); }
    }
}
DI void stage_gb(Frame& F, const float* g, const float* bb, LAS float* gl, LAS float* bl) {
    const f32x4 gv = *(const f32x4*)(g + 4 * F.tid), bv = *(const f32x4*)(bb + 4 * F.tid);
    *(LAS f32x4*)(gl + 4 * F.tid) = gv; *(LAS f32x4*)(bl + 4 * F.tid) = bv;
}
DI void ln_emb(Frame& F) {
    const int gw = F.vcu * 8 + F.wave, NGW = F.G * 8;
    const float* x = fin(F, 0); const float* g = fin(F, 1); const float* bb = fin(F, 2); bf16* H = (bf16*)(fws(F) + WS_H); unsigned char* H8 = fws(F) + WS_H8; float* HS = (float*)(fws(F) + WS_HS);
    LAS float* gl = (LAS float*)F.lds; LAS float* bl = gl + DM;
    __syncthreads(); stage_gb(F, g, bb, gl, bl); __syncthreads();
    f32x4 pre[8];
    if (gw < T_TOK) { const f32x4* xr = (const f32x4*)(x + (size_t)gw * DM) + F.lane;
#pragma unroll
        for (int j = 0; j < 8; ++j) pre[j] = __builtin_nontemporal_load(xr + 64 * j); }
    for (int m = gw; m < T_TOK; m += NGW) {
        f32x4 v[8]; float s = 0.f;
#pragma unroll
        for (int j = 0; j < 8; ++j) { v[j] = pre[j]; s += (v[j].x + v[j].y) + (v[j].z + v[j].w); }
        if (m + NGW < T_TOK) { const f32x4* xr = (const f32x4*)(x + (size_t)(m + NGW) * DM) + F.lane;
#pragma unroll
            for (int j = 0; j < 8; ++j) pre[j] = __builtin_nontemporal_load(xr + 64 * j); }
        const float mean = wave_sum(s) * (1.f / DM); float s2 = 0.f;
#pragma unroll
        for (int j = 0; j < 8; ++j) { v[j] = v[j] - mean; s2 += (v[j].x * v[j].x + v[j].y * v[j].y) + (v[j].z * v[j].z + v[j].w * v[j].w); }
        const float rstd = 1.f / sqrtf(wave_sum(s2) * (1.f / DM) + LN_EPS);
        u32x2* o8 = (u32x2*)(H + (size_t)m * DM) + F.lane; float am = 0.f;
#pragma unroll
        for (int j = 0; j < 8; ++j) { const f32x4 gg = ((const LAS f32x4*)gl)[F.lane + 64 * j], bv = ((const LAS f32x4*)bl)[F.lane + 64 * j];
            v[j] = v[j] * rstd * gg + bv; am = fmaxf(fmaxf(am, fmaxf(fabsf(v[j].x), fabsf(v[j].y))), fmaxf(fabsf(v[j].z), fabsf(v[j].w)));
            u32x2 w; w.x = cvt_pk_bf16(v[j].x, v[j].y); w.y = cvt_pk_bf16(v[j].z, v[j].w); o8[64 * j] = w; }
        am = wave_max(am); const float inv = am > 0.f ? 127.0f / am : 0.f;
        unsigned* q4 = (unsigned*)(H8 + (size_t)m * DM) + F.lane;
#pragma unroll
        for (int j = 0; j < 8; ++j) q4[64 * j] = q8(v[j].x * inv) | (q8(v[j].y * inv) << 8) | (q8(v[j].z * inv) << 16) | (q8(v[j].w * inv) << 24);
        if (F.lane == 0) HS[m] = am * (1.0f / 127.0f);
    }
}

constexpr int AT_KS = 72, AT_VS = 392;
DI void attn_phase(Frame& F, int l) {
    const bf16* P = (const bf16*)(fws(F) + WS_PROJ); bf16* Y = (bf16*)(fout(F) + DO_Y);
    LAS bf16* Ks = (LAS bf16*)F.lds; LAS bf16* Vt = (LAS bf16*)(F.lds + 384 * AT_KS * 2);
    const int tid = F.tid, lane = F.lane, w = F.wave, r = lane & 31, h = lane >> 5;
    const float* sinkp = fin(F, 4) + l * 8;
    const bool deal = (F.G == 256);
    const int u_first = deal ? (F.vcu >= 128 ? (F.vcu - 128) * 4 : F.vcu * 4 + 3) : F.vcu, u_step = deal ? 1 : F.G, u_end = deal ? (F.vcu >= 128 ? (F.vcu - 128) * 4 + 3 : F.vcu * 4 + 4) : NBATCH * 32 * 2;
    for (int u = u_first; u < u_end; u += u_step) {
        const int kvh = u & 1, n = (u >> 1) & 31, b = u >> 6;
        const size_t rowb = (size_t)b * SEQ;
        __syncthreads();
        u32x4 kst[6], vst[6];
#pragma unroll
        for (int i = 0; i < 6; ++i) { const int idx = tid + 512 * i, row = idx >> 3, ch = idx & 7; const int tok = n * 128 - 128 + row;
            const int tc = tok < 0 ? 0 : (tok >= SEQ ? SEQ - 1 : tok); const bf16* src = P + (rowb + tc) * NPROJ; kst[i] = *(const u32x4*)(src + C_AK + kvh * 64 + ch * 8); vst[i] = *(const u32x4*)(src + C_AV + kvh * 64 + ch * 8); }
#pragma unroll
        for (int i = 0; i < 6; ++i) { const int idx = tid + 512 * i, row = idx >> 3, ch = idx & 7; const int tok = n * 128 - 128 + row;
            const bool okr = (tok >= 0) && (tok < SEQ); const u32x4 z4 = (u32x4){0u, 0u, 0u, 0u};
            const u32x4 kv = okr ? kst[i] : z4, vv = okr ? vst[i] : z4;
            *(LAS u32x4*)(Ks + row * AT_KS + ch * 8) = kv;
            LAS bf16* vd = Vt + (ch * 8) * AT_VS + row;
            vd[0 * AT_VS] = (bf16)(vv.x & 0xffffu); vd[1 * AT_VS] = (bf16)(vv.x >> 16); vd[2 * AT_VS] = (bf16)(vv.y & 0xffffu); vd[3 * AT_VS] = (bf16)(vv.y >> 16);
            vd[4 * AT_VS] = (bf16)(vv.z & 0xffffu); vd[5 * AT_VS] = (bf16)(vv.z >> 16); vd[6 * AT_VS] = (bf16)(vv.w & 0xffffu); vd[7 * AT_VS] = (bf16)(vv.w >> 16); }
        const int hq = kvh * 4 + (w >> 1);
        bf16x8 qn[4];
        { const bf16* qsrc = P + (rowb + n * 128 + (w & 1) * 64 + r) * NPROJ + C_AQ + hq * 64 + 8 * h;
#pragma unroll
          for (int ks = 0; ks < 4; ++ks) qn[ks] = *(const bf16x8*)(qsrc + ks * 16); }
        __syncthreads();
        const float slope2 = exp2f(-(float)(hq + 1)) * 1.4426950408889634f; const float sink2 = sinkp[hq] * 1.4426950408889634f; const float c1 = 0.125f * 1.4426950408889634f;
        const bool edge = (n == 0) || (n == 31); const int jlo = (n == 0) ? 128 : 0, jhi = (n == 31) ? 256 : 384;
#pragma unroll 1
        for (int qi = 0; qi < 2; ++qi) {
            const int t0 = (w & 1) * 64 + 32 * qi;
            bf16x8 qf[4];
#pragma unroll
            for (int ks = 0; ks < 4; ++ks) qf[ks] = qn[ks];
            if (qi == 0) { const bf16* qsrc = P + (rowb + n * 128 + t0 + 32 + r) * NPROJ + C_AQ + hq * 64 + 8 * h;
#pragma unroll
                for (int ks = 0; ks < 4; ++ks) qn[ks] = *(const bf16x8*)(qsrc + ks * 16); }
            float m = sink2, lsum = (h == 0) ? 1.0f : 0.0f;
            f32x16 O0, O1;
#pragma unroll
            for (int i = 0; i < 16; ++i) { O0[i] = 0.f; O1[i] = 0.f; }
#pragma unroll 1
            for (int kt = 0; kt < 9; ++kt) {
                const int j0 = t0 + 32 * kt;
                f32x16 s;
#pragma unroll
                for (int i = 0; i < 16; ++i) s[i] = 0.f;
#pragma unroll
                for (int ks = 0; ks < 4; ++ks) { const bf16x8 a = *(const LAS bf16x8*)(Ks + (j0 + r) * AT_KS + ks * 16 + 8 * h); s = MFMA32(a, qf[ks], s); }
                const float fbase = (float)(32 * kt - 128 - r + 4 * h);
#pragma unroll
                for (int i = 0; i < 16; ++i) { const float fd = fbase + (float)((i & 3) + 8 * (i >> 2)); s[i] = __builtin_fmaf(s[i], c1, -slope2 * __builtin_fabsf(fd)); }
                if (kt == 0 || kt == 8 || edge) {
#pragma unroll
                    for (int i = 0; i < 16; ++i) { const float fd = fbase + (float)((i & 3) + 8 * (i >> 2)); const int j = j0 + crow(i, h);
                        const bool ok = (__builtin_fabsf(fd) <= 128.f) && (j >= jlo) && (j < jhi); s[i] = ok ? s[i] : -INFINITY; } }
                float mx = -INFINITY;
#pragma unroll
                for (int i = 0; i < 16; ++i) mx = fmaxf(mx, s[i]);
                mx = max32(mx);
                const float mn = fmaxf(m, mx); const float sc = __builtin_amdgcn_exp2f(m - mn); m = mn;
                float ps = 0.f;
#pragma unroll
                for (int i = 0; i < 16; ++i) { const float p = __builtin_amdgcn_exp2f(s[i] - mn); s[i] = p; ps += p; }
                lsum = lsum * sc + ps;
#pragma unroll
                for (int i = 0; i < 16; ++i) { O0[i] *= sc; O1[i] *= sc; }
#pragma unroll
                for (int s2 = 0; s2 < 2; ++s2) {
                    u32x4 pw; pw.x = cvt_pk_bf16(s[8 * s2 + 0], s[8 * s2 + 1]); pw.y = cvt_pk_bf16(s[8 * s2 + 2], s[8 * s2 + 3]); pw.z = cvt_pk_bf16(s[8 * s2 + 4], s[8 * s2 + 5]); pw.w = cvt_pk_bf16(s[8 * s2 + 6], s[8 * s2 + 7]);
                    const bf16x8 pf = __builtin_bit_cast(bf16x8, pw);
                    const LAS bf16* vb = Vt + j0 + 16 * s2 + 4 * h;
                    { const u32x2 lo = *(const LAS u32x2*)(vb + r * AT_VS), hi = *(const LAS u32x2*)(vb + r * AT_VS + 8); const u32x4 aw = (u32x4){lo.x, lo.y, hi.x, hi.y}; O0 = MFMA32(__builtin_bit_cast(bf16x8, aw), pf, O0); }
                    { const u32x2 lo = *(const LAS u32x2*)(vb + (32 + r) * AT_VS), hi = *(const LAS u32x2*)(vb + (32 + r) * AT_VS + 8); const u32x4 aw = (u32x4){lo.x, lo.y, hi.x, hi.y}; O1 = MFMA32(__builtin_bit_cast(bf16x8, aw), pf, O1); }
                }
            }
            const float lt = sum32(lsum); const float inv = __builtin_amdgcn_rcpf(lt);
            bf16* yo = Y + (rowb + n * 128 + t0 + r) * DM + hq * 64 + 4 * h;
#pragma unroll
            for (int g4 = 0; g4 < 4; ++g4) {
                u32x2 w0; w0.x = cvt_pk_bf16(O0[4 * g4] * inv, O0[4 * g4 + 1] * inv); w0.y = cvt_pk_bf16(O0[4 * g4 + 2] * inv, O0[4 * g4 + 3] * inv); *(u32x2*)(yo + 8 * g4) = w0;
                u32x2 w1; w1.x = cvt_pk_bf16(O1[4 * g4] * inv, O1[4 * g4 + 1] * inv); w1.y = cvt_pk_bf16(O1[4 * g4 + 2] * inv, O1[4 * g4 + 3] * inv); *(u32x2*)(yo + 32 + 8 * g4) = w1; }
        }
    }
}

DI void conv_phase(Frame& F, int l) {
    const bf16* P = (const bf16*)(fws(F) + WS_PROJ); bf16* Y = (bf16*)(fout(F) + DO_Y);
    const float* cw = fin(F, 5) + (size_t)l * 3 * 512;
    const int nthr = F.G * 512;
    for (int it = F.vcu * 512 + F.tid; it < T_TOK * 64; it += nthr) {
        const int ch = it & 63, tok = it >> 6, tl = tok & (SEQ - 1);
        const bf16* src = P + (size_t)tok * NPROJ + ch * 8;
        float u0[8], u1[8], u2[8], bq[8], a[8], c[8];
        { const u32x4 cc = *(const u32x4*)(src + C_CC), hh = *(const u32x4*)(src + C_CH); unpack8(cc, a); unpack8(hh, c);
#pragma unroll
          for (int j = 0; j < 8; ++j) u1[j] = a[j] * c[j]; }
        if (tl > 0) { const u32x4 cc = *(const u32x4*)(src - NPROJ + C_CC), hh = *(const u32x4*)(src - NPROJ + C_CH); unpack8(cc, a); unpack8(hh, c);
#pragma unroll
          for (int j = 0; j < 8; ++j) u0[j] = a[j] * c[j]; }
        else {
#pragma unroll
          for (int j = 0; j < 8; ++j) u0[j] = 0.f; }
        if (tl < SEQ - 1) { const u32x4 cc = *(const u32x4*)(src + NPROJ + C_CC), hh = *(const u32x4*)(src + NPROJ + C_CH); unpack8(cc, a); unpack8(hh, c);
#pragma unroll
          for (int j = 0; j < 8; ++j) u2[j] = a[j] * c[j]; }
        else {
#pragma unroll
          for (int j = 0; j < 8; ++j) u2[j] = 0.f; }
        { const u32x4 bw = *(const u32x4*)(src + C_CB); unpack8(bw, bq); }
        float o[8];
#pragma unroll
        for (int j = 0; j < 8; ++j) { const int cidx = ch * 8 + j; o[j] = bq[j] * (cw[cidx] * u0[j] + cw[512 + cidx] * u1[j] + cw[1024 + cidx] * u2[j]); }
        *(u32x4*)(Y + (size_t)tok * DM + 512 + ch * 8) = pack8(o);
    }
}

constexpr int GL_RS = 72;
constexpr int GL_VS = 136;
constexpr int GL_QH_OFF = 0;
constexpr int GL_KD_OFF = GL_QH_OFF + 64 * GL_RS * 2;
constexpr int GL_KT_OFF = GL_KD_OFF + 64 * GL_RS * 2;
constexpr int GL_QT_OFF = GL_KT_OFF + 64 * GL_RS * 2;
constexpr int GL_KO_OFF = GL_QT_OFF + 32 * GL_RS * 2;
constexpr int GL_V_OFF = GL_KO_OFF + 32 * GL_RS * 2;
constexpr int GL_RZ_OFF = GL_V_OFF + 2 * 64 * GL_VS * 2;
constexpr int GL_RQ_OFF = GL_RZ_OFF + 64 * GL_RS * 2;
constexpr int GL_OB_OFF = GL_RQ_OFF + 64 * GL_RS * 2;
constexpr int GL_SX_OFF = GL_OB_OFF + 64 * GL_VS * 2;
constexpr int GL_DEC_OFF = GL_SX_OFF + 2 * 128 * GL_RS * 2;
constexpr int GL_END = GL_DEC_OFF + 64 * 4;
static_assert(GL_END <= LDSCTL_OFF, "GLA LDS");
#define LDS_BARRIER() asm volatile("s_waitcnt lgkmcnt(0)\n\ts_barrier" ::: "memory")

template <int N> DI float dpp_row_shr(float x) { return __builtin_bit_cast(float, __builtin_amdgcn_update_dpp(0, __builtin_bit_cast(int, x), 0x110 + N, 0xf, 0xf, true)); }
DI float wave_scan_incl(float x, int lane) {
    x += dpp_row_shr<1>(x); x += dpp_row_shr<2>(x); x += dpp_row_shr<4>(x); x += dpp_row_shr<8>(x);
    x += __builtin_bit_cast(float, __builtin_amdgcn_update_dpp(0, __builtin_bit_cast(int, x), 0x142, 0xa, 0xf, false));
    x += __builtin_bit_cast(float, __builtin_amdgcn_update_dpp(0, __builtin_bit_cast(int, x), 0x143, 0xc, 0xf, false));
    (void)lane;
    return x;
}
DI float gla_lgamma(Frame& F, int l, int dir, int hh) { const float dl = fin(F, 8)[(l * 2 + dir) * 4 + hh]; return -__logf(1.0f + __expf(-dl)); }
DI bf16* gla_partial(Frame& F, int mixer, int dir, int dkh) {
    unsigned char* base = mixer == 0 ? (fout(F) + DO_OB) : (fws(F) + WS_OB1);
    return (bf16*)base + (size_t)(dir * 2 + dkh) * T_TOK * 512;
}

template <int I>
DI void gla_out_tile(const LAS bf16* Sc, const LAS bf16* Qh, const LAS bf16* Qt, const LAS bf16* Kd, const LAS bf16* Ko, const LAS bf16* Vc, LAS bf16* Ob, const int dvt, const int r, const int h, const int lane) {
    const LAS bf16* Qi = (I == 0) ? Qh : Qt;
    f32x16 acc;
#pragma unroll
    for (int i = 0; i < 16; ++i) acc[i] = 0.f;
#pragma unroll
    for (int ks = 0; ks < 4; ++ks) { const bf16x8 a = tr_frag(Sc, GL_VS, 16 * ks + 8 * h, 16 * ks + 8 * h + 4, 32 * dvt, lane), bb = *(const LAS bf16x8*)(Qi + r * GL_RS + ks * 16 + 8 * h); acc = MFMA32(a, bb, acc); }
    bf16x8 qb[4];
#pragma unroll
    for (int ks = 0; ks < 4; ++ks) qb[ks] = *(const LAS bf16x8*)(Qh + (32 * I + r) * GL_RS + ks * 16 + 8 * h);
#pragma unroll
    for (int J = 0; J <= I; ++J) {
        const LAS bf16* Ksrc = (J == I) ? (Kd + (32 * J) * GL_RS) : Ko;
        f32x16 s;
#pragma unroll
        for (int i = 0; i < 16; ++i) s[i] = 0.f;
#pragma unroll
        for (int ks = 0; ks < 4; ++ks) { const bf16x8 a = *(const LAS bf16x8*)(Ksrc + r * GL_RS + ks * 16 + 8 * h); s = MFMA32(a, qb[ks], s); }
        if (J == I) {
#pragma unroll
            for (int i = 0; i < 16; ++i) s[i] = (crow(i, h) <= r) ? s[i] : 0.f; }
#pragma unroll
        for (int s2 = 0; s2 < 2; ++s2) {
            u32x4 pw; pw.x = cvt_pk_bf16(s[8 * s2 + 0], s[8 * s2 + 1]); pw.y = cvt_pk_bf16(s[8 * s2 + 2], s[8 * s2 + 3]); pw.z = cvt_pk_bf16(s[8 * s2 + 4], s[8 * s2 + 5]); pw.w = cvt_pk_bf16(s[8 * s2 + 6], s[8 * s2 + 7]);
            const int rl = 32 * J + 16 * s2 + 4 * h;
            const bf16x8 a = tr_frag(Vc, GL_VS, rl, rl + 8, 32 * dvt, lane);
            acc = MFMA32(a, __builtin_bit_cast(bf16x8, pw), acc); }
    }
    LAS bf16* yo = Ob + (32 * I + r) * GL_VS + 32 * dvt + 4 * h;
#pragma unroll
    for (int g4 = 0; g4 < 4; ++g4) { u32x2 w0; w0.x = cvt_pk_bf16(acc[4 * g4], acc[4 * g4 + 1]); w0.y = cvt_pk_bf16(acc[4 * g4 + 2], acc[4 * g4 + 3]); *(LAS u32x2*)(yo + 8 * g4) = w0; }
}

DI void gla_seq_phase(Frame& F, int l, const float* lbp) {
    const bf16* P = (const bf16*)(fws(F) + WS_PROJ);
    const int tid = F.tid, lane = F.lane, w = F.wave, r = lane & 31, h = lane >> 5;
    LAS bf16* Qh = (LAS bf16*)(F.lds + GL_QH_OFF); LAS bf16* Kd = (LAS bf16*)(F.lds + GL_KD_OFF); LAS bf16* Qt = (LAS bf16*)(F.lds + GL_QT_OFF); LAS bf16* Kt = (LAS bf16*)(F.lds + GL_KT_OFF);
    LAS bf16* Ko = (LAS bf16*)(F.lds + GL_KO_OFF); LAS bf16* Vs = (LAS bf16*)(F.lds + GL_V_OFF); LAS bf16* Sx = (LAS bf16*)(F.lds + GL_SX_OFF); LAS float* dec = (LAS float*)(F.lds + GL_DEC_OFF);
    LAS bf16* Rz = (LAS bf16*)(F.lds + GL_RZ_OFF); LAS bf16* Rq = (LAS bf16*)(F.lds + GL_RQ_OFF); LAS bf16* Ob = (LAS bf16*)(F.lds + GL_OB_OFF);
    const int zrow = tid >> 3, zch = tid & 7, vrow0 = tid >> 4, vch = tid & 15;
    for (int unit = F.vcu; unit < 256; unit += F.G)
#pragma unroll 1
    for (int rp_ = 0; rp_ < 1 + (int)((((PH_DUP >> 17) & 1u) && unit < 128) || (((PH_DUP >> 18) & 1u) && unit >= 128)); ++rp_) {
        const int dkh = unit & 1, dir = (unit >> 1) & 1, hh = (unit >> 2) & 3, b = (unit >> 4) & 7, mixer = unit >> 7;
        const int qcol = mixer == 0 ? C_GQ : C_RQ, zcol = mixer == 0 ? (dir ? C_GZB : C_GZF) : C_RK, vcol = mixer == 0 ? C_GI : C_RV;
        const float lg = mixer == 1 ? gla_lgamma(F, l, dir, hh) : 0.f;
        const float rbu = (float)(lane + 1) * lg, rbeta = (lane >= 32) ? 32.f * lg : 0.f;
        const float rfa = __expf(rbu - rbeta), rfna = __expf(fminf(rbeta - rbu, 80.f)), rfkt = __expf(64.f * lg - rbu), re31 = __expf(32.f * lg), rdec = __expf(64.f * lg);
        const size_t rowb = (size_t)b * SEQ;
        bf16* ob = gla_partial(F, mixer, dir, dkh);
        const int dch = hh * 128 + 64 * dkh;
        float lbv[8];
#pragma unroll
        for (int j = 0; j < 8; ++j) lbv[j] = (mixer == 0 && lbp) ? lbp[dch + 8 * w + j] : 0.f;
        __syncthreads();
        for (int i = tid; i < 64 * GL_VS / 2; i += 512) ((LAS unsigned*)Sx)[i] = 0u;
        f32x16 st0, st1;
#pragma unroll
        for (int i = 0; i < 16; ++i) { st0[i] = 0.f; st1[i] = 0.f; }
        u32x4 zr, qr, vr0, vr1;
#define GLA_LOAD(cc) do { const int c_ = (cc); const bf16* s0_ = P + (rowb + c_ * 64 + (dir ? 63 - zrow : zrow)) * NPROJ; zr = *(const u32x4*)(s0_ + zcol + dch + 8 * zch); qr = *(const u32x4*)(s0_ + qcol + dch + 8 * zch); \
        const bf16* s1_ = P + (rowb + c_ * 64 + (dir ? 63 - vrow0 : vrow0)) * NPROJ + vcol + hh * 128 + 8 * vch; const bf16* s2_ = P + (rowb + c_ * 64 + (dir ? 63 - (vrow0 + 32) : (vrow0 + 32))) * NPROJ + vcol + hh * 128 + 8 * vch; \
        vr0 = *(const u32x4*)s1_; vr1 = *(const u32x4*)s2_; } while (0)
#define GLA_STASH(vb) do { *(LAS u32x4*)(Rz + zrow * GL_RS + 8 * zch) = zr; *(LAS u32x4*)(Rq + zrow * GL_RS + 8 * zch) = qr; \
        *(LAS u32x4*)(Vs + (vb) * (64 * GL_VS) + vrow0 * GL_VS + 8 * vch) = vr0; *(LAS u32x4*)(Vs + (vb) * (64 * GL_VS) + (vrow0 + 32) * GL_VS + 8 * vch) = vr1; } while (0)
        GLA_LOAD(dir ? 63 : 0);
        GLA_STASH(0);
        GLA_LOAD(dir ? 62 : 1);
        LDS_BARRIER();
#pragma unroll 1
        for (int cs = 0; cs < 64; ++cs) {
            const int c = dir ? 63 - cs : cs;
            if (cs > 0) { const int cp = dir ? 64 - cs : cs - 1;
#pragma unroll
                for (int k2 = 0; k2 < 2; ++k2) { const int u = vrow0 + 32 * k2; const u32x4 ov = *(const LAS u32x4*)(Ob + u * GL_VS + 8 * vch);
                    *(u32x4*)(ob + (rowb + cp * 64 + (dir ? 63 - u : u)) * 512 + hh * 128 + 8 * vch) = ov; } }
            float kk[8], bq[8], qv[8];
            unpack8(*(const LAS u32x4*)(Rz + lane * GL_RS + 8 * w), kk); unpack8(*(const LAS u32x4*)(Rq + lane * GL_RS + 8 * w), qv);
            float qh[8], kd[8], kq[8], kt[8];
            if (mixer == 1) {
#pragma unroll
                for (int j = 0; j < 8; ++j) { const float k2 = kk[j] * 0.08838834764831845f; qh[j] = qv[j] * rfa; kd[j] = k2 * rfna; kt[j] = k2 * rfkt; kq[j] = (lane >= 32 ? qh[j] : kd[j]) * re31; }
                if (lane < 8) dec[8 * w + lane] = rdec;
            } else {
#pragma unroll
            for (int j = 0; j < 8; ++j) { const float f = lbv[j] + (1.0f - lbv[j]) * __builtin_amdgcn_rcpf(1.0f + __builtin_amdgcn_exp2f(kk[j] * -1.4426950408889634f)); kk[j] = 1.0f - f; bq[j] = __builtin_amdgcn_logf(f); }
#pragma unroll
            for (int j = 0; j < 8; ++j) bq[j] = wave_scan_incl(bq[j], lane);
#pragma unroll
            for (int j = 0; j < 8; ++j) {
                const float b31 = __builtin_bit_cast(float, __builtin_amdgcn_readlane(__builtin_bit_cast(int, bq[j]), 31));
                const float bl = __builtin_bit_cast(float, __builtin_amdgcn_readlane(__builtin_bit_cast(int, bq[j]), 63));
                const bool up = lane >= 32; const float beta = up ? b31 : 0.f; const float a = bq[j] - beta;
                const float e31 = __builtin_amdgcn_exp2f(b31);
                qh[j] = qv[j] * __builtin_amdgcn_exp2f(a); kd[j] = kk[j] * __builtin_amdgcn_exp2f(fminf(-a, 115.f)); kt[j] = kk[j] * __builtin_amdgcn_exp2f(bl - bq[j]);
                kq[j] = (up ? qh[j] : kd[j]) * e31;
            }
            if (lane == 63) {
                *(LAS f32x4*)(dec + 8 * w) = (f32x4){__builtin_amdgcn_exp2f(bq[0]), __builtin_amdgcn_exp2f(bq[1]), __builtin_amdgcn_exp2f(bq[2]), __builtin_amdgcn_exp2f(bq[3])};
                *(LAS f32x4*)(dec + 8 * w + 4) = (f32x4){__builtin_amdgcn_exp2f(bq[4]), __builtin_amdgcn_exp2f(bq[5]), __builtin_amdgcn_exp2f(bq[6]), __builtin_amdgcn_exp2f(bq[7])}; }
            }
            { const int off = lane * GL_RS + 8 * w;
              *(LAS u32x4*)(Qh + off) = pack8(qh); *(LAS u32x4*)(Kd + off) = pack8(kd); *(LAS u32x4*)(Kt + off) = pack8(kt);
              if (lane < 32) *(LAS u32x4*)(Ko + off) = pack8(kq); else *(LAS u32x4*)(Qt + (lane - 32) * GL_RS + 8 * w) = pack8(kq); }
            LDS_BARRIER();
            if (cs + 1 < 64) { GLA_STASH((cs + 1) & 1); if (cs + 2 < 64) GLA_LOAD(dir ? 61 - cs : cs + 2); }
            const LAS bf16* Vc = Vs + (cs & 1) * (64 * GL_VS);
            if (w < 4) {
                gla_out_tile<0>(Sx + (cs & 1) * (64 * GL_VS), Qh, Qt, Kd, Ko, Vc, Ob, w, r, h, lane);
                const float dl0 = dec[r], dl1 = dec[32 + r];
                LAS bf16* Sn = Sx + ((cs + 1) & 1) * (64 * GL_VS);
#pragma unroll
                for (int i = 0; i < 16; ++i) { st0[i] *= dl0; st1[i] *= dl1; }
#pragma unroll
                for (int ks = 0; ks < 4; ++ks) {
                    const bf16x8 a = tr_frag(Vc, GL_VS, 16 * ks + 8 * h, 16 * ks + 8 * h + 4, 32 * w, lane);
                    const bf16x8 b0 = tr_frag(Kt, GL_RS, 16 * ks + 8 * h, 16 * ks + 8 * h + 4, 0, lane), b1 = tr_frag(Kt, GL_RS, 16 * ks + 8 * h, 16 * ks + 8 * h + 4, 32, lane);
                    st0 = MFMA32(a, b0, st0); st1 = MFMA32(a, b1, st1); }
#pragma unroll
                for (int g4 = 0; g4 < 4; ++g4) {
                    u32x2 w0; w0.x = cvt_pk_bf16(st0[4 * g4], st0[4 * g4 + 1]); w0.y = cvt_pk_bf16(st0[4 * g4 + 2], st0[4 * g4 + 3]); *(LAS u32x2*)(Sn + r * GL_VS + 32 * w + 8 * g4 + 4 * h) = w0;
                    u32x2 w1; w1.x = cvt_pk_bf16(st1[4 * g4], st1[4 * g4 + 1]); w1.y = cvt_pk_bf16(st1[4 * g4 + 2], st1[4 * g4 + 3]); *(LAS u32x2*)(Sn + (32 + r) * GL_VS + 32 * w + 8 * g4 + 4 * h) = w1; }
            } else gla_out_tile<1>(Sx + (cs & 1) * (64 * GL_VS), Qh, Qt, Kd, Ko, Vc, Ob, w & 3, r, h, lane);
            LDS_BARRIER();
        }
        { const int cp = dir ? 0 : 63;
#pragma unroll
          for (int k2 = 0; k2 < 2; ++k2) { const int u = vrow0 + 32 * k2; const u32x4 ov = *(const LAS u32x4*)(Ob + u * GL_VS + 8 * vch);
              *(u32x4*)(ob + (rowb + cp * 64 + (dir ? 63 - u : u)) * 512 + hh * 128 + 8 * vch) = ov; } }
#undef GLA_LOAD
#undef GLA_STASH
    }
}
DI void gla_norm_phase(Frame& F, int l) {
    const bf16* P = (const bf16*)(fws(F) + WS_PROJ); const bf16* Y = (const bf16*)(fout(F) + DO_Y); unsigned char* Y8 = fws(F) + WS_Y8; float* YSC = (float*)(fws(F) + WS_YSC);
    const int gw = F.vcu * 8 + F.wave, NGW = F.G * 8, lane = F.lane;
    const bf16* p0 = gla_partial(F, 0, 0, 0); const bf16* p1 = gla_partial(F, 1, 0, 0);
    const float* ng0 = fin(F, 7) + (size_t)l * 512 + lane * 8; const float* ng1 = fin(F, 9) + (size_t)l * 512 + lane * 8;
    float cwv[3][8];
    { const float* cw = fin(F, 5) + (size_t)l * 3 * 512 + lane * 8;
#pragma unroll
      for (int t3 = 0; t3 < 3; ++t3) { const f32x4 c0 = *(const f32x4*)(cw + t3 * 512), c1 = *(const f32x4*)(cw + t3 * 512 + 4); cwv[t3][0] = c0.x; cwv[t3][1] = c0.y; cwv[t3][2] = c0.z; cwv[t3][3] = c0.w; cwv[t3][4] = c1.x; cwv[t3][5] = c1.y; cwv[t3][6] = c1.z; cwv[t3][7] = c1.w; } }
    for (int tok = gw; tok < T_TOK; tok += NGW) {
        float v[32];
        const u32x4 ya = __builtin_nontemporal_load((const u32x4*)(Y + (size_t)tok * DM + lane * 8));
        const int tl = tok & (SEQ - 1); const bf16* cs = P + (size_t)tok * NPROJ + lane * 8;
        const u32x4 z4 = (u32x4){0u, 0u, 0u, 0u};
        const u32x4 cbw = *(const u32x4*)(cs + C_CB), cc1 = *(const u32x4*)(cs + C_CC), ch1 = *(const u32x4*)(cs + C_CH);
        const u32x4 cc0 = tl > 0 ? *(const u32x4*)(cs - NPROJ + C_CC) : z4, ch0 = tl > 0 ? *(const u32x4*)(cs - NPROJ + C_CH) : z4;
        const u32x4 cc2 = tl < SEQ - 1 ? *(const u32x4*)(cs + NPROJ + C_CC) : z4, ch2 = tl < SEQ - 1 ? *(const u32x4*)(cs + NPROJ + C_CH) : z4;
        u32x4 pa[4], pb[4];
#pragma unroll
        for (int part = 0; part < 4; ++part) { pa[part] = __builtin_nontemporal_load((const u32x4*)(p0 + ((size_t)part * T_TOK + tok) * 512 + lane * 8)); pb[part] = __builtin_nontemporal_load((const u32x4*)(p1 + ((size_t)part * T_TOK + tok) * 512 + lane * 8)); }
        const u32x4 g0 = __builtin_nontemporal_load((const u32x4*)(P + (size_t)tok * NPROJ + C_GO + lane * 8)), g1 = __builtin_nontemporal_load((const u32x4*)(P + (size_t)tok * NPROJ + C_RG + lane * 8));
        { float t8[8]; unpack8(ya, t8);
#pragma unroll
          for (int q = 0; q < 8; ++q) v[q] = t8[q];
          float a0[8], h0[8], a1[8], h1[8], a2[8], h2[8], bq8[8]; unpack8(cc0, a0); unpack8(ch0, h0); unpack8(cc1, a1); unpack8(ch1, h1); unpack8(cc2, a2); unpack8(ch2, h2); unpack8(cbw, bq8);
#pragma unroll
          for (int q = 0; q < 8; ++q) v[8 + q] = bq8[q] * (cwv[0][q] * (a0[q] * h0[q]) + cwv[1][q] * (a1[q] * h1[q]) + cwv[2][q] * (a2[q] * h2[q])); }
#pragma unroll
        for (int mixer = 0; mixer < 2; ++mixer) {
            float o[8];
#pragma unroll
            for (int q = 0; q < 8; ++q) o[q] = 0.f;
#pragma unroll
            for (int part = 0; part < 4; ++part) { float t8[8]; unpack8(mixer == 0 ? pa[part] : pb[part], t8);
#pragma unroll
                for (int q = 0; q < 8; ++q) o[q] += t8[q]; }
            float s1 = 0.f, s2 = 0.f;
#pragma unroll
            for (int q = 0; q < 8; ++q) { s1 += o[q]; s2 += o[q] * o[q]; }
            s1 += sx<1>(s1); s2 += sx<1>(s2); s1 += sx<2>(s1); s2 += sx<2>(s2); s1 += sx<4>(s1); s2 += sx<4>(s2); s1 += sx<8>(s1); s2 += sx<8>(s2);
            float mean = 0.f, rstd;
            if (mixer == 0) rstd = __builtin_amdgcn_rsqf(s2 * (1.f / 128.f) + HN_EPS);
            else { mean = s1 * (1.f / 128.f); const float var = fmaxf(s2 * (1.f / 128.f) - mean * mean, 0.f); rstd = __builtin_amdgcn_rsqf(var + HN_EPS); }
            const float* ng = mixer == 0 ? ng0 : ng1; const f32x4 n0 = *(const f32x4*)ng, n1 = *(const f32x4*)(ng + 4); const float nn[8] = {n0.x, n0.y, n0.z, n0.w, n1.x, n1.y, n1.z, n1.w};
            float gate[8]; unpack8(mixer == 0 ? g0 : g1, gate);
#pragma unroll
            for (int q = 0; q < 8; ++q) v[16 + 8 * mixer + q] = (o[q] - mean) * rstd * nn[q] * siluf_(gate[q]);
        }
        float am = 0.f;
#pragma unroll
        for (int q = 0; q < 32; ++q) am = fmaxf(am, fabsf(v[q]));
        am = wave_max(am); const float inv = am > 0.f ? 127.0f / am : 0.f;
#pragma unroll
        for (int j = 0; j < 4; ++j) { u32x2 w2; w2.x = q8(v[j * 8] * inv) | (q8(v[j * 8 + 1] * inv) << 8) | (q8(v[j * 8 + 2] * inv) << 16) | (q8(v[j * 8 + 3] * inv) << 24);
            w2.y = q8(v[j * 8 + 4] * inv) | (q8(v[j * 8 + 5] * inv) << 8) | (q8(v[j * 8 + 6] * inv) << 16) | (q8(v[j * 8 + 7] * inv) << 24); *(u32x2*)(Y8 + (size_t)tok * DM + lane * 8 + 512 * j) = w2; }
        if (lane == 0) YSC[tok] = am * (1.0f / 127.0f);
    }
}

DI float reduce16(const float (&v)[16], int lane) {
    float a[8];
#pragma unroll
    for (int e = 0; e < 8; ++e) { const bool up = (lane & 32) != 0; const float keep = up ? v[e + 8] : v[e], give = up ? v[e] : v[e + 8]; a[e] = keep + sx32(give, lane); }
    float b4[4];
#pragma unroll
    for (int e = 0; e < 4; ++e) { const bool up = (lane & 16) != 0; const float keep = up ? a[e + 4] : a[e], give = up ? a[e] : a[e + 4]; b4[e] = keep + sx<16>(give); }
    float c2[2];
#pragma unroll
    for (int e = 0; e < 2; ++e) { const bool up = (lane & 8) != 0; const float keep = up ? b4[e + 2] : b4[e], give = up ? b4[e] : b4[e + 2]; c2[e] = keep + sx<8>(give); }
    float d; { const bool up = (lane & 4) != 0; const float keep = up ? c2[1] : c2[0], give = up ? c2[0] : c2[1]; d = keep + sx<4>(give); }
    d += sx<2>(d); d += sx<1>(d);
    return d;
}
constexpr int RW_RS = 2056;
DI void ln1_router_phase(Frame& F, int l, bool dry = false) {
    bf16* H = (bf16*)(fws(F) + WS_H); const unsigned char* MIX = fws(F) + WS_MIX; const float* MSC = (const float*)(fws(F) + WS_MSC);
    const float* g = fin(F, 11) + (size_t)l * DM; const float* bb = fin(F, 12) + (size_t)l * DM; const float* rw = fin(F, 13); const float* rb = fin(F, 14);
    int* EID = (int*)(fws(F) + WS_EID); float* EW = (float*)(fws(F) + WS_EW); int* CNT = (int*)(fws(F) + WS_CNT); unsigned char* H8 = fws(F) + WS_H8; float* HS = (float*)(fws(F) + WS_HS);
    bf16* HO = H; if (dry) { HO = (bf16*)(fws(F) + WS_OB1); H8 = fout(F) + DO_OB; EID = (int*)(fws(F) + WS_Y8); EW = (float*)(fws(F) + WS_Y8 + MiB); CNT = (int*)(fws(F) + WS_Y8 + 2 * MiB); HS = (float*)(fws(F) + WS_Y8 + 3 * MiB); }
    LAS bf16* rwb = (LAS bf16*)F.lds;
    LAS float* gl = (LAS float*)(F.lds + 16 * RW_RS * 2); LAS float* bl = gl + DM;
    LAS int* cnt = (LAS int*)(F.lds + LDSCTL_OFF + 64);
    const int lane = F.lane;
    const float rbe = rb[lane & 15];
    __syncthreads();
    stage_gb(F, g, bb, gl, bl);
    { f32x4 rv[16];
#pragma unroll
      for (int it = 0; it < 16; ++it) rv[it] = *(const f32x4*)(rw + 4 * (F.tid + 512 * it));
#pragma unroll
      for (int it = 0; it < 16; ++it) { const int i = 4 * (F.tid + 512 * it), k = i >> 4, e = i & 15; rwb[e * RW_RS + k] = f2bf(rv[it].x); rwb[(e + 1) * RW_RS + k] = f2bf(rv[it].y); rwb[(e + 2) * RW_RS + k] = f2bf(rv[it].z); rwb[(e + 3) * RW_RS + k] = f2bf(rv[it].w); } }
    for (int ch = F.vcu; ch < 256; ch += F.G) {
        if (F.tid < 16) cnt[F.tid] = 0;
        __syncthreads();
        const int tok0 = ch * 128 + F.wave * 16;
        u32x4 ph[4]; u32x2 pm[4]; float psc[4];
#pragma unroll
        for (int j = 0; j < 4; ++j) { ph[j] = *(const u32x4*)(H + (size_t)tok0 * DM + lane * 8 + 512 * j); pm[j] = __builtin_nontemporal_load((const u32x2*)(MIX + (size_t)tok0 * DM + lane * 8 + 512 * j)); psc[j] = MSC[(size_t)tok0 * 8 + (lane >> 5) + 2 * j]; }
#pragma unroll 1
        for (int ti = 0; ti < 16; ++ti) {
            const int tok = tok0 + ti;
            float v[32]; float s = 0.f;
#pragma unroll
            for (int j = 0; j < 4; ++j) { float a[8], m8[8]; unpack8(ph[j], a); unpack_i8(pm[j], psc[j], m8);
#pragma unroll
                for (int q = 0; q < 8; ++q) { v[j * 8 + q] = ALPHA * a[q] + m8[q]; s += v[j * 8 + q]; } }
            if (ti + 1 < 16) {
#pragma unroll
                for (int j = 0; j < 4; ++j) { ph[j] = *(const u32x4*)(H + (size_t)(tok + 1) * DM + lane * 8 + 512 * j); pm[j] = __builtin_nontemporal_load((const u32x2*)(MIX + (size_t)(tok + 1) * DM + lane * 8 + 512 * j)); psc[j] = MSC[(size_t)(tok + 1) * 8 + (lane >> 5) + 2 * j]; } }
            const float mean = wave_sum(s) * (1.f / DM); float s2 = 0.f;
#pragma unroll
            for (int q = 0; q < 32; ++q) { v[q] -= mean; s2 += v[q] * v[q]; }
            const float rstd = 1.f / sqrtf(wave_sum(s2) * (1.f / DM) + LN_EPS);
            float am = 0.f;
#pragma unroll
            for (int j = 0; j < 4; ++j) { const int c0 = lane * 8 + 512 * j; const f32x4 g0 = *(const LAS f32x4*)(gl + c0), g1 = *(const LAS f32x4*)(gl + c0 + 4), b0 = *(const LAS f32x4*)(bl + c0), b1 = *(const LAS f32x4*)(bl + c0 + 4);
                const float gg[8] = {g0.x, g0.y, g0.z, g0.w, g1.x, g1.y, g1.z, g1.w}, bv[8] = {b0.x, b0.y, b0.z, b0.w, b1.x, b1.y, b1.z, b1.w};
                float o[8];
#pragma unroll
                for (int q = 0; q < 8; ++q) { o[q] = v[j * 8 + q] * rstd * gg[q] + bv[q]; v[j * 8 + q] = o[q]; am = fmaxf(am, fabsf(o[q])); }
                *(u32x4*)(HO + (size_t)tok * DM + c0) = pack8(o); }
            (void)am; (void)HS;
#pragma unroll
            for (int j = 0; j < 4; ++j) { u32x2 w2; w2.x = pg8::pk_fp8x4(v[j * 8] * pg8::ACT_SCALE, v[j * 8 + 1] * pg8::ACT_SCALE, v[j * 8 + 2] * pg8::ACT_SCALE, v[j * 8 + 3] * pg8::ACT_SCALE);
                w2.y = pg8::pk_fp8x4(v[j * 8 + 4] * pg8::ACT_SCALE, v[j * 8 + 5] * pg8::ACT_SCALE, v[j * 8 + 6] * pg8::ACT_SCALE, v[j * 8 + 7] * pg8::ACT_SCALE); *(u32x2*)(H8 + (size_t)tok * DM + lane * 8 + 512 * j) = w2; }
        }
        asm volatile("s_waitcnt vmcnt(0)" ::: "memory");
        f32x4 acc = (f32x4){0.f, 0.f, 0.f, 0.f};
        { const bf16* hrow = HO + (size_t)(tok0 + (lane & 15)) * DM + 8 * (lane >> 4); const LAS bf16* wrow = rwb + (lane & 15) * RW_RS + 8 * (lane >> 4);
#pragma unroll 16
          for (int st = 0; st < 64; ++st) { const bf16x8 a = *(const bf16x8*)(hrow + 32 * st), bq = *(const LAS bf16x8*)(wrow + 32 * st); acc = __builtin_amdgcn_mfma_f32_16x16x32_bf16(a, bq, acc, 0, 0, 0); } }
#pragma unroll
        for (int reg = 0; reg < 4; ++reg) {
            const int tok = tok0 + 4 * (lane >> 4) + reg; const int rowb = lane & 48;
            const float x = acc[reg] + rbe;
            float mx = x;
            mx = fmaxf(mx, sx<1>(mx)); mx = fmaxf(mx, sx<2>(mx)); mx = fmaxf(mx, sx<4>(mx)); mx = fmaxf(mx, sx<8>(mx));
            const float p = __expf(x - mx);
            float qa = -1.f, qc = -1.f;
#pragma unroll
            for (int q = 0; q < 4; ++q) { const float y = shfl_idx(p, (lane & ~3) + q); if (y > qa) { qc = qa; qa = y; } else if (y > qc) qc = y; }
            const float gs = qa + qc;
            int gsel = 0; float gbest = -1.f;
#pragma unroll
            for (int gi = 0; gi < 4; ++gi) { const float y = shfl_idx(gs, rowb + 4 * gi); if (y > gbest) { gbest = y; gsel = gi; } }
            int i1 = 0, i2 = 0; float p1 = -1.f, p2 = -1.f;
#pragma unroll
            for (int q = 0; q < 4; ++q) { const float y = shfl_idx(p, rowb + 4 * gsel + q); if (y > p1) { p2 = p1; i2 = i1; p1 = y; i1 = q; } else if (y > p2) { p2 = y; i2 = q; } }
            if ((lane & 15) == 0) { const float inv = 1.f / (p1 + p2); const int e1 = gsel * 4 + i1, e2 = gsel * 4 + i2;
                EID[tok * 2] = e1; EID[tok * 2 + 1] = e2; EW[tok * 2] = p1 * inv; EW[tok * 2 + 1] = p2 * inv;
                __hip_atomic_fetch_add(cnt + e1, 1, __ATOMIC_RELAXED, __HIP_MEMORY_SCOPE_WORKGROUP); __hip_atomic_fetch_add(cnt + e2, 1, __ATOMIC_RELAXED, __HIP_MEMORY_SCOPE_WORKGROUP); }
        }
        __syncthreads();
        if (F.tid < 16) CNT[ch * 16 + F.tid] = cnt[F.tid];
        __syncthreads();
    }
}
DI void assign_phase(Frame& F) {
    const int* EID = (const int*)(fws(F) + WS_EID); const int* CNT = (const int*)(fws(F) + WS_CNT);
    int* SOT = (int*)(fws(F) + WS_SOT); int* TOS = (int*)(fws(F) + WS_TOS); int* TST = (int*)(fws(F) + WS_TST);
    LAS int* tot = (LAS int*)F.lds;
    LAS int* base = tot + 16;
    LAS int* pre = base + 16;
    LAS int* eids = pre + 16;
    LAS int* part = eids + 256;
    const int tid = F.tid;
    const int e = tid & 15, pp = tid >> 4;
    int cv[8];
#pragma unroll
    for (int k = 0; k < 8; ++k) cv[k] = CNT[(pp * 8 + k) * 16 + e];
    __syncthreads();
    { int s = 0;
#pragma unroll
      for (int k = 0; k < 8; ++k) s += cv[k];
      part[pp * 16 + e] = s; }
    __syncthreads();
    if (tid < 16) { int s = 0; for (int q = 0; q < 32; ++q) s += part[q * 16 + tid]; tot[tid] = s; }
    __syncthreads();
    if (tid == 0) { int acc = 0; for (int q = 0; q < 16; ++q) { base[q] = acc; acc += (tot[q] + 255) & ~255; }
        if (F.bx == 0) { int tacc = 0; for (int q = 0; q < 16; ++q) { TST[q] = tacc; tacc += (tot[q] + 255) >> 8; } TST[16] = tacc; } }
    __syncthreads();
    if (F.bx == 0) { for (int q = 0; q < 16; ++q) { const int lo = base[q] + tot[q], hi = base[q] + ((tot[q] + 255) & ~255); for (int s = lo + tid; s < hi; s += 512) TOS[s] = 0; } }
    for (int ch = F.vcu; ch < 256; ch += F.G) {
        __syncthreads();
        { int s = 0;
#pragma unroll
          for (int k = 0; k < 8; ++k) s += (pp * 8 + k < ch) ? cv[k] : 0;
          part[pp * 16 + e] = s; }
        if (tid < 256) eids[tid] = EID[ch * 256 + tid];
        __syncthreads();
        if (tid < 16) { int s = 0; for (int q = 0; q < 32; ++q) s += part[q * 16 + tid]; pre[tid] = s; }
        __syncthreads();
        if (tid < 256) { const int ee = eids[tid]; int rank = 0; for (int j = 0; j < tid; ++j) rank += (eids[j] == ee) ? 1 : 0;
            const int pos = base[ee] + pre[ee] + rank; const int tok = ch * 128 + (tid >> 1);
            TOS[pos] = tok; SOT[ch * 256 + tid] = pos; }
    }
}
DI void unpack_f8(u32x2 w, float* o) {
    const f32x2 a = __builtin_amdgcn_cvt_pk_f32_fp8((int)w.x, false), b = __builtin_amdgcn_cvt_pk_f32_fp8((int)w.x, true), c = __builtin_amdgcn_cvt_pk_f32_fp8((int)w.y, false), d = __builtin_amdgcn_cvt_pk_f32_fp8((int)w.y, true);
    o[0] = a.x; o[1] = a.y; o[2] = b.x; o[3] = b.y; o[4] = c.x; o[5] = c.y; o[6] = d.x; o[7] = d.y; }
DI void combine_ln2_phase(Frame& F, int l, bool final_out, bool dry = false) {
    bf16* H = (bf16*)(fws(F) + WS_H); const unsigned char* YS = fws(F) + WS_YS;
    const float* g = fin(F, 18) + (size_t)l * DM; const float* bb = fin(F, 19) + (size_t)l * DM;
    const int* SOT = (const int*)(fws(F) + WS_SOT); const float* EW = (const float*)(fws(F) + WS_EW);
    float* OUT = (float*)fout(F); unsigned char* H8 = fws(F) + WS_H8; float* HS = (float*)(fws(F) + WS_HS);
    bf16* HO = H; if (dry) { HO = (bf16*)(fws(F) + WS_OB1); H8 = fws(F) + WS_Y8; HS = (float*)(fws(F) + WS_YSC); final_out = false; }
    const int gw = F.vcu * 8 + F.wave, NGW = F.G * 8, lane = F.lane;
    LAS float* gl = (LAS float*)F.lds; LAS float* bl = gl + DM;
    __syncthreads(); stage_gb(F, g, bb, gl, bl); __syncthreads();
    int s0n = 0, s1n = 0; float w0n = 0.f, w1n = 0.f;
    float w0c = 0.f, w1c = 0.f; u32x4 ph[4]; u32x2 py0[4], py1[4];
    if (gw < T_TOK) { const int s0 = SOT[gw * 2], s1 = SOT[gw * 2 + 1]; w0c = EW[gw * 2]; w1c = EW[gw * 2 + 1];
#pragma unroll
        for (int j = 0; j < 4; ++j) { const int c0 = lane * 8 + 512 * j; ph[j] = *(const u32x4*)(H + (size_t)gw * DM + c0); py0[j] = __builtin_nontemporal_load((const u32x2*)(YS + (size_t)s0 * DM + c0)); py1[j] = __builtin_nontemporal_load((const u32x2*)(YS + (size_t)s1 * DM + c0)); }
        if (gw + NGW < T_TOK) { const int t2 = gw + NGW; s0n = SOT[t2 * 2]; s1n = SOT[t2 * 2 + 1]; w0n = EW[t2 * 2]; w1n = EW[t2 * 2 + 1]; } }
    for (int tok = gw; tok < T_TOK; tok += NGW) {
        const float w0 = w0c * (1.0f / pg8::YS_SCALE), w1 = w1c * (1.0f / pg8::YS_SCALE);
        float v[32]; float s = 0.f;
#pragma unroll
        for (int j = 0; j < 4; ++j) { float a[8], y0[8], y1[8]; unpack8(ph[j], a); unpack_f8(py0[j], y0); unpack_f8(py1[j], y1);
#pragma unroll
            for (int q = 0; q < 8; ++q) { v[j * 8 + q] = ALPHA * a[q] + w0 * y0[q] + w1 * y1[q]; s += v[j * 8 + q]; } }
        if (tok + NGW < T_TOK) { const int t1 = tok + NGW; const int s0 = s0n, s1 = s1n; w0c = w0n; w1c = w1n;
#pragma unroll
            for (int j = 0; j < 4; ++j) { const int c0 = lane * 8 + 512 * j; ph[j] = *(const u32x4*)(H + (size_t)t1 * DM + c0); py0[j] = __builtin_nontemporal_load((const u32x2*)(YS + (size_t)s0 * DM + c0)); py1[j] = __builtin_nontemporal_load((const u32x2*)(YS + (size_t)s1 * DM + c0)); }
            if (t1 + NGW < T_TOK) { const int t2 = t1 + NGW; s0n = SOT[t2 * 2]; s1n = SOT[t2 * 2 + 1]; w0n = EW[t2 * 2]; w1n = EW[t2 * 2 + 1]; } }
        const float mean = wave_sum(s) * (1.f / DM); float s2 = 0.f;
#pragma unroll
        for (int q = 0; q < 32; ++q) { v[q] -= mean; s2 += v[q] * v[q]; }
        const float rstd = 1.f / sqrtf(wave_sum(s2) * (1.f / DM) + LN_EPS);
#pragma unroll
        for (int j = 0; j < 4; ++j) { const int c0 = lane * 8 + 512 * j; const f32x4 g0 = *(const LAS f32x4*)(gl + c0), g1 = *(const LAS f32x4*)(gl + c0 + 4), b0 = *(const LAS f32x4*)(bl + c0), b1 = *(const LAS f32x4*)(bl + c0 + 4);
            const float gg[8] = {g0.x, g0.y, g0.z, g0.w, g1.x, g1.y, g1.z, g1.w}, bv[8] = {b0.x, b0.y, b0.z, b0.w, b1.x, b1.y, b1.z, b1.w};
            float o[8];
#pragma unroll
            for (int q = 0; q < 8; ++q) { o[q] = v[j * 8 + q] * rstd * gg[q] + bv[q]; v[j * 8 + q] = o[q]; }
            if (final_out) { __builtin_nontemporal_store((f32x4){o[0], o[1], o[2], o[3]}, (f32x4*)(OUT + (size_t)tok * DM + c0)); __builtin_nontemporal_store((f32x4){o[4], o[5], o[6], o[7]}, (f32x4*)(OUT + (size_t)tok * DM + c0 + 4)); }
            else *(u32x4*)(HO + (size_t)tok * DM + c0) = pack8(o); }
        if (!final_out) { float am = 0.f;
#pragma unroll
            for (int q = 0; q < 32; ++q) am = fmaxf(am, fabsf(v[q]));
            am = wave_max(am); const float inv = am > 0.f ? 127.0f / am : 0.f;
#pragma unroll
            for (int j = 0; j < 4; ++j) { u32x2 w2; w2.x = q8(v[j * 8] * inv) | (q8(v[j * 8 + 1] * inv) << 8) | (q8(v[j * 8 + 2] * inv) << 16) | (q8(v[j * 8 + 3] * inv) << 24);
                w2.y = q8(v[j * 8 + 4] * inv) | (q8(v[j * 8 + 5] * inv) << 8) | (q8(v[j * 8 + 6] * inv) << 16) | (q8(v[j * 8 + 7] * inv) << 24); *(u32x2*)(H8 + (size_t)tok * DM + lane * 8 + 512 * j) = w2; }
            if (lane == 0) HS[tok] = am * (1.0f / 127.0f); }
    }
}

constexpr int PH_PER_LAYER = 9, N_PHASES = 2 + DEPTH * PH_PER_LAYER;
#ifndef PH_MASK
#define PH_MASK 0xFFFFFFFFu
#endif
#define PHM(b) ((PH_MASK >> (b)) & 1u)
#define REP(b) _Pragma("unroll") for (int rep_ = 0; rep_ < 1 + (int)((PH_DUP >> (b)) & 1u); ++rep_)
__global__ void __launch_bounds__(512, 2) mk_fwd(Args args) {
    extern __shared__ __attribute__((aligned(16))) unsigned char lds_raw[];
    Frame F;
    F.lds = (LAS unsigned char*)lds_raw;
    F.wave0 = __builtin_amdgcn_readfirstlane((int)threadIdx.x >> 6);
    frame_refresh(F);
    volatile LAS unsigned* MISC = (volatile LAS unsigned*)(F.lds + MISC_OFF);
    for (int u = F.tid; u < (LDS_BYTES - LDSCTL_OFF) / 4; u += 512) ((LAS unsigned*)(F.lds + LDSCTL_OFF))[u] = 0u;
    __syncthreads();
    unsigned* ctl = (unsigned*)(fws(F) + WS_CTL);
    XcdBarrier bar; bar.bar = ctl + CW_BAR; bar.x = 0; bar.st = nullptr;
    const int lo = args.ph_lo, hi = args.ph_hi;
    const bool multi = (hi - lo) > 1;
    if (multi) bar = xcd_barrier_post(ctl + CW_BAR, MISC + 8);
#define IN(k) (frame_refresh(F), (lo <= (k) && (k) < hi))
#define SEAM(k) do { if (lo <= (k) && (k) + 1 < hi) { _Pragma("unroll") for (int rb_ = 0; rb_ < 1 + (int)((PH_DUP >> 16) & 1u); ++rb_) { XcdBarrier b2_ = bar; asm volatile("" : "+s"(b2_.bar)); xcd_barrier(b2_); } } } while (0)
    if (IN(0) && PHM(0)) {
        REP(0) wabs_phase(F, 0);
        REP(14) ln_emb(F);
        if (F.bx == 0) { float* LB = (float*)(fws(F) + WS_TST + 128); const float* hl = fin(F, 6); for (int d = F.tid; d < 512; d += 512) LB[d] = 1.0f / (1.0f + __expf(hl[d] - hl[512 + d])); }
    }
    SEAM(0);
    if (IN(1) && PHM(0)) { REP(15) { convert_weights(F, 0); __syncthreads(); } }
    SEAM(1);
#pragma unroll 1
    for (int l = 0; l < DEPTH; ++l) {
        const int p0 = 2 + l * PH_PER_LAYER;
        const float* lbp = (l == 0) ? nullptr : (const float*)(fws(F) + WS_TST + 128);
        if (IN(p0 + 0) && PHM(1)) REP(1) {
            const float* ABS = (const float*)(fws(F) + WS_CTL + CTL_ABS) + (size_t)l * ABS_PER_LAYER;
            pg8::Gemm g{(const bf16*)(fws(F) + WS_H8), (const bf16*)(fws(F) + WS_WIN), DM / 2}; pg8::StaticOrder S; S.init(T_TOK / 256, NPROJ / 256, F.G, F.bx);
            pg8::EpiBf16Q E{(bf16*)(fws(F) + WS_PROJ), NPROJ, (const float*)(fws(F) + WS_HS), ABS + ABS_IN};
            pg8::gemm_phase<pg8::EpiBf16Q, pg8::StaticOrder, false>(F.lds, F.tid, g, S, E, nullptr);
            if (l == 0) { frame_refresh(F); wabs_tail(F, (T_TOK / 256) * (NPROJ / 256), 0, WABS_T1); }
        }
        SEAM(p0 + 0);
        if (IN(p0 + 1)) { if (PHM(4)) REP(4) gla_seq_phase(F, l, lbp); if (PHM(2)) REP(2) attn_phase(F, l); }
        SEAM(p0 + 1);
        if (IN(p0 + 2) && PHM(5)) REP(5) gla_norm_phase(F, l);
        SEAM(p0 + 2);
        if (IN(p0 + 3) && PHM(7)) REP(7) {
            __syncthreads();
            const float* ABS = (const float*)(fws(F) + WS_CTL + CTL_ABS) + (size_t)l * ABS_PER_LAYER;
            pg8::Gemm g{(const bf16*)(fws(F) + WS_Y8), (const bf16*)(fws(F) + WS_WOUT), DM / 2}; pg8::StaticOrder S; S.init(T_TOK / 256, DM / 256, F.G, F.bx);
            pg8::EpiI8Tile<true> E{fws(F) + WS_MIX, DM, (float*)(fws(F) + WS_MSC), 8, (const float*)(fws(F) + WS_YSC), ABS + ABS_OUT, (LAS float*)(F.lds + RING_BYTES)};
            pg8::gemm_phase<pg8::EpiI8Tile<true>, pg8::StaticOrder, false>(F.lds, F.tid, g, S, E, nullptr);
        }
        SEAM(p0 + 3);
        if (IN(p0 + 4) && PHM(8)) {
#pragma unroll 1
            for (int rep_ = 0; rep_ < 1 + (int)((PH_DUP >> 8) & 1u); ++rep_) ln1_router_phase(F, l, rep_ == 1); }
        SEAM(p0 + 4);
        if (IN(p0 + 5) && PHM(9)) REP(9) assign_phase(F);
        SEAM(p0 + 5);
        if (IN(p0 + 6) && PHM(10)) REP(10) {
            __syncthreads();
            const int* TST = (const int*)(fws(F) + WS_TST);
            const float* ABS = (const float*)(fws(F) + WS_CTL + CTL_ABS) + (size_t)l * ABS_PER_LAYER;
            pg8::Gemm g{(const bf16*)(fws(F) + WS_H8), (const bf16*)(fws(F) + WS_WGU), DM / 2}; pg8::MoeOrder S; S.init(__builtin_amdgcn_readfirstlane(TST[16]), 8, F.G, F.bx); S.tile_start = TST; S.expert_stride = (size_t)2048 * DM;
            pg8::EpiSwiGLUF8 E{fws(F) + WS_HID, DEXP, (const float*)(fws(F) + WS_GUS) + l * 2 * NEXP, TST}; (void)ABS;
            pg8::gemm_phase<pg8::EpiSwiGLUF8, pg8::MoeOrder, true>(F.lds, F.tid, g, S, E, (const int*)(fws(F) + WS_TOS));
            if (l == 0) { frame_refresh(F); const int nu = ((const int*)(fws(F) + WS_TST))[16] * 8; wabs_tail(F, nu, WABS_T1, wabs_t2(F.G, nu)); }
        }
        SEAM(p0 + 6);
        if (IN(p0 + 7) && PHM(11)) REP(11) {
            const int* TST = (const int*)(fws(F) + WS_TST);
            pg8::Gemm g{(const bf16*)(fws(F) + WS_HID), (const bf16*)(fws(F) + WS_WD), DEXP / 2}; pg8::MoeOrder S; S.init(__builtin_amdgcn_readfirstlane(TST[16]), 8, F.G, F.bx); S.tile_start = TST; S.expert_stride = (size_t)DM * DEXP;
            pg8::EpiF8Out E{fws(F) + WS_YS, DM, (const float*)(fws(F) + WS_WDS) + l * NEXP, TST};
            pg8::gemm_phase<pg8::EpiF8Out, pg8::MoeOrder, false>(F.lds, F.tid, g, S, E, nullptr);
            if (l == 0) { frame_refresh(F); const int nu = ((const int*)(fws(F) + WS_TST))[16] * 8; wabs_tail(F, nu, wabs_t2(F.G, nu), WABS_PER_L); }
        }
        SEAM(p0 + 7);
        if (IN(p0 + 8)) { if (PHM(12)) { if ((PH_DUP >> 12) & 1u) combine_ln2_phase(F, l, false, true); combine_ln2_phase(F, l, l == DEPTH - 1); } if (PHM(13) && l + 1 < DEPTH) { __syncthreads(); convert_weights(F, l + 1); } }
        if (l + 1 < DEPTH) SEAM(p0 + 8);
    }
#undef IN
#undef SEAM
}

extern "C" void kernel_launch(void* const* d_in, const int* in_sizes, int n_in, void* d_out, int out_size, void* d_ws, size_t ws_size, hipStream_t stream) {
    static int grid = 0;
    if (grid == 0) {
        if (n_in != 20 || out_size != T_TOK * DM || ws_size < WS_END) { fprintf(stderr, "kernel_launch: unexpected shapes (n_in %d out %d ws %zu)\n", n_in, out_size, ws_size); grid = -1; return; }
        int dev = 0, cus = 0;
        if (hipGetDevice(&dev) != hipSuccess || hipDeviceGetAttribute(&cus, hipDeviceAttributeMultiprocessorCount, dev) != hipSuccess) { grid = -1; return; }
        if (hipFuncSetAttribute((const void*)mk_fwd, hipFuncAttributeMaxDynamicSharedMemorySize, LDS_BYTES) != hipSuccess) { fprintf(stderr, "kernel_launch: hipFuncSetAttribute failed\n"); grid = -1; return; }
        int per_cu = 0;
        if (hipOccupancyMaxActiveBlocksPerMultiprocessor(&per_cu, (const void*)mk_fwd, 512, LDS_BYTES) != hipSuccess || per_cu < 1) fprintf(stderr, "kernel_launch: occupancy query reports %d\n", per_cu);
        (void)hipGetLastError();
        grid = cus;
    }
    if (grid < 0) return;
    (void)hipMemsetAsync((char*)d_ws + WS_CTL, 0, CTL_ZERO_BYTES, stream);
    Args a{};
    for (int i = 0; i < 20; ++i) a.in[i] = (const float*)d_in[i];
    a.out = (float*)d_out; a.ws = (unsigned char*)d_ws;
#if MK_ONE_LAUNCH
    a.ph_lo = 0; a.ph_hi = N_PHASES;
    hipLaunchKernelGGL(mk_fwd, dim3(grid), dim3(512), LDS_BYTES, stream, a);
#else
    for (int p = 0; p < N_PHASES; ++p) { a.ph_lo = p; a.ph_hi = p + 1; hipLaunchKernelGGL(mk_fwd, dim3(grid), dim3(512), LDS_BYTES, stream, a); }
#endif
}
```

```cpp
#include <hip/hip_runtime.h>
#ifndef PH_DUP
#define PH_DUP 0u
#endif
#include <cstdio>
#include <cstdint>

#ifndef MK_ONE_LAUNCH
#define MK_ONE_LAUNCH 1
#endif

#define LAS __attribute__((address_space(3)))
#define GAS __attribute__((address_space(1)))
typedef unsigned short bf16;
typedef short bf16x8 __attribute__((ext_vector_type(8)));
typedef short s16x4 __attribute__((ext_vector_type(4)));
typedef float f32x2 __attribute__((ext_vector_type(2)));
typedef float f32x4 __attribute__((ext_vector_type(4)));
typedef float f32x16 __attribute__((ext_vector_type(16)));
typedef unsigned u32x2 __attribute__((ext_vector_type(2)));
typedef unsigned u32x4 __attribute__((ext_vector_type(4)));
#define DI __device__ __forceinline__

constexpr int T_TOK = 32768, DM = 2048, SEQ = 4096, NBATCH = 8, NPROJ = 6912, NEXP = 16, DEXP = 1024, DEPTH = 2;
constexpr int SLOT_CAP = 69632;
constexpr float LN_EPS = 1e-5f, HN_EPS = 1e-6f, ALPHA = 1.41421356237f;
constexpr int C_AQ = 0, C_AK = 512, C_AV = 640, C_CB = 768, C_CC = 1280, C_CH = 1792, C_GQ = 2304, C_GZF = 2816, C_GZB = 3328, C_GI = 3840, C_GO = 4352,
              C_RQ = 4864, C_RK = 5376, C_RV = 5888, C_RG = 6400;

constexpr size_t MiB = 1u << 20, KiB = 1u << 10;
constexpr size_t WS_CTL = 0, CTL_ZERO_BYTES = 1 * MiB;
constexpr size_t WS_EID = 1 * MiB, WS_EW = WS_EID + 256 * KiB, WS_SOT = WS_EW + 256 * KiB, WS_TOS = WS_SOT + 256 * KiB, WS_CNT = WS_TOS + 272 * KiB, WS_TST = WS_CNT + 16 * KiB;
constexpr size_t WS_WDS = WS_TST + 3072;
constexpr size_t WS_GUS = WS_WDS + 128;
constexpr size_t WS_HS = 3 * MiB, WS_YSC = WS_HS + 128 * KiB;
constexpr size_t WS_WIN = 8 * MiB, WS_WOUT = 22 * MiB, WS_WGU = 26 * MiB, WS_WD = 90 * MiB;
constexpr size_t WS_H8 = 154 * MiB;
constexpr size_t WS_H = 235 * MiB, WS_PROJ = 363 * MiB, WS_OB1 = 795 * MiB, WS_Y8 = 923 * MiB, WS_END = 987 * MiB;
constexpr size_t WS_MIX = WS_PROJ, WS_MSC = WS_PROJ + 64 * MiB, WS_HID = WS_PROJ, WS_YS = WS_PROJ + 136 * MiB, WS_YSS = WS_YS + 136 * MiB;
static_assert(WS_TST + 4096 <= WS_HS && WS_YSC + 128 * KiB <= WS_WIN, "ws map");
static_assert(WS_WIN + (size_t)NPROJ * DM <= WS_WOUT && WS_WOUT + (size_t)DM * DM <= WS_WGU && WS_WGU + (size_t)NEXP * 2048 * DM <= WS_WD && WS_WD + (size_t)NEXP * DM * DEXP * 2 <= WS_H8 && WS_H8 + (size_t)T_TOK * DM <= WS_H, "ws map");
static_assert(WS_H + (size_t)T_TOK * DM * 2 <= WS_PROJ && WS_PROJ + (size_t)T_TOK * NPROJ * 2 <= WS_OB1 && WS_YSS + (size_t)SLOT_CAP * 8 * 4 <= WS_OB1 && WS_YS + (size_t)SLOT_CAP * DM <= WS_YSS && WS_MSC + (size_t)T_TOK * 8 * 4 <= WS_YS && WS_HID + (size_t)SLOT_CAP * DEXP * 2 <= WS_YS, "ws map");
constexpr size_t CTL_ABS = 64 * KiB; constexpr int ABS_IN = 0, ABS_OUT = NPROJ, ABS_GU = NPROJ + DM, ABS_PER_LAYER = NPROJ + DM + NEXP * 2048;
static_assert(CTL_ABS + (size_t)2 * ABS_PER_LAYER * 4 <= CTL_ZERO_BYTES, "ctl map");
constexpr size_t DO_Y = 0, DO_OB = 128 * MiB;
constexpr int CW_BAR = 4096;

constexpr int RING_BYTES = 131072, LDSCTL_OFF = 147456, MISC_OFF = LDSCTL_OFF + 320, LDS_BYTES = 148480;

typedef __bf16 bf16x2_t __attribute__((ext_vector_type(2)));
DI unsigned cvt_pk_bf16(float lo, float hi) { const f32x2 v = {lo, hi}; const bf16x2_t b = __builtin_convertvector(v, bf16x2_t); return __builtin_bit_cast(unsigned, b); }
DI float bf_lo(unsigned w) { return __uint_as_float(w << 16); }
DI float bf_hi(unsigned w) { return __uint_as_float(w & 0xffff0000u); }
DI float bf2f(bf16 b) { return __uint_as_float(((unsigned)b) << 16); }
DI bf16 f2bf(float f) { return (bf16)(cvt_pk_bf16(f, 0.f) & 0xffffu); }
DI int lane_fresh() { unsigned z = 0u; asm volatile("" : "+s"(z)); int ln = (int)__builtin_amdgcn_mbcnt_hi(~0u, __builtin_amdgcn_mbcnt_lo(~0u, z)); return ln; }
DI float shfl_idx(float v, int src_lane) { return __builtin_bit_cast(float, __builtin_amdgcn_ds_bpermute(src_lane << 2, __builtin_bit_cast(int, v))); }
template <int M> DI float sx(float v) { static_assert(M >= 1 && M < 32, "swizzle mask"); return __builtin_bit_cast(float, __builtin_amdgcn_ds_swizzle(__builtin_bit_cast(int, v), (M << 10) | 0x1f)); }
DI float sum32(float v) { return v + __builtin_bit_cast(float, __builtin_amdgcn_ds_bpermute((lane_fresh() ^ 32) << 2, __builtin_bit_cast(int, v))); }
DI float max32(float v) { return fmaxf(v, __builtin_bit_cast(float, __builtin_amdgcn_ds_bpermute((lane_fresh() ^ 32) << 2, __builtin_bit_cast(int, v)))); }
DI float sx32(float v, int lane) { return __builtin_bit_cast(float, __builtin_amdgcn_ds_bpermute((lane ^ 32) << 2, __builtin_bit_cast(int, v))); }
DI float wave_sum(float v) { v += sx<1>(v); v += sx<2>(v); v += sx<4>(v); v += sx<8>(v); v += sx<16>(v); return sum32(v); }
DI float wave_max(float v) { v = fmaxf(v, sx<1>(v)); v = fmaxf(v, sx<2>(v)); v = fmaxf(v, sx<4>(v)); v = fmaxf(v, sx<8>(v)); v = fmaxf(v, sx<16>(v)); return max32(v); }
DI float sigmoidf_(float z) { return __builtin_amdgcn_rcpf(1.0f + __expf(-z)); }
DI float siluf_(float z) { return z * __builtin_amdgcn_rcpf(1.0f + __expf(-z)); }
DI void unpack8(const u32x4 w, float (&f)[8]) { f[0] = bf_lo(w.x); f[1] = bf_hi(w.x); f[2] = bf_lo(w.y); f[3] = bf_hi(w.y); f[4] = bf_lo(w.z); f[5] = bf_hi(w.z); f[6] = bf_lo(w.w); f[7] = bf_hi(w.w); }
DI void unpack_i8(const u32x2 w, float sc, float (&f)[8]) {
#pragma unroll
    for (int k = 0; k < 4; ++k) { f[k] = (float)((int)(w.x << (24 - 8 * k)) >> 24) * sc; f[4 + k] = (float)((int)(w.y << (24 - 8 * k)) >> 24) * sc; }
}
DI u32x4 pack8(const float (&f)[8]) { u32x4 w; w.x = cvt_pk_bf16(f[0], f[1]); w.y = cvt_pk_bf16(f[2], f[3]); w.z = cvt_pk_bf16(f[4], f[5]); w.w = cvt_pk_bf16(f[6], f[7]); return w; }
DI int crow(int i, int h) { return (i & 3) + 8 * (i >> 2) + 4 * h; }
#define LDS_WAIT() asm volatile("s_waitcnt lgkmcnt(0)" ::: "memory")
#define VM_WAIT() asm volatile("s_waitcnt vmcnt(0)" ::: "memory")
#define MFMA32(a, b, c) __builtin_amdgcn_mfma_f32_32x32x16_bf16((a), (b), (c), 0, 0, 0)

namespace pg8 {
typedef unsigned short bf16_t;
constexpr int BM = 256, BK = 64, HALF = 128, HTB = HALF * BK * 2, STAGE_BYTES = 8 * HTB, NXCD = 8, WGM = 8;
__host__ __device__ __forceinline__ int lds_byte(int r, int c) { const int st = (r >> 4) * 2 + (c >> 5), rr = r & 15, cc = c & 31, ob = rr * 64 + cc * 2; return st * 1024 + (ob ^ (((ob >> 9) & 1) << 5)); }
__host__ __device__ __forceinline__ void stage_rc(int b, int& R, int& C) { const int st = b / 1024, sb = b % 1024, swz = sb ^ (((sb >> 9) & 1) << 5); R = (st >> 1) * 16 + swz / 64; C = (st & 1) * 32 + (swz % 64) / 2; }
__host__ __device__ __forceinline__ int perm32(int rho) { const int n = rho >> 4, i = rho & 15; return 8 * (i >> 2) + 4 * n + (i & 3); }

struct Unit { int pm, pn; };
struct Gemm { const bf16_t* A; const bf16_t* Bt; int K; };

struct StaticOrder {
    int nM, nN, nwg, G, c;
    DI void init(int nM_, int nN_, int G_, int c_) { nM = nM_; nN = nN_; nwg = nM * nN; G = G_; c = c_; }
    DI bool next(int i, Unit& u) const {
        const long L = (long)i * G + c; if (L >= nwg) return false;
        int wgid = (int)L; { const int q = nwg / NXCD, r = nwg % NXCD, xcd = wgid % NXCD, off = wgid / NXCD; wgid = (xcd < r ? xcd * (q + 1) : r * (q + 1) + (xcd - r) * q) + off; }
        const int nig = WGM * nN, gid = wgid / nig, fm = gid * WGM, gsz = (nM - fm) < WGM ? (nM - fm) : WGM;
        u.pm = fm + ((wgid % nig) % gsz); u.pn = (wgid % nig) / gsz; return true;
    }
    DI size_t b_off(const Unit& u, size_t tstep) const { return (size_t)u.pn * tstep; }
};
struct MoeOrder : StaticOrder {
    const int* tile_start; size_t expert_stride;
    DI bool next(int i, Unit& u) const { Unit t; const bool ok = StaticOrder::next(i, t); u.pm = __builtin_amdgcn_readfirstlane(t.pm); u.pn = __builtin_amdgcn_readfirstlane(t.pn); return ok; }
    DI size_t b_off(const Unit& u, size_t tstep) const {
        int e = 0;
#pragma unroll
        for (int j = 1; j < 16; ++j) e += (u.pm >= tile_start[j]) ? 1 : 0;
        e = __builtin_amdgcn_readfirstlane(e);
        return (size_t)e * expert_stride + (size_t)u.pn * tstep;
    }
};

typedef int i32x4 __attribute__((ext_vector_type(4)));
DI unsigned q8f(float x) { return (unsigned)(int)__builtin_rintf(x) & 0xffu; }
struct EpiBf16Q {
    static constexpr bool PERM = true, I8 = true, F8 = false;
    bf16_t* O; int ldc; const float* sa; const float* sb;
    DI void operator()(const f32x4 (&acc)[2][2][4][2], const Unit& u, int wr, int wc, int fr, int fq) const {
        const int row0 = u.pm * BM + wr * 64 + fr; const int col0 = u.pn * BM + wc * 32 + 8 * fq;
        f32x4 bv[2][2];
#pragma unroll
        for (int bj = 0; bj < 2; ++bj)
#pragma unroll
            for (int n = 0; n < 2; ++n) bv[bj][n] = *(const f32x4*)(sb + col0 + bj * HALF + 4 * n) * (1.0f / 127.0f);
#pragma unroll
        for (int ai = 0; ai < 2; ++ai)
#pragma unroll
            for (int m = 0; m < 4; ++m) { const int row = row0 + ai * HALF + m * 16; const float ra = sa[row]; bf16_t* rowp = O + (size_t)row * ldc + col0;
#pragma unroll
                for (int bj = 0; bj < 2; ++bj) { const f32x4 v0 = __builtin_convertvector(__builtin_bit_cast(i32x4, acc[ai][bj][m][0]), f32x4) * (bv[bj][0] * ra), v1 = __builtin_convertvector(__builtin_bit_cast(i32x4, acc[ai][bj][m][1]), f32x4) * (bv[bj][1] * ra);
                    u32x4 w; w.x = cvt_pk_bf16(v0[0], v0[1]); w.y = cvt_pk_bf16(v0[2], v0[3]); w.z = cvt_pk_bf16(v1[0], v1[1]); w.w = cvt_pk_bf16(v1[2], v1[3]);
                    *(u32x4*)(rowp + bj * HALF) = w; } }
    }
};
typedef int i32x8 __attribute__((ext_vector_type(8)));
constexpr float ACT_SCALE = 16.0f;
constexpr float HID_SCALE = 8.0f;
DI unsigned pk_fp8x4(float a, float b, float c, float d) {
    a = __builtin_amdgcn_fmed3f(a, -448.f, 448.f); b = __builtin_amdgcn_fmed3f(b, -448.f, 448.f); c = __builtin_amdgcn_fmed3f(c, -448.f, 448.f); d = __builtin_amdgcn_fmed3f(d, -448.f, 448.f);
    int w = __builtin_amdgcn_cvt_pk_fp8_f32(a, b, 0, false); w = __builtin_amdgcn_cvt_pk_fp8_f32(c, d, w, true); return (unsigned)w; }
struct EpiSwiGLUF8 {
    static constexpr bool PERM = true, I8 = false, F8 = true;
    unsigned char* O; int ldc; const float* gus; const int* tile_start;
    DI void operator()(const f32x4 (&acc)[2][2][4][2], const Unit& u, int wr, int wc, int fr, int fq) const {
        int e = 0;
#pragma unroll
        for (int j = 1; j < 16; ++j) e += (u.pm >= tile_start[j]) ? 1 : 0;
        const float mg = gus[2 * e], mu = gus[2 * e + 1] * HID_SCALE;
        const int row0 = u.pm * BM + wr * 64 + fr; const int col0 = u.pn * HALF + wc * 32 + 8 * fq;
#pragma unroll
        for (int ai = 0; ai < 2; ++ai)
#pragma unroll
            for (int m = 0; m < 4; ++m) { unsigned char* rowp = O + (size_t)(row0 + ai * HALF + m * 16) * ldc + col0;
                float o[8];
#pragma unroll
                for (int n = 0; n < 2; ++n)
#pragma unroll
                    for (int j = 0; j < 4; ++j) { const float g = acc[ai][0][m][n][j] * mg; o[n * 4 + j] = g * __builtin_amdgcn_rcpf(1.0f + __expf(-g)) * (acc[ai][1][m][n][j] * mu); }
                u32x2 w; w.x = pk_fp8x4(o[0], o[1], o[2], o[3]); w.y = pk_fp8x4(o[4], o[5], o[6], o[7]);
                *(u32x2*)rowp = w; }
    }
};
struct EpiSwiGLUQ {
    static constexpr bool PERM = true, I8 = true, F8 = false;
    unsigned char* O; int ldc; const float* sa; const float* sb; const int* rowmap; const int* tile_start;
    DI void operator()(const f32x4 (&acc)[2][2][4][2], const Unit& u, int wr, int wc, int fr, int fq) const {
        int e = 0;
#pragma unroll
        for (int j = 1; j < 16; ++j) e += (u.pm >= tile_start[j]) ? 1 : 0;
        const int row0 = u.pm * BM + wr * 64 + fr; const int col0 = u.pn * HALF + wc * 32 + 8 * fq, bcol0 = e * 2048 + u.pn * BM + wc * 32 + 8 * fq;
        f32x4 bv[2][2];
#pragma unroll
        for (int bj = 0; bj < 2; ++bj)
#pragma unroll
            for (int n = 0; n < 2; ++n) bv[bj][n] = *(const f32x4*)(sb + bcol0 + bj * HALF + 4 * n) * (1.0f / 127.0f);
#pragma unroll
        for (int ai = 0; ai < 2; ++ai)
#pragma unroll
            for (int m = 0; m < 4; ++m) { const int row = row0 + ai * HALF + m * 16; const float ra = sa[rowmap[row]]; unsigned char* rowp = O + (size_t)row * ldc + col0;
                float o[8];
#pragma unroll
                for (int n = 0; n < 2; ++n) { const f32x4 gv = __builtin_convertvector(__builtin_bit_cast(i32x4, acc[ai][0][m][n]), f32x4) * (bv[0][n] * ra), uv = __builtin_convertvector(__builtin_bit_cast(i32x4, acc[ai][1][m][n]), f32x4) * (bv[1][n] * ra);
#pragma unroll
                    for (int j = 0; j < 4; ++j) { const float g = gv[j]; o[n * 4 + j] = g * __builtin_amdgcn_rcpf(1.0f + __expf(-g)) * (uv[j] * HID_SCALE); } }
                u32x2 w; w.x = pk_fp8x4(o[0], o[1], o[2], o[3]); w.y = pk_fp8x4(o[4], o[5], o[6], o[7]);
                *(u32x2*)rowp = w; }
    }
};
template <bool QIN, bool F8IN = false> struct EpiI8Tile {
    static constexpr bool PERM = true, I8 = QIN, F8 = F8IN;
    unsigned char* O8; int ldc; float* SC; int ntile; const float* sa; const float* sb; LAS float* xch; const float* wds; const int* tile_start;
    DI void operator()(const f32x4 (&acc)[2][2][4][2], const Unit& u, int wr, int wc, int fr, int fq) const {
        const int row0 = u.pm * BM + wr * 64 + fr; const int col0 = u.pn * BM + wc * 32 + 8 * fq;
        float mul = 1.0f / 127.0f;
        if constexpr (F8IN) { int e = 0;
#pragma unroll
            for (int j = 1; j < 16; ++j) e += (u.pm >= tile_start[j]) ? 1 : 0;
            mul *= wds[e]; }
        f32x4 bv[2][2];
        if constexpr (QIN) {
#pragma unroll
            for (int bj = 0; bj < 2; ++bj)
#pragma unroll
                for (int n = 0; n < 2; ++n) bv[bj][n] = *(const f32x4*)(sb + col0 + bj * HALF + 4 * n) * (1.0f / 127.0f); }
        f32x4 v[2][4][2][2]; float lmax[2][4];
#pragma unroll
        for (int ai = 0; ai < 2; ++ai)
#pragma unroll
            for (int m = 0; m < 4; ++m) { float ra = 1.f; if constexpr (QIN) ra = sa[row0 + ai * HALF + m * 16]; float mx = 0.f;
#pragma unroll
                for (int bj = 0; bj < 2; ++bj)
#pragma unroll
                    for (int n = 0; n < 2; ++n) { f32x4 x; if constexpr (QIN) x = __builtin_convertvector(__builtin_bit_cast(i32x4, acc[ai][bj][m][n]), f32x4) * (bv[bj][n] * ra); else x = acc[ai][bj][m][n];
                        v[ai][m][bj][n] = x; mx = fmaxf(mx, fmaxf(fmaxf(fabsf(x[0]), fabsf(x[1])), fmaxf(fabsf(x[2]), fabsf(x[3])))); }
                mx = fmaxf(mx, sx<16>(mx)); mx = max32(mx);
                lmax[ai][m] = mx;
                if (fq == 0) xch[(ai * HALF + wr * 64 + m * 16 + fr) * 4 + wc] = mx; }
        asm volatile("s_waitcnt lgkmcnt(0)\n\ts_barrier" ::: "memory");
#pragma unroll
        for (int ai = 0; ai < 2; ++ai)
#pragma unroll
            for (int m = 0; m < 4; ++m) { const int rl = ai * HALF + wr * 64 + m * 16 + fr; const f32x4 q4 = *(const LAS f32x4*)(xch + rl * 4);
                const float rmax = fmaxf(fmaxf(q4[0], q4[1]), fmaxf(q4[2], q4[3])); const float inv = rmax > 0.f ? 127.0f * __builtin_amdgcn_rcpf(rmax) : 0.f;
                const int row = row0 + ai * HALF + m * 16;
                if (wc == 0 && fq == 0) SC[(size_t)row * ntile + u.pn] = rmax * mul;
                unsigned char* rowp = O8 + (size_t)row * ldc + col0;
#pragma unroll
                for (int bj = 0; bj < 2; ++bj) { const f32x4 x0 = v[ai][m][bj][0] * inv, x1 = v[ai][m][bj][1] * inv;
                    u32x2 w2; w2.x = q8f(x0[0]) | (q8f(x0[1]) << 8) | (q8f(x0[2]) << 16) | (q8f(x0[3]) << 24); w2.y = q8f(x1[0]) | (q8f(x1[1]) << 8) | (q8f(x1[2]) << 16) | (q8f(x1[3]) << 24);
                    *(u32x2*)(rowp + bj * HALF) = w2; } }
    }
};
constexpr float YS_SCALE = 64.0f;
struct EpiF8Out {
    static constexpr bool PERM = true, I8 = false, F8 = true;
    unsigned char* O8; int ldc; const float* wds; const int* tile_start;
    DI void operator()(const f32x4 (&acc)[2][2][4][2], const Unit& u, int wr, int wc, int fr, int fq) const {
        int e = 0;
#pragma unroll
        for (int j = 1; j < 16; ++j) e += (u.pm >= tile_start[j]) ? 1 : 0;
        const float mul = wds[e] * YS_SCALE;
        const int row0 = u.pm * BM + wr * 64 + fr; const int col0 = u.pn * BM + wc * 32 + 8 * fq;
#pragma unroll
        for (int ai = 0; ai < 2; ++ai)
#pragma unroll
            for (int m = 0; m < 4; ++m) { unsigned char* rowp = O8 + (size_t)(row0 + ai * HALF + m * 16) * ldc + col0;
#pragma unroll
                for (int bj = 0; bj < 2; ++bj) { const f32x4 x0 = acc[ai][bj][m][0] * mul, x1 = acc[ai][bj][m][1] * mul;
                    u32x2 w2; w2.x = pk_fp8x4(x0[0], x0[1], x0[2], x0[3]); w2.y = pk_fp8x4(x1[0], x1[1], x1[2], x1[3]);
                    *(u32x2*)(rowp + bj * HALF) = w2; } }
    }
};
struct EpiBf16 {
    static constexpr bool PERM = true, I8 = false, F8 = false;
    bf16_t* O; int ldc;
    DI void operator()(const f32x4 (&acc)[2][2][4][2], const Unit& u, int wr, int wc, int fr, int fq) const {
        const int row0 = u.pm * BM + wr * 64 + fr; const int col0 = u.pn * BM + wc * 32 + 8 * fq;
#pragma unroll
        for (int ai = 0; ai < 2; ++ai)
#pragma unroll
            for (int m = 0; m < 4; ++m) { bf16_t* rowp = O + (size_t)(row0 + ai * HALF + m * 16) * ldc + col0;
#pragma unroll
                for (int bj = 0; bj < 2; ++bj) { const f32x4 v0 = acc[ai][bj][m][0], v1 = acc[ai][bj][m][1];
                    u32x4 w; w.x = cvt_pk_bf16(v0[0], v0[1]); w.y = cvt_pk_bf16(v0[2], v0[3]); w.z = cvt_pk_bf16(v1[0], v1[1]); w.w = cvt_pk_bf16(v1[2], v1[3]);
                    *(u32x4*)(rowp + bj * HALF) = w; } }
    }
};
struct EpiSwiGLU {
    static constexpr bool PERM = true, I8 = false, F8 = false;
    bf16_t* O; int ldc;
    DI void operator()(const f32x4 (&acc)[2][2][4][2], const Unit& u, int wr, int wc, int fr, int fq) const {
        const int row0 = u.pm * BM + wr * 64 + fr; const int col0 = u.pn * HALF + wc * 32 + 8 * fq;
#pragma unroll
        for (int ai = 0; ai < 2; ++ai)
#pragma unroll
            for (int m = 0; m < 4; ++m) { bf16_t* rowp = O + (size_t)(row0 + ai * HALF + m * 16) * ldc + col0;
                float o[8];
#pragma unroll
                for (int n = 0; n < 2; ++n)
#pragma unroll
                    for (int j = 0; j < 4; ++j) { const float g = acc[ai][0][m][n][j], up = acc[ai][1][m][n][j]; o[n * 4 + j] = g * __builtin_amdgcn_rcpf(1.0f + __expf(-g)) * up; }
                u32x4 w; w.x = cvt_pk_bf16(o[0], o[1]); w.y = cvt_pk_bf16(o[2], o[3]); w.z = cvt_pk_bf16(o[4], o[5]); w.w = cvt_pk_bf16(o[6], o[7]);
                *(u32x4*)rowp = w; }
    }
};

template <class Epi, class Sched, bool GATHER>
DI void gemm_phase(LAS unsigned char* lds, const int tid, const Gemm g, const Sched& S, const Epi& E, const int* rowmap) {
    const int wid = __builtin_amdgcn_readfirstlane(tid >> 6), lane = tid & 63, wr = wid >> 2, wc = wid & 3, fr = lane & 15, fq = lane >> 4;
    const int K = g.K, nt = K / BK;
    unsigned voffA[2], voffB[2];
#pragma unroll
    for (int i = 0; i < 2; ++i) { int R, C; stage_rc(tid * 16 + i * 8192, R, C); const int Rb = Epi::PERM ? ((R & ~31) + perm32(R & 31)) : R;
        voffA[i] = (unsigned)(R * K + C) * 2u; voffB[i] = (unsigned)(Rb * K + C) * 2u; }
    const size_t kstep = (size_t)(BK * 2);
    const size_t hstep = (size_t)HALF * K * 2;
    const size_t tstep = 2 * hstep;
    const unsigned ldsw = (unsigned)wid * 1024u;
    const int aoff = lds_byte(wr * 64 + fr, fq * 8), boff = lds_byte(wc * 32 + fr, fq * 8);
#define PG8_SA(b, h) (((b) * 2 + (h)) * HTB)
#define PG8_SB(b, h) ((4 + (b) * 2 + (h)) * HTB)
#define PG8_STAGE(bufoff, gbase, voff) do { _Pragma("unroll") for (int _i = 0; _i < 2; ++_i) { unsigned vo_ = (voff)[_i]; asm volatile("" : "+v"(vo_)); \
        __builtin_amdgcn_global_load_lds((const unsigned*)((const char*)(gbase) + vo_), (LAS unsigned*)(lds + (bufoff) + ldsw + _i * 8192), 16, 0, 0); } } while (0)
#define PG8_LDA(dst, b, h) do { _Pragma("unroll") for (int m = 0; m < 4; ++m) { if constexpr (Epi::F8) { const i32x4 lo_ = *(const LAS i32x4*)(lds + PG8_SA(b, h) + aoff + m * 2048), hi_ = *(const LAS i32x4*)(lds + PG8_SA(b, h) + aoff + m * 2048 + 1024); \
            dst##8[m] = __builtin_shufflevector(lo_, hi_, 0, 1, 2, 3, 4, 5, 6, 7); } else { _Pragma("unroll") for (int k = 0; k < 2; ++k) dst[m][k] = *(const LAS bf16x8*)(lds + PG8_SA(b, h) + aoff + m * 2048 + k * 1024); } } } while (0)
#define PG8_LDB(dst, b, h) do { _Pragma("unroll") for (int n = 0; n < 2; ++n) { if constexpr (Epi::F8) { const i32x4 lo_ = *(const LAS i32x4*)(lds + PG8_SB(b, h) + boff + n * 2048), hi_ = *(const LAS i32x4*)(lds + PG8_SB(b, h) + boff + n * 2048 + 1024); \
            dst##8[n] = __builtin_shufflevector(lo_, hi_, 0, 1, 2, 3, 4, 5, 6, 7); } else { _Pragma("unroll") for (int k = 0; k < 2; ++k) dst[n][k] = *(const LAS bf16x8*)(lds + PG8_SB(b, h) + boff + n * 2048 + k * 1024); } } } while (0)
#define PG8_MMA(ai, bj, At, Bt) do { __builtin_amdgcn_s_setprio(1); _Pragma("unroll") for (int m = 0; m < 4; ++m) _Pragma("unroll") for (int n = 0; n < 2; ++n) _Pragma("unroll") for (int k = 0; k < 2; ++k) { \
        if constexpr (Epi::F8) { if (k == 0) acc[ai][bj][m][n] = __builtin_amdgcn_mfma_scale_f32_16x16x128_f8f6f4(Bt##8[n], At##8[m], acc[ai][bj][m][n], 0, 0, 0, 0, 0, 0); } \
        else if constexpr (Epi::I8) acc[ai][bj][m][n] = __builtin_bit_cast(f32x4, __builtin_amdgcn_mfma_i32_16x16x64_i8(__builtin_bit_cast(i32x4, Bt[n][k]), __builtin_bit_cast(i32x4, At[m][k]), __builtin_bit_cast(i32x4, acc[ai][bj][m][n]), 0, 0, 0)); \
        else acc[ai][bj][m][n] = __builtin_amdgcn_mfma_f32_16x16x32_bf16(Bt[n][k], At[m][k], acc[ai][bj][m][n], 0, 0, 0); } __builtin_amdgcn_s_setprio(0); } while (0)
#define PG8_WAIT_V(n) asm volatile("s_waitcnt vmcnt(" #n ")" ::: "memory")
#define PG8_WAIT_L(n) asm volatile("s_waitcnt lgkmcnt(" #n ")" ::: "memory")
#define PG8_BAR __builtin_amdgcn_s_barrier()
#define PG8_SCHED __builtin_amdgcn_sched_barrier(0)
    Unit cur, nxt; int ui = 0;
    if (!S.next(0, cur)) return;
    f32x4 acc[2][2][4][2];
#pragma unroll
    for (int a = 0; a < 2; ++a)
#pragma unroll
        for (int b = 0; b < 2; ++b)
#pragma unroll
            for (int m = 0; m < 4; ++m)
#pragma unroll
                for (int n = 0; n < 2; ++n) acc[a][b][m][n] = (f32x4){0.f, 0.f, 0.f, 0.f};
    bf16x8 At[4][2], B0[2][2], B1[2][2];
    i32x8 At8[4], B08[2], B18[2];
    unsigned cvA[2][2];
    const char* cA = (const char*)g.A + (GATHER ? (size_t)0 : (size_t)cur.pm * tstep);
#define PG8_LOAD_ROWS(unit) do { _Pragma("unroll") for (int h = 0; h < 2; ++h) _Pragma("unroll") for (int i = 0; i < 2; ++i) { int R, C; stage_rc(tid * 16 + i * 8192, R, C); \
        cvA[h][i] = (unsigned)(rowmap[(unit).pm * BM + h * HALF + R] * K + C) * 2u; } } while (0)
    if constexpr (GATHER) { PG8_LOAD_ROWS(cur); }
    const char* cB = (const char*)g.Bt + S.b_off(cur, tstep);
#define PG8_STAGE_A(bufoff, base_direct, koff_gather, h, usenext) do { if constexpr (GATHER) { PG8_STAGE(bufoff, (const char*)g.A + (koff_gather), cvA[h]); } \
        else { PG8_STAGE(bufoff, (base_direct), voffA); } } while (0)
    PG8_STAGE(PG8_SB(0, 0), cB, voffB); PG8_STAGE(PG8_SB(0, 1), cB + hstep, voffB); PG8_STAGE_A(PG8_SA(0, 0), cA, 0, 0, false); PG8_STAGE_A(PG8_SA(0, 1), cA + hstep, 0, 1, false);
    if (wr == 1) PG8_BAR;
    PG8_WAIT_V(2); PG8_BAR;
    PG8_STAGE(PG8_SB(1, 0), cB + kstep, voffB); PG8_STAGE_A(PG8_SA(1, 0), cA + kstep, kstep, 0, false); PG8_STAGE(PG8_SB(1, 1), cB + hstep + kstep, voffB);
    PG8_WAIT_V(6); PG8_BAR;
    for (;;) {
        const bool has_next = S.next(ui + 1, nxt);
        const char* nA = has_next ? (const char*)g.A + (GATHER ? (size_t)0 : (size_t)nxt.pm * tstep) : cA; const char* nB = has_next ? (const char*)g.Bt + S.b_off(nxt, tstep) : cB;
        for (int t = 0; t < nt; t += 2) {
            const bool last = (t == nt - 2);
            const char* a1 = cA + (size_t)(t + 1) * kstep;
            const char* a2 = last ? nA : cA + (size_t)(t + 2) * kstep; const char* b2 = last ? nB : cB + (size_t)(t + 2) * kstep;
            const char* a3 = a2 + kstep; const char* b3 = b2 + kstep;
            const size_t k1 = (size_t)(t + 1) * kstep, k2 = last ? (size_t)0 : (size_t)(t + 2) * kstep, k3 = k2 + kstep;
            PG8_LDB(B0, 0, 0); PG8_LDB(B1, 0, 1); PG8_SCHED; PG8_LDA(At, 0, 0); PG8_STAGE_A(PG8_SA(1, 1), a1 + hstep, k1, 1, false);
            if constexpr (GATHER) { if (last && has_next) { PG8_LOAD_ROWS(nxt); } }
            PG8_WAIT_V(8); PG8_WAIT_L(0); PG8_BAR; PG8_MMA(0, 0, At, B0); PG8_MMA(0, 1, At, B1); PG8_BAR; PG8_SCHED;
            PG8_LDA(At, 0, 1); PG8_STAGE(PG8_SB(0, 0), b2, voffB); PG8_STAGE(PG8_SB(0, 1), b2 + hstep, voffB); PG8_STAGE_A(PG8_SA(0, 0), a2, k2, 0, last);
            PG8_WAIT_V(8); PG8_WAIT_L(0); PG8_BAR; PG8_MMA(1, 0, At, B0); PG8_MMA(1, 1, At, B1); PG8_BAR; PG8_SCHED;
            PG8_LDB(B0, 1, 0); PG8_LDB(B1, 1, 1); PG8_SCHED; PG8_LDA(At, 1, 0); PG8_STAGE_A(PG8_SA(0, 1), a2 + hstep, k2, 1, last);
            PG8_WAIT_V(8); PG8_WAIT_L(0); PG8_BAR; PG8_MMA(0, 0, At, B0); PG8_MMA(0, 1, At, B1); PG8_BAR; PG8_SCHED;
            PG8_LDA(At, 1, 1); PG8_STAGE(PG8_SB(1, 0), b3, voffB); PG8_STAGE(PG8_SB(1, 1), b3 + hstep, voffB); PG8_STAGE_A(PG8_SA(1, 0), a3, k3, 0, last);
            PG8_WAIT_V(8); PG8_WAIT_L(0); PG8_BAR; PG8_MMA(1, 0, At, B0); PG8_MMA(1, 1, At, B1); PG8_BAR; PG8_SCHED;
        }
        if (wr == 0) PG8_BAR;
        { const int ln_ = lane_fresh(); int fr_ = ln_ & 15, fq_ = ln_ >> 4; asm volatile("" : "+v"(fr_), "+v"(fq_));
          E(acc, cur, wr, wc, fr_, fq_); }
        if (!has_next) break;
#pragma unroll
        for (int a = 0; a < 2; ++a)
#pragma unroll
            for (int b = 0; b < 2; ++b)
#pragma unroll
                for (int m = 0; m < 4; ++m)
#pragma unroll
                    for (int n = 0; n < 2; ++n) acc[a][b][m][n] = (f32x4){0.f, 0.f, 0.f, 0.f};
        cur = nxt; cA = nA; cB = nB; ++ui;
        if (wr == 1) PG8_BAR;
    }
    PG8_WAIT_V(0);
    PG8_BAR;
#undef PG8_SA
#undef PG8_SB
#undef PG8_STAGE
#undef PG8_STAGE_A
#undef PG8_LOAD_ROWS
#undef PG8_LDA
#undef PG8_LDB
#undef PG8_MMA
#undef PG8_WAIT_V
#undef PG8_WAIT_L
#undef PG8_BAR
#undef PG8_SCHED
}
}

#define XB_TMO      128
#define XB_XCNT(j)  (256  + 64 * (j))
#define XB_XSUB(j)  (1280 + 64 * (j))
#define XB_XGEN(j)  (2304 + 64 * (j))
#define XB_TOP      3328
#define XB_TOPGEN   3392
#define XCD_BAR_WORDS 3456
#define XB_SPIN_CAP (1u << 18)
__device__ __forceinline__ unsigned xb_ld(unsigned* p)              { return __hip_atomic_load(p, __ATOMIC_RELAXED, __HIP_MEMORY_SCOPE_AGENT); }
__device__ __forceinline__ unsigned xb_add(unsigned* p, unsigned v) { return __hip_atomic_fetch_add(p, v, __ATOMIC_RELAXED, __HIP_MEMORY_SCOPE_AGENT); }
__device__ __forceinline__ unsigned xb_xcc_id() { return (unsigned)__builtin_amdgcn_s_getreg((3 << 11) | 20) & 0xFu; }
#define XB_SPIN(cond, bar) do { unsigned _sp = 0; while (cond) { __builtin_amdgcn_s_sleep(1); \
    if ((++_sp & 255u) == 0u) { if (xb_ld(&(bar)[XB_TMO])) break; if (_sp > XB_SPIN_CAP) { atomicAdd(&(bar)[XB_TMO], 1u); break; } } } } while (0)
struct XcdBarrier { unsigned* bar; unsigned x; volatile LAS unsigned* st; };
__device__ __forceinline__ XcdBarrier xcd_barrier_post(unsigned* bar, volatile LAS unsigned* st) {
    XcdBarrier b; b.bar = bar; b.x = xb_xcc_id(); b.st = st;
    if (threadIdx.x == 0) (void)xb_add(&bar[XB_XCNT(b.x)], 1u);
    return b;
}
__device__ __forceinline__ void xcd_barrier_complete(unsigned* bar, unsigned x, unsigned& nloc, unsigned& nx) {
    const unsigned G = gridDim.x * gridDim.y * gridDim.z;
    unsigned sum, cnt, mine, sp = 0u;
    for (;;) {
        sum = 0u; cnt = 0u; mine = 0u;
#pragma unroll
        for (unsigned j = 0; j < 16; ++j) { const unsigned c = xb_ld(&bar[XB_XCNT(j)]); sum += c; cnt += (c > 0u) ? 1u : 0u; mine = (j == x) ? c : mine; }
        if (sum == G) break;
        __builtin_amdgcn_s_sleep(1);
        if ((++sp & 255u) == 0u) { if (xb_ld(&bar[XB_TMO])) break; if (sp > XB_SPIN_CAP) { atomicAdd(&bar[XB_TMO], 1u); break; } }
    }
    nloc = mine > 0u ? mine : 1u; nx = cnt > 0u ? cnt : 1u;
}
__device__ __forceinline__ void xcd_barrier(const XcdBarrier& b) {
    asm volatile("s_waitcnt vmcnt(0)" ::: "memory");
    __syncthreads();
    if (threadIdx.x == 0) {
        unsigned* bar = b.bar;
        __builtin_amdgcn_s_waitcnt(0);
        unsigned nloc = b.st[0], nx = b.st[1];
        if (nloc == 0u) { xcd_barrier_complete(bar, b.x, nloc, nx); b.st[0] = nloc; b.st[1] = nx; }
        const unsigned old = xb_add(&bar[XB_XSUB(b.x)], 1u);
        const unsigned gen = old / nloc;
        if (old + 1u == (gen + 1u) * nloc) {
            __builtin_amdgcn_fence(__ATOMIC_RELEASE, "agent");
            asm volatile("s_waitcnt vmcnt(0)" ::: "memory");
            const unsigned og = xb_add(&bar[XB_TOP], 1u);
            const unsigned tg = og / nx;
            if (og + 1u == (tg + 1u) * nx) xb_add(&bar[XB_TOPGEN], 1u);
            else XB_SPIN(xb_ld(&bar[XB_TOPGEN]) == tg, bar);
            __builtin_amdgcn_fence(__ATOMIC_ACQUIRE, "agent");
            xb_add(&bar[XB_XGEN(b.x)], 1u);
            asm volatile("s_waitcnt vmcnt(0)" ::: "memory");
        } else {
            XB_SPIN(xb_ld(&bar[XB_XGEN(b.x)]) == gen, bar);
            __builtin_amdgcn_fence(__ATOMIC_ACQUIRE, "agent");
            asm volatile("s_waitcnt vmcnt(0)" ::: "memory");
        }
    }
    __syncthreads();
}

struct Args { const float* in[20]; float* out; unsigned char* ws; int ph_lo, ph_hi; };
typedef __attribute__((address_space(4))) const unsigned char* kptr_t;
struct Frame {
    LAS unsigned char* lds;
    int tid, lane, wave, vcu, G, bx;
    int wave0;
    kptr_t ka;
};
DI void frame_refresh(Frame& F) {
    int wv = F.wave0; asm volatile("" : "+s"(wv)); int ln = lane_fresh(); asm volatile("" : "+v"(ln));
    F.lane = ln; F.wave = wv; F.tid = wv * 64 + ln;
    int g = gridDim.x; asm volatile("" : "+s"(g)); F.G = g; int bx = blockIdx.x; asm volatile("" : "+s"(bx)); F.bx = bx;
    F.vcu = (g % 8 == 0) ? (bx % 8) * (g / 8) + bx / 8 : bx;
    kptr_t p = (kptr_t)__builtin_amdgcn_kernarg_segment_ptr(); asm volatile("" : "+s"(p)); F.ka = p;
}
DI kptr_t karg_fresh() { kptr_t p = (kptr_t)__builtin_amdgcn_kernarg_segment_ptr(); asm volatile("" : "+s"(p)); return p; }
DI const float* fin(const Frame& F, int i) { return (const float*)(*(const GAS float* const __attribute__((address_space(4)))*)(F.ka + 8 * i)); }
DI unsigned char* fout(const Frame& F) { return (unsigned char*)(*(GAS unsigned char* const __attribute__((address_space(4)))*)(F.ka + 160)); }
DI unsigned char* fws(const Frame& F) { return (unsigned char*)(*(GAS unsigned char* const __attribute__((address_space(4)))*)(F.ka + 168)); }

typedef short v4i16_t __attribute__((ext_vector_type(4)));
DI s16x4 lds_tr(const LAS bf16* p) { return __builtin_bit_cast(s16x4, __builtin_amdgcn_ds_read_tr16_b64_v4i16((LAS v4i16_t*)p)); }
DI bf16x8 tr_frag(const LAS bf16* img, int stride, int row_lo, int row_hi, int colbase, int lane) {
    const int q = (lane & 15) >> 2, p = lane & 3, blk = (lane >> 4) & 1;
    const s16x4 lo = lds_tr(img + (row_lo + q) * stride + colbase + 16 * blk + 4 * p);
    const s16x4 hi = lds_tr(img + (row_hi + q) * stride + colbase + 16 * blk + 4 * p);
    return (bf16x8){lo[0], lo[1], lo[2], lo[3], hi[0], hi[1], hi[2], hi[3]};
}
DI int rot_off(int row, int col);
DI bf16x8 tr_frag_rot(const LAS bf16* img, int row_lo, int row_hi, int colbase, int lane) {
    const int q = (lane & 15) >> 2, p = lane & 3, blk = (lane >> 4) & 1;
    const s16x4 lo = lds_tr(img + rot_off(row_lo + q, colbase + 16 * blk + 4 * p));
    const s16x4 hi = lds_tr(img + rot_off(row_hi + q, colbase + 16 * blk + 4 * p));
    return (bf16x8){lo[0], lo[1], lo[2], lo[3], hi[0], hi[1], hi[2], hi[3]};
}
DI void transpose_item(const float* W, int N, int K, int k0, int n0, bf16* WT, int dst_row0, LAS bf16* img, int lane) {
    const int kk = lane >> 4, n4 = (lane & 15) * 4;
    f32x4 v[16];
#pragma unroll
    for (int i = 0; i < 16; ++i) v[i] = __builtin_nontemporal_load((const f32x4*)(W + (size_t)(k0 + 4 * i + kk) * N + n0 + n4));
#pragma unroll
    for (int i = 0; i < 16; ++i) { u32x2 w2; w2.x = cvt_pk_bf16(v[i].x, v[i].y); w2.y = cvt_pk_bf16(v[i].z, v[i].w); *(LAS u32x2*)(img + (4 * i + kk) * 72 + n4) = w2; }
    LDS_WAIT(); asm volatile("" ::: "memory");
    const int r = lane & 31, h = lane >> 5;
#pragma unroll
    for (int cb = 0; cb < 2; ++cb)
#pragma unroll
        for (int kb = 0; kb < 4; ++kb) { const bf16x8 f = tr_frag(img, 72, 16 * kb + 8 * h, 16 * kb + 8 * h + 4, 32 * cb, lane);
            *(bf16x8*)(WT + (size_t)(dst_row0 + 32 * cb + r) * K + k0 + 16 * kb + 8 * h) = f; }
    LDS_WAIT(); asm volatile("" ::: "memory");
}
DI void wabs_item(const float* W, int N, int k0, int n0, unsigned* dst, int lane) {
    const float* p = W + (size_t)k0 * N + n0 + lane * 4;
    f32x4 m = (f32x4){0.f, 0.f, 0.f, 0.f};
#pragma unroll 8
    for (int k = 0; k < 128; ++k) { const f32x4 v = __builtin_nontemporal_load((const f32x4*)(p + (size_t)k * N)); m.x = fmaxf(m.x, fabsf(v.x)); m.y = fmaxf(m.y, fabsf(v.y)); m.z = fmaxf(m.z, fabsf(v.z)); m.w = fmaxf(m.w, fabsf(v.w)); }
    unsigned* d = dst + lane * 4;
    __hip_atomic_fetch_max(d + 0, __float_as_uint(m.x), __ATOMIC_RELAXED, __HIP_MEMORY_SCOPE_AGENT); __hip_atomic_fetch_max(d + 1, __float_as_uint(m.y), __ATOMIC_RELAXED, __HIP_MEMORY_SCOPE_AGENT);
    __hip_atomic_fetch_max(d + 2, __float_as_uint(m.z), __ATOMIC_RELAXED, __HIP_MEMORY_SCOPE_AGENT); __hip_atomic_fetch_max(d + 3, __float_as_uint(m.w), __ATOMIC_RELAXED, __HIP_MEMORY_SCOPE_AGENT);
}
constexpr int WABS_I_IN = (NPROJ / 256) * 16, WABS_I_OUT = (DM / 256) * 16, WABS_I_G1 = (DEXP / 256) * 16, WABS_I_GU = NEXP * 2 * WABS_I_G1, WABS_PER_L = WABS_I_IN + WABS_I_OUT;
DI void wabs_layer_item(Frame& F, int l, int r) {
    unsigned* A = (unsigned*)(fws(F) + WS_CTL + CTL_ABS) + (size_t)l * ABS_PER_LAYER;
    if (r < WABS_I_IN) { const int nb = r >> 4, kr = r & 15; wabs_item(fin(F, 3) + (size_t)l * DM * NPROJ, NPROJ, 128 * kr, 256 * nb, A + ABS_IN + 256 * nb, F.lane); return; } r -= WABS_I_IN;
    if (r < WABS_I_OUT) { const int nb = r >> 4, kr = r & 15; wabs_item(fin(F, 10) + (size_t)l * DM * DM, DM, 128 * kr, 256 * nb, A + ABS_OUT + 256 * nb, F.lane); return; } r -= WABS_I_OUT;
    { const int e = r / (2 * WABS_I_G1), r2 = r % (2 * WABS_I_G1), isup = r2 / WABS_I_G1, r3 = r2 % WABS_I_G1, nb = r3 >> 4, kr = r3 & 15;
      const float* W = (isup ? fin(F, 16) : fin(F, 15)) + ((size_t)l * NEXP + e) * DM * DEXP;
      const int n0 = 256 * nb; unsigned* dst = A + ABS_GU + e * 2048;
      const float* p = W + (size_t)(128 * kr) * DEXP + n0 + F.lane * 4;
      f32x4 m = (f32x4){0.f, 0.f, 0.f, 0.f};
#pragma unroll 8
      for (int k = 0; k < 128; ++k) { const f32x4 v = __builtin_nontemporal_load((const f32x4*)(p + (size_t)k * DEXP)); m.x = fmaxf(m.x, fabsf(v.x)); m.y = fmaxf(m.y, fabsf(v.y)); m.z = fmaxf(m.z, fabsf(v.z)); m.w = fmaxf(m.w, fabsf(v.w)); }
      const int n = n0 + F.lane * 4; unsigned* d = dst + 256 * (n >> 7) + 128 * isup + (n & 127);
      __hip_atomic_fetch_max(d + 0, __float_as_uint(m.x), __ATOMIC_RELAXED, __HIP_MEMORY_SCOPE_AGENT); __hip_atomic_fetch_max(d + 1, __float_as_uint(m.y), __ATOMIC_RELAXED, __HIP_MEMORY_SCOPE_AGENT);
      __hip_atomic_fetch_max(d + 2, __float_as_uint(m.z), __ATOMIC_RELAXED, __HIP_MEMORY_SCOPE_AGENT); __hip_atomic_fetch_max(d + 3, __float_as_uint(m.w), __ATOMIC_RELAXED, __HIP_MEMORY_SCOPE_AGENT); }
}
DI void wabs_phase(Frame& F, int l) {
    const int gw = F.vcu * 8 + F.wave, NGW = F.G * 8;
    for (int it = gw; it < WABS_PER_L; it += NGW) wabs_layer_item(F, l, it);
}
constexpr int WABS_T1 = WABS_PER_L < 1024 ? WABS_PER_L : 1024;
DI int wabs_t2(int G, int nunits) { const int nfull = nunits % G, nidle = nfull ? G - nfull : G; const int t2 = WABS_T1 + nidle * 8; return t2 < WABS_PER_L ? t2 : WABS_PER_L; }
DI void wabs_tail(Frame& F, int nunits, int lo, int hi) {
    const int nfull = nunits % F.G; const int nidle = nfull ? F.G - nfull : F.G; const int fi = nfull ? F.bx - nfull : F.bx;
    if (fi < 0) return;
    for (int it = lo + fi * 8 + F.wave; it < hi; it += nidle * 8) wabs_layer_item(F, 1, it);
}
DI unsigned q8(float x) { return (unsigned)(int)__builtin_rintf(x) & 0xffu; }
DI void transpose_item_q(const float* W, int N, int K8, int k0, int n0, unsigned char* WT8, int dst_row0, const float* amax, LAS bf16* img, int lane) {
    const int kk2 = lane >> 4, n4 = (lane & 15) * 4;
    const f32x4 am = *(const f32x4*)(amax + dst_row0 + n4);
    const f32x4 inv = (f32x4){am.x > 0.f ? 127.0f / am.x : 0.f, am.y > 0.f ? 127.0f / am.y : 0.f, am.z > 0.f ? 127.0f / am.z : 0.f, am.w > 0.f ? 127.0f / am.w : 0.f};
    f32x4 va[8], vb[8];
#pragma unroll
    for (int i = 0; i < 8; ++i) { const float* p = W + (size_t)(k0 + 8 * i + 2 * kk2) * N + n0 + n4; va[i] = __builtin_nontemporal_load((const f32x4*)p); vb[i] = __builtin_nontemporal_load((const f32x4*)(p + N)); }
#pragma unroll
    for (int i = 0; i < 8; ++i) { const f32x4 a = va[i] * inv, b2 = vb[i] * inv;
        const unsigned e0 = q8(a.x) | (q8(b2.x) << 8), e1 = q8(a.y) | (q8(b2.y) << 8), e2 = q8(a.z) | (q8(b2.z) << 8), e3 = q8(a.w) | (q8(b2.w) << 8);
        u32x2 w2; w2.x = e0 | (e1 << 16); w2.y = e2 | (e3 << 16); *(LAS u32x2*)(img + (4 * i + kk2) * 72 + n4) = w2; }
    LDS_WAIT(); asm volatile("" ::: "memory");
    const int r = lane & 31, h = lane >> 5;
#pragma unroll
    for (int cb = 0; cb < 2; ++cb)
#pragma unroll
        for (int kb = 0; kb < 2; ++kb) { const bf16x8 f = tr_frag(img, 72, 16 * kb + 8 * h, 16 * kb + 8 * h + 4, 32 * cb, lane);
            *(bf16x8*)(WT8 + (size_t)(dst_row0 + 32 * cb + r) * K8 + k0 + 32 * kb + 16 * h) = f; }
    LDS_WAIT(); asm volatile("" ::: "memory");
}
DI void transpose_item_f8(const float* W, int N, int K8, int k0, int n0, unsigned char* WT8, int dst_row0, const float scale, LAS bf16* img, int lane) {
    const int kk2 = lane >> 4, n4 = (lane & 15) * 4;
    f32x4 va[8], vb[8];
#pragma unroll
    for (int i = 0; i < 8; ++i) { const float* p = W + (size_t)(k0 + 8 * i + 2 * kk2) * N + n0 + n4; va[i] = __builtin_nontemporal_load((const f32x4*)p); vb[i] = __builtin_nontemporal_load((const f32x4*)(p + N)); }
#pragma unroll
    for (int i = 0; i < 8; ++i) { const f32x4 a = va[i] * scale, b2 = vb[i] * scale;
        u32x2 w2; w2.x = pg8::pk_fp8x4(a.x, b2.x, a.y, b2.y); w2.y = pg8::pk_fp8x4(a.z, b2.z, a.w, b2.w); *(LAS u32x2*)(img + (4 * i + kk2) * 72 + n4) = w2; }
    LDS_WAIT(); asm volatile("" ::: "memory");
    const int r = lane & 31, h = lane >> 5;
#pragma unroll
    for (int cb = 0; cb < 2; ++cb)
#pragma unroll
        for (int kb = 0; kb < 2; ++kb) { const bf16x8 f = tr_frag(img, 72, 16 * kb + 8 * h, 16 * kb + 8 * h + 4, 32 * cb, lane);
            *(bf16x8*)(WT8 + (size_t)(dst_row0 + 32 * cb + r) * K8 + k0 + 32 * kb + 16 * h) = f; }
    LDS_WAIT(); asm volatile("" ::: "memory");
}
DI void convert_weights(Frame& F, int l) {
    LAS bf16* img = (LAS bf16*)(F.lds + F.wave * 9216);
    const int gw = F.vcu * 8 + F.wave, NGW = F.G * 8;
    const float* w_in = fin(F, 3) + (size_t)l * DM * NPROJ; const float* w_out = fin(F, 10) + (size_t)l * DM * DM;
    const float* w_gate = fin(F, 15) + (size_t)l * NEXP * DM * DEXP; const float* w_up = fin(F, 16) + (size_t)l * NEXP * DM * DEXP; const float* w_down = fin(F, 17) + (size_t)l * NEXP * DEXP * DM;
    unsigned char* WIN = fws(F) + WS_WIN; unsigned char* WOUT = fws(F) + WS_WOUT; unsigned char* WGU = fws(F) + WS_WGU; unsigned char* WD = fws(F) + WS_WD;
    const float* ABS = (const float*)(fws(F) + WS_CTL + CTL_ABS) + (size_t)l * ABS_PER_LAYER;
    LAS float* wred = (LAS float*)(F.lds + 81920); LAS float* wsc = wred + 384;
    __syncthreads();
#pragma unroll 1
    for (int eb = 0; eb < 3 * NEXP; eb += 16) {
        f32x4 v[16];
#pragma unroll
        for (int i = 0; i < 16; ++i) { const int e = eb + i; const float* src = e < NEXP ? w_down + (size_t)e * DEXP * DM : ((e & 1) ? w_up : w_gate) + (size_t)((e - NEXP) >> 1) * DM * DEXP;
            v[i] = *(const f32x4*)(src + 4 * F.tid); }
#pragma unroll
        for (int i = 0; i < 16; ++i) { const float m = wave_max(fmaxf(fmaxf(fabsf(v[i].x), fabsf(v[i].y)), fmaxf(fabsf(v[i].z), fabsf(v[i].w)))); if (F.lane == 0) wred[(eb + i) * 8 + F.wave] = m; } }
    __syncthreads();
    if (F.tid < 3 * NEXP) { float m = 1e-30f;
#pragma unroll
        for (int j = 0; j < 8; ++j) m = fmaxf(m, wred[F.tid * 8 + j]);
        const float sc = exp2f(floorf(log2f(64.0f / m))); wsc[F.tid] = sc;
        if (F.bx == 0) { if (F.tid < NEXP) ((float*)(fws(F) + WS_WDS))[l * NEXP + F.tid] = 1.0f / (pg8::HID_SCALE * sc); else ((float*)(fws(F) + WS_GUS))[l * 2 * NEXP + F.tid - NEXP] = 1.0f / (pg8::ACT_SCALE * sc); } }
    __syncthreads();
    constexpr int I_IN = (DM / 64) * (NPROJ / 64), I_OUT = (DM / 64) * (DM / 64), I_G1 = (DM / 64) * (DEXP / 64), I_GU = NEXP * 2 * I_G1, I_D1 = (DEXP / 64) * (DM / 64), I_D = NEXP * I_D1;
    constexpr int NITEMS = I_IN + I_OUT + I_GU + I_D;
    for (int it = gw; it < NITEMS; it += NGW) {
        int r = it;
        if (r < I_IN) { const int nblk = NPROJ / 64, kb = r / nblk, nb = r % nblk; transpose_item_q(w_in, NPROJ, DM, 64 * kb, 64 * nb, WIN, 64 * nb, ABS + ABS_IN, img, F.lane); continue; } r -= I_IN;
        if (r < I_OUT) { const int nblk = DM / 64, kb = r / nblk, nb = r % nblk; transpose_item_q(w_out, DM, DM, 64 * kb, 64 * nb, WOUT, 64 * nb, ABS + ABS_OUT, img, F.lane); continue; } r -= I_OUT;
        if (r < I_GU) { const int e = r / (2 * I_G1), r2 = r % (2 * I_G1), isup = r2 / I_G1, r3 = r2 % I_G1; const int nblk = DEXP / 64, kb = r3 / nblk, nb = r3 % nblk, n0 = 64 * nb;
            const float* W = (isup ? w_up : w_gate) + (size_t)e * DM * DEXP;
            transpose_item_f8(W, DEXP, DM, 64 * kb, n0, WGU + (size_t)e * 2048 * DM, 256 * (n0 >> 7) + 128 * isup + (n0 & 127), wsc[NEXP + 2 * e + isup], img, F.lane); continue; } r -= I_GU;
        { const int e = r / I_D1, r3 = r % I_D1; const int nblk = DM / 64, kb = r3 / nblk, nb = r3 % nblk;
            transpose_item_f8(w_down + (size_t)e * DEXP * DM, DM, DEXP, 64 * kb, 64 * nb, WD + (size_t)e * DM * DEXP, 64 * nb, wsc[e], img, F.lane); }
    }
}
DI void stage_gb(Frame& F, const float* g, const float* bb, LAS float* gl, LAS float* bl) {
    const f32x4 gv = *(const f32x4*)(g + 4 * F.tid), bv = *(const f32x4*)(bb + 4 * F.tid);
    *(LAS f32x4*)(gl + 4 * F.tid) = gv; *(LAS f32x4*)(bl + 4 * F.tid) = bv;
}
DI void ln_emb(Frame& F) {
    const int gw = F.vcu * 8 + F.wave, NGW = F.G * 8;
    const float* x = fin(F, 0); const float* g = fin(F, 1); const float* bb = fin(F, 2); bf16* H = (bf16*)(fws(F) + WS_H); unsigned char* H8 = fws(F) + WS_H8; float* HS = (float*)(fws(F) + WS_HS);
    LAS float* gl = (LAS float*)F.lds; LAS float* bl = gl + DM;
    __syncthreads(); stage_gb(F, g, bb, gl, bl); __syncthreads();
    f32x4 pre[8];
    if (gw < T_TOK) { const f32x4* xr = (const f32x4*)(x + (size_t)gw * DM) + F.lane;
#pragma unroll
        for (int j = 0; j < 8; ++j) pre[j] = __builtin_nontemporal_load(xr + 64 * j); }
    for (int m = gw; m < T_TOK; m += NGW) {
        f32x4 v[8]; float s = 0.f;
#pragma unroll
        for (int j = 0; j < 8; ++j) { v[j] = pre[j]; s += (v[j].x + v[j].y) + (v[j].z + v[j].w); }
        if (m + NGW < T_TOK) { const f32x4* xr = (const f32x4*)(x + (size_t)(m + NGW) * DM) + F.lane;
#pragma unroll
            for (int j = 0; j < 8; ++j) pre[j] = __builtin_nontemporal_load(xr + 64 * j); }
        const float mean = wave_sum(s) * (1.f / DM); float s2 = 0.f;
#pragma unroll
        for (int j = 0; j < 8; ++j) { v[j] = v[j] - mean; s2 += (v[j].x * v[j].x + v[j].y * v[j].y) + (v[j].z * v[j].z + v[j].w * v[j].w); }
        const float rstd = 1.f / sqrtf(wave_sum(s2) * (1.f / DM) + LN_EPS);
        u32x2* o8 = (u32x2*)(H + (size_t)m * DM) + F.lane; float am = 0.f;
#pragma unroll
        for (int j = 0; j < 8; ++j) { const f32x4 gg = ((const LAS f32x4*)gl)[F.lane + 64 * j], bv = ((const LAS f32x4*)bl)[F.lane + 64 * j];
            v[j] = v[j] * rstd * gg + bv; am = fmaxf(fmaxf(am, fmaxf(fabsf(v[j].x), fabsf(v[j].y))), fmaxf(fabsf(v[j].z), fabsf(v[j].w)));
            u32x2 w; w.x = cvt_pk_bf16(v[j].x, v[j].y); w.y = cvt_pk_bf16(v[j].z, v[j].w); o8[64 * j] = w; }
        am = wave_max(am); const float inv = am > 0.f ? 127.0f / am : 0.f;
        unsigned* q4 = (unsigned*)(H8 + (size_t)m * DM) + F.lane;
#pragma unroll
        for (int j = 0; j < 8; ++j) q4[64 * j] = q8(v[j].x * inv) | (q8(v[j].y * inv) << 8) | (q8(v[j].z * inv) << 16) | (q8(v[j].w * inv) << 24);
        if (F.lane == 0) HS[m] = am * (1.0f / 127.0f);
    }
}

constexpr int AT_KS = 72, AT_VS = 388;
DI void attn_phase(Frame& F, int l) {
    const bf16* P = (const bf16*)(fws(F) + WS_PROJ); bf16* Y = (bf16*)(fout(F) + DO_Y);
    LAS bf16* Ks = (LAS bf16*)F.lds; LAS bf16* Vt = (LAS bf16*)(F.lds + 384 * AT_KS * 2);
    const int tid = F.tid, lane = F.lane, w = F.wave, r = lane & 31, h = lane >> 5;
    const float* sinkp = fin(F, 4) + l * 8;
    const bool deal = (F.G == 256);
    const int u_first = deal ? (F.vcu >= 128 ? (F.vcu - 128) * 4 : F.vcu * 4 + 3) : F.vcu, u_step = deal ? 1 : F.G, u_end = deal ? (F.vcu >= 128 ? (F.vcu - 128) * 4 + 3 : F.vcu * 4 + 4) : NBATCH * 32 * 2;
    for (int u = u_first; u < u_end; u += u_step) {
        const int kvh = u & 1, n = (u >> 1) & 31, b = u >> 6;
        const size_t rowb = (size_t)b * SEQ;
        __syncthreads();
#pragma unroll
        for (int i = 0; i < 6; ++i) { const int idx = tid + 512 * i, row = idx >> 3, ch = idx & 7; const int tok = n * 128 - 128 + row;
            u32x4 kv = (u32x4){0u, 0u, 0u, 0u}, vv = (u32x4){0u, 0u, 0u, 0u};
            if (tok >= 0 && tok < SEQ) { const bf16* src = P + (rowb + tok) * NPROJ; kv = *(const u32x4*)(src + C_AK + kvh * 64 + ch * 8); vv = *(const u32x4*)(src + C_AV + kvh * 64 + ch * 8); }
            *(LAS u32x4*)(Ks + row * AT_KS + ch * 8) = kv;
            LAS bf16* vd = Vt + (ch * 8) * AT_VS + row;
            vd[0 * AT_VS] = (bf16)(vv.x & 0xffffu); vd[1 * AT_VS] = (bf16)(vv.x >> 16); vd[2 * AT_VS] = (bf16)(vv.y & 0xffffu); vd[3 * AT_VS] = (bf16)(vv.y >> 16);
            vd[4 * AT_VS] = (bf16)(vv.z & 0xffffu); vd[5 * AT_VS] = (bf16)(vv.z >> 16); vd[6 * AT_VS] = (bf16)(vv.w & 0xffffu); vd[7 * AT_VS] = (bf16)(vv.w >> 16); }
        __syncthreads();
        const int hq = kvh * 4 + (w >> 1);
        const float slope2 = exp2f(-(float)(hq + 1)) * 1.4426950408889634f; const float sink2 = sinkp[hq] * 1.4426950408889634f; const float c1 = 0.125f * 1.4426950408889634f;
        const bool edge = (n == 0) || (n == 31); const int jlo = (n == 0) ? 128 : 0, jhi = (n == 31) ? 256 : 384;
#pragma unroll 1
        for (int qi = 0; qi < 2; ++qi) {
            const int t0 = (w & 1) * 64 + 32 * qi;
            const bf16* qsrc = P + (rowb + n * 128 + t0 + r) * NPROJ + C_AQ + hq * 64 + 8 * h;
            bf16x8 qf[4];
#pragma unroll
            for (int ks = 0; ks < 4; ++ks) qf[ks] = *(const bf16x8*)(qsrc + ks * 16);
            float m = sink2, lsum = (h == 0) ? 1.0f : 0.0f;
            f32x16 O0, O1;
#pragma unroll
            for (int i = 0; i < 16; ++i) { O0[i] = 0.f; O1[i] = 0.f; }
#pragma unroll 1
            for (int kt = 0; kt < 9; ++kt) {
                const int j0 = t0 + 32 * kt;
                f32x16 s;
#pragma unroll
                for (int i = 0; i < 16; ++i) s[i] = 0.f;
#pragma unroll
                for (int ks = 0; ks < 4; ++ks) { const bf16x8 a = *(const LAS bf16x8*)(Ks + (j0 + r) * AT_KS + ks * 16 + 8 * h); s = MFMA32(a, qf[ks], s); }
                const float fbase = (float)(32 * kt - 128 - r + 4 * h);
#pragma unroll
                for (int i = 0; i < 16; ++i) { const float fd = fbase + (float)((i & 3) + 8 * (i >> 2)); s[i] = __builtin_fmaf(s[i], c1, -slope2 * __builtin_fabsf(fd)); }
                if (kt == 0 || kt == 8 || edge) {
#pragma unroll
                    for (int i = 0; i < 16; ++i) { const float fd = fbase + (float)((i & 3) + 8 * (i >> 2)); const int j = j0 + crow(i, h);
                        const bool ok = (__builtin_fabsf(fd) <= 128.f) && (j >= jlo) && (j < jhi); s[i] = ok ? s[i] : -INFINITY; } }
                float mx = -INFINITY;
#pragma unroll
                for (int i = 0; i < 16; ++i) mx = fmaxf(mx, s[i]);
                mx = max32(mx);
                const float mn = fmaxf(m, mx); const float sc = __builtin_amdgcn_exp2f(m - mn); m = mn;
                float ps = 0.f;
#pragma unroll
                for (int i = 0; i < 16; ++i) { const float p = __builtin_amdgcn_exp2f(s[i] - mn); s[i] = p; ps += p; }
                lsum = lsum * sc + ps;
#pragma unroll
                for (int i = 0; i < 16; ++i) { O0[i] *= sc; O1[i] *= sc; }
#pragma unroll
                for (int s2 = 0; s2 < 2; ++s2) {
                    u32x4 pw; pw.x = cvt_pk_bf16(s[8 * s2 + 0], s[8 * s2 + 1]); pw.y = cvt_pk_bf16(s[8 * s2 + 2], s[8 * s2 + 3]); pw.z = cvt_pk_bf16(s[8 * s2 + 4], s[8 * s2 + 5]); pw.w = cvt_pk_bf16(s[8 * s2 + 6], s[8 * s2 + 7]);
                    const bf16x8 pf = __builtin_bit_cast(bf16x8, pw);
                    const LAS bf16* vb = Vt + j0 + 16 * s2 + 4 * h;
                    { const u32x2 lo = *(const LAS u32x2*)(vb + r * AT_VS), hi = *(const LAS u32x2*)(vb + r * AT_VS + 8); const u32x4 aw = (u32x4){lo.x, lo.y, hi.x, hi.y}; O0 = MFMA32(__builtin_bit_cast(bf16x8, aw), pf, O0); }
                    { const u32x2 lo = *(const LAS u32x2*)(vb + (32 + r) * AT_VS), hi = *(const LAS u32x2*)(vb + (32 + r) * AT_VS + 8); const u32x4 aw = (u32x4){lo.x, lo.y, hi.x, hi.y}; O1 = MFMA32(__builtin_bit_cast(bf16x8, aw), pf, O1); }
                }
            }
            const float lt = sum32(lsum); const float inv = __builtin_amdgcn_rcpf(lt);
            bf16* yo = Y + (rowb + n * 128 + t0 + r) * DM + hq * 64 + 4 * h;
#pragma unroll
            for (int g4 = 0; g4 < 4; ++g4) {
                u32x2 w0; w0.x = cvt_pk_bf16(O0[4 * g4] * inv, O0[4 * g4 + 1] * inv); w0.y = cvt_pk_bf16(O0[4 * g4 + 2] * inv, O0[4 * g4 + 3] * inv); *(u32x2*)(yo + 8 * g4) = w0;
                u32x2 w1; w1.x = cvt_pk_bf16(O1[4 * g4] * inv, O1[4 * g4 + 1] * inv); w1.y = cvt_pk_bf16(O1[4 * g4 + 2] * inv, O1[4 * g4 + 3] * inv); *(u32x2*)(yo + 32 + 8 * g4) = w1; }
        }
    }
}

DI void conv_phase(Frame& F, int l) {
    const bf16* P = (const bf16*)(fws(F) + WS_PROJ); bf16* Y = (bf16*)(fout(F) + DO_Y);
    const float* cw = fin(F, 5) + (size_t)l * 3 * 512;
    const int nthr = F.G * 512;
    for (int it = F.vcu * 512 + F.tid; it < T_TOK * 64; it += nthr) {
        const int ch = it & 63, tok = it >> 6, tl = tok & (SEQ - 1);
        const bf16* src = P + (size_t)tok * NPROJ + ch * 8;
        float u0[8], u1[8], u2[8], bq[8], a[8], c[8];
        { const u32x4 cc = *(const u32x4*)(src + C_CC), hh = *(const u32x4*)(src + C_CH); unpack8(cc, a); unpack8(hh, c);
#pragma unroll
          for (int j = 0; j < 8; ++j) u1[j] = a[j] * c[j]; }
        if (tl > 0) { const u32x4 cc = *(const u32x4*)(src - NPROJ + C_CC), hh = *(const u32x4*)(src - NPROJ + C_CH); unpack8(cc, a); unpack8(hh, c);
#pragma unroll
          for (int j = 0; j < 8; ++j) u0[j] = a[j] * c[j]; }
        else {
#pragma unroll
          for (int j = 0; j < 8; ++j) u0[j] = 0.f; }
        if (tl < SEQ - 1) { const u32x4 cc = *(const u32x4*)(src + NPROJ + C_CC), hh = *(const u32x4*)(src + NPROJ + C_CH); unpack8(cc, a); unpack8(hh, c);
#pragma unroll
          for (int j = 0; j < 8; ++j) u2[j] = a[j] * c[j]; }
        else {
#pragma unroll
          for (int j = 0; j < 8; ++j) u2[j] = 0.f; }
        { const u32x4 bw = *(const u32x4*)(src + C_CB); unpack8(bw, bq); }
        float o[8];
#pragma unroll
        for (int j = 0; j < 8; ++j) { const int cidx = ch * 8 + j; o[j] = bq[j] * (cw[cidx] * u0[j] + cw[512 + cidx] * u1[j] + cw[1024 + cidx] * u2[j]); }
        *(u32x4*)(Y + (size_t)tok * DM + 512 + ch * 8) = pack8(o);
    }
}

constexpr int GL_RS = 72;
constexpr int GL_VS = 136;
constexpr int GL_RW = 128;
DI int rot_off(int row, int col) { return row * GL_RW + ((col + 32 * (row & 3) + 8 * ((row >> 2) & 3)) & (GL_RW - 1)); }
constexpr int GL_QH_OFF = 0;
constexpr int GL_KD_OFF = GL_QH_OFF + 64 * GL_RS * 2;
constexpr int GL_KT_OFF = GL_KD_OFF + 64 * GL_RS * 2;
constexpr int GL_QT_OFF = GL_KT_OFF + 64 * GL_RS * 2;
constexpr int GL_KO_OFF = GL_QT_OFF + 32 * GL_RS * 2;
constexpr int GL_V_OFF = GL_KO_OFF + 32 * GL_RS * 2;
constexpr int GL_RZ_OFF = GL_V_OFF + 2 * 64 * GL_VS * 2;
constexpr int GL_RQ_OFF = GL_RZ_OFF + 64 * GL_RS * 2;
constexpr int GL_OB_OFF = GL_RQ_OFF + 64 * GL_RS * 2;
constexpr int GL_SX_OFF = GL_OB_OFF + 64 * GL_VS * 2;
constexpr int GL_DEC_OFF = GL_SX_OFF + 2 * 128 * GL_RS * 2;
constexpr int GL_END = GL_DEC_OFF + 64 * 4;
static_assert(GL_END <= LDSCTL_OFF, "GLA LDS");
#define LDS_BARRIER() asm volatile("s_waitcnt lgkmcnt(0)\n\ts_barrier" ::: "memory")

template <int N> DI float dpp_row_shr(float x) { return __builtin_bit_cast(float, __builtin_amdgcn_update_dpp(0, __builtin_bit_cast(int, x), 0x110 + N, 0xf, 0xf, true)); }
DI float wave_scan_incl(float x, int lane) {
    x += dpp_row_shr<1>(x); x += dpp_row_shr<2>(x); x += dpp_row_shr<4>(x); x += dpp_row_shr<8>(x);
    x += __builtin_bit_cast(float, __builtin_amdgcn_update_dpp(0, __builtin_bit_cast(int, x), 0x142, 0xa, 0xf, false));
    x += __builtin_bit_cast(float, __builtin_amdgcn_update_dpp(0, __builtin_bit_cast(int, x), 0x143, 0xc, 0xf, false));
    (void)lane;
    return x;
}
DI float gla_lgamma(Frame& F, int l, int dir, int hh) { const float dl = fin(F, 8)[(l * 2 + dir) * 4 + hh]; return -__logf(1.0f + __expf(-dl)); }
DI bf16* gla_partial(Frame& F, int mixer, int dir, int dkh) {
    unsigned char* base = mixer == 0 ? (fout(F) + DO_OB) : (fws(F) + WS_OB1);
    return (bf16*)base + (size_t)(dir * 2 + dkh) * T_TOK * 512;
}

template <int I>
DI void gla_out_tile(const LAS bf16* Sc, const LAS bf16* Qh, const LAS bf16* Qt, const LAS bf16* Kd, const LAS bf16* Ko, const LAS bf16* Vc, LAS bf16* Ob, const int dvt, const int r, const int h, const int lane) {
    const LAS bf16* Qi = (I == 0) ? Qh : Qt;
    f32x16 acc;
#pragma unroll
    for (int i = 0; i < 16; ++i) acc[i] = 0.f;
#pragma unroll
    for (int ks = 0; ks < 4; ++ks) { const bf16x8 a = tr_frag_rot(Sc, 16 * ks + 8 * h, 16 * ks + 8 * h + 4, 32 * dvt, lane), bb = *(const LAS bf16x8*)(Qi + r * GL_RS + ks * 16 + 8 * h); acc = MFMA32(a, bb, acc); }
    bf16x8 qb[4];
#pragma unroll
    for (int ks = 0; ks < 4; ++ks) qb[ks] = *(const LAS bf16x8*)(Qh + (32 * I + r) * GL_RS + ks * 16 + 8 * h);
#pragma unroll
    for (int J = 0; J <= I; ++J) {
        const LAS bf16* Ksrc = (J == I) ? (Kd + (32 * J) * GL_RS) : Ko;
        f32x16 s;
#pragma unroll
        for (int i = 0; i < 16; ++i) s[i] = 0.f;
#pragma unroll
        for (int ks = 0; ks < 4; ++ks) { const bf16x8 a = *(const LAS bf16x8*)(Ksrc + r * GL_RS + ks * 16 + 8 * h); s = MFMA32(a, qb[ks], s); }
        if (J == I) {
#pragma unroll
            for (int i = 0; i < 16; ++i) s[i] = (crow(i, h) <= r) ? s[i] : 0.f; }
#pragma unroll
        for (int s2 = 0; s2 < 2; ++s2) {
            u32x4 pw; pw.x = cvt_pk_bf16(s[8 * s2 + 0], s[8 * s2 + 1]); pw.y = cvt_pk_bf16(s[8 * s2 + 2], s[8 * s2 + 3]); pw.z = cvt_pk_bf16(s[8 * s2 + 4], s[8 * s2 + 5]); pw.w = cvt_pk_bf16(s[8 * s2 + 6], s[8 * s2 + 7]);
            const int rl = 32 * J + 16 * s2 + 4 * h;
            const bf16x8 a = tr_frag_rot(Vc, rl, rl + 8, 32 * dvt, lane);
            acc = MFMA32(a, __builtin_bit_cast(bf16x8, pw), acc); }
    }
    LAS bf16* yo = Ob + (32 * I + r) * GL_VS + 32 * dvt + 4 * h;
#pragma unroll
    for (int g4 = 0; g4 < 4; ++g4) { u32x2 w0; w0.x = cvt_pk_bf16(acc[4 * g4], acc[4 * g4 + 1]); w0.y = cvt_pk_bf16(acc[4 * g4 + 2], acc[4 * g4 + 3]); *(LAS u32x2*)(yo + 8 * g4) = w0; }
}

DI void gla_seq_phase(Frame& F, int l, const float* lbp) {
    const bf16* P = (const bf16*)(fws(F) + WS_PROJ);
    const int tid = F.tid, lane = F.lane, w = F.wave, r = lane & 31, h = lane >> 5;
    LAS bf16* Qh = (LAS bf16*)(F.lds + GL_QH_OFF); LAS bf16* Kd = (LAS bf16*)(F.lds + GL_KD_OFF); LAS bf16* Qt = (LAS bf16*)(F.lds + GL_QT_OFF); LAS bf16* Kt = (LAS bf16*)(F.lds + GL_KT_OFF);
    LAS bf16* Ko = (LAS bf16*)(F.lds + GL_KO_OFF); LAS bf16* Vs = (LAS bf16*)(F.lds + GL_V_OFF); LAS bf16* Sx = (LAS bf16*)(F.lds + GL_SX_OFF); LAS float* dec = (LAS float*)(F.lds + GL_DEC_OFF);
    LAS bf16* Rz = (LAS bf16*)(F.lds + GL_RZ_OFF); LAS bf16* Rq = (LAS bf16*)(F.lds + GL_RQ_OFF); LAS bf16* Ob = (LAS bf16*)(F.lds + GL_OB_OFF);
    const int zrow = tid >> 3, zch = tid & 7, vrow0 = tid >> 4, vch = tid & 15;
    for (int unit = F.vcu; unit < 256; unit += F.G)
#pragma unroll 1
    for (int rp_ = 0; rp_ < 1 + (int)((((PH_DUP >> 17) & 1u) && unit < 128) || (((PH_DUP >> 18) & 1u) && unit >= 128)); ++rp_) {
        const int dkh = unit & 1, dir = (unit >> 1) & 1, hh = (unit >> 2) & 3, b = (unit >> 4) & 7, mixer = unit >> 7;
        const int qcol = mixer == 0 ? C_GQ : C_RQ, zcol = mixer == 0 ? (dir ? C_GZB : C_GZF) : C_RK, vcol = mixer == 0 ? C_GI : C_RV;
        const float lg = mixer == 1 ? gla_lgamma(F, l, dir, hh) : 0.f;
        const float rbu = (float)(lane + 1) * lg, rbeta = (lane >= 32) ? 32.f * lg : 0.f;
        const float rfa = __expf(rbu - rbeta), rfna = __expf(fminf(rbeta - rbu, 80.f)), rfkt = __expf(64.f * lg - rbu), re31 = __expf(32.f * lg), rdec = __expf(64.f * lg);
        const size_t rowb = (size_t)b * SEQ;
        bf16* ob = gla_partial(F, mixer, dir, dkh);
        const int dch = hh * 128 + 64 * dkh;
        float lbv[8];
#pragma unroll
        for (int j = 0; j < 8; ++j) lbv[j] = (mixer == 0 && lbp) ? lbp[dch + 8 * w + j] : 0.f;
        __syncthreads();
        for (int i = tid; i < 64 * GL_VS / 2; i += 512) ((LAS unsigned*)Sx)[i] = 0u;
        f32x16 st0, st1;
#pragma unroll
        for (int i = 0; i < 16; ++i) { st0[i] = 0.f; st1[i] = 0.f; }
        u32x4 zr, qr, vr0, vr1;
#define GLA_LOAD(cc) do { const int c_ = (cc); const bf16* s0_ = P + (rowb + c_ * 64 + (dir ? 63 - zrow : zrow)) * NPROJ; zr = *(const u32x4*)(s0_ + zcol + dch + 8 * zch); qr = *(const u32x4*)(s0_ + qcol + dch + 8 * zch); \
        const bf16* s1_ = P + (rowb + c_ * 64 + (dir ? 63 - vrow0 : vrow0)) * NPROJ + vcol + hh * 128 + 8 * vch; const bf16* s2_ = P + (rowb + c_ * 64 + (dir ? 63 - (vrow0 + 32) : (vrow0 + 32))) * NPROJ + vcol + hh * 128 + 8 * vch; \
        vr0 = *(const u32x4*)s1_; vr1 = *(const u32x4*)s2_; } while (0)
#define GLA_STASH(vb) do { *(LAS u32x4*)(Rz + zrow * GL_RS + 8 * zch) = zr; *(LAS u32x4*)(Rq + zrow * GL_RS + 8 * zch) = qr; \
        *(LAS u32x4*)(Vs + (vb) * (64 * GL_VS) + rot_off(vrow0, 8 * vch)) = vr0; *(LAS u32x4*)(Vs + (vb) * (64 * GL_VS) + rot_off(vrow0 + 32, 8 * vch)) = vr1; } while (0)
        GLA_LOAD(dir ? 63 : 0);
        GLA_STASH(0);
        GLA_LOAD(dir ? 62 : 1);
        LDS_BARRIER();
#pragma unroll 1
        for (int cs = 0; cs < 64; ++cs) {
            const int c = dir ? 63 - cs : cs;
            if (cs > 0) { const int cp = dir ? 64 - cs : cs - 1;
#pragma unroll
                for (int k2 = 0; k2 < 2; ++k2) { const int u = vrow0 + 32 * k2; const u32x4 ov = *(const LAS u32x4*)(Ob + u * GL_VS + 8 * vch);
                    *(u32x4*)(ob + (rowb + cp * 64 + (dir ? 63 - u : u)) * 512 + hh * 128 + 8 * vch) = ov; } }
            float kk[8], bq[8], qv[8];
            unpack8(*(const LAS u32x4*)(Rz + lane * GL_RS + 8 * w), kk); unpack8(*(const LAS u32x4*)(Rq + lane * GL_RS + 8 * w), qv);
            float qh[8], kd[8], kq[8], kt[8];
            if (mixer == 1) {
#pragma unroll
                for (int j = 0; j < 8; ++j) { const float k2 = kk[j] * 0.08838834764831845f; qh[j] = qv[j] * rfa; kd[j] = k2 * rfna; kt[j] = k2 * rfkt; kq[j] = (lane >= 32 ? qh[j] : kd[j]) * re31; }
                if (lane < 8) dec[8 * w + lane] = rdec;
            } else {
#pragma unroll
            for (int j = 0; j < 8; ++j) { const float f = lbv[j] + (1.0f - lbv[j]) * __builtin_amdgcn_rcpf(1.0f + __builtin_amdgcn_exp2f(kk[j] * -1.4426950408889634f)); kk[j] = 1.0f - f; bq[j] = __builtin_amdgcn_logf(f); }
#pragma unroll
            for (int j = 0; j < 8; ++j) bq[j] = wave_scan_incl(bq[j], lane);
#pragma unroll
            for (int j = 0; j < 8; ++j) {
                const float b31 = __builtin_bit_cast(float, __builtin_amdgcn_readlane(__builtin_bit_cast(int, bq[j]), 31));
                const float bl = __builtin_bit_cast(float, __builtin_amdgcn_readlane(__builtin_bit_cast(int, bq[j]), 63));
                const bool up = lane >= 32; const float beta = up ? b31 : 0.f; const float a = bq[j] - beta;
                const float e31 = __builtin_amdgcn_exp2f(b31);
                qh[j] = qv[j] * __builtin_amdgcn_exp2f(a); kd[j] = kk[j] * __builtin_amdgcn_exp2f(fminf(-a, 115.f)); kt[j] = kk[j] * __builtin_amdgcn_exp2f(bl - bq[j]);
                kq[j] = (up ? qh[j] : kd[j]) * e31;
            }
            if (lane == 63) {
                *(LAS f32x4*)(dec + 8 * w) = (f32x4){__builtin_amdgcn_exp2f(bq[0]), __builtin_amdgcn_exp2f(bq[1]), __builtin_amdgcn_exp2f(bq[2]), __builtin_amdgcn_exp2f(bq[3])};
                *(LAS f32x4*)(dec + 8 * w + 4) = (f32x4){__builtin_amdgcn_exp2f(bq[4]), __builtin_amdgcn_exp2f(bq[5]), __builtin_amdgcn_exp2f(bq[6]), __builtin_amdgcn_exp2f(bq[7])}; }
            }
            { const int off = lane * GL_RS + 8 * w;
              *(LAS u32x4*)(Qh + off) = pack8(qh); *(LAS u32x4*)(Kd + off) = pack8(kd); *(LAS u32x4*)(Kt + off) = pack8(kt);
              if (lane < 32) *(LAS u32x4*)(Ko + off) = pack8(kq); else *(LAS u32x4*)(Qt + (lane - 32) * GL_RS + 8 * w) = pack8(kq); }
            LDS_BARRIER();
            if (cs + 1 < 64) { GLA_STASH((cs + 1) & 1); if (cs + 2 < 64) GLA_LOAD(dir ? 61 - cs : cs + 2); }
            const LAS bf16* Vc = Vs + (cs & 1) * (64 * GL_VS);
            int lane2 = lane; asm volatile("" : "+v"(lane2));
            const int r2 = lane2 & 31, h2 = lane2 >> 5;
            if (w < 4) {
                gla_out_tile<0>(Sx + (cs & 1) * (64 * GL_VS), Qh, Qt, Kd, Ko, Vc, Ob, w, r2, h2, lane2);
                const float dl0 = dec[r], dl1 = dec[32 + r];
                LAS bf16* Sn = Sx + ((cs + 1) & 1) * (64 * GL_VS);
#pragma unroll
                for (int i = 0; i < 16; ++i) { st0[i] *= dl0; st1[i] *= dl1; }
#pragma unroll
                for (int ks = 0; ks < 4; ++ks) {
                    const bf16x8 a = tr_frag_rot(Vc, 16 * ks + 8 * h2, 16 * ks + 8 * h2 + 4, 32 * w, lane2);
                    const bf16x8 b0 = tr_frag(Kt, GL_RS, 16 * ks + 8 * h, 16 * ks + 8 * h + 4, 0, lane), b1 = tr_frag(Kt, GL_RS, 16 * ks + 8 * h, 16 * ks + 8 * h + 4, 32, lane);
                    st0 = MFMA32(a, b0, st0); st1 = MFMA32(a, b1, st1); }
#pragma unroll
                for (int g4 = 0; g4 < 4; ++g4) {
                    u32x2 w0; w0.x = cvt_pk_bf16(st0[4 * g4], st0[4 * g4 + 1]); w0.y = cvt_pk_bf16(st0[4 * g4 + 2], st0[4 * g4 + 3]); *(LAS u32x2*)(Sn + rot_off(r, 32 * w + 8 * g4 + 4 * h)) = w0;
                    u32x2 w1; w1.x = cvt_pk_bf16(st1[4 * g4], st1[4 * g4 + 1]); w1.y = cvt_pk_bf16(st1[4 * g4 + 2], st1[4 * g4 + 3]); *(LAS u32x2*)(Sn + rot_off(32 + r, 32 * w + 8 * g4 + 4 * h)) = w1; }
            } else gla_out_tile<1>(Sx + (cs & 1) * (64 * GL_VS), Qh, Qt, Kd, Ko, Vc, Ob, w & 3, r2, h2, lane2);
            LDS_BARRIER();
        }
        { const int cp = dir ? 0 : 63;
#pragma unroll
          for (int k2 = 0; k2 < 2; ++k2) { const int u = vrow0 + 32 * k2; const u32x4 ov = *(const LAS u32x4*)(Ob + u * GL_VS + 8 * vch);
              *(u32x4*)(ob + (rowb + cp * 64 + (dir ? 63 - u : u)) * 512 + hh * 128 + 8 * vch) = ov; } }
#undef GLA_LOAD
#undef GLA_STASH
    }
}
DI void gla_norm_phase(Frame& F, int l) {
    const bf16* P = (const bf16*)(fws(F) + WS_PROJ); const bf16* Y = (const bf16*)(fout(F) + DO_Y); unsigned char* Y8 = fws(F) + WS_Y8; float* YSC = (float*)(fws(F) + WS_YSC);
    const int gw = F.vcu * 8 + F.wave, NGW = F.G * 8, lane = F.lane;
    const bf16* p0 = gla_partial(F, 0, 0, 0); const bf16* p1 = gla_partial(F, 1, 0, 0);
    const float* ng0 = fin(F, 7) + (size_t)l * 512 + lane * 8; const float* ng1 = fin(F, 9) + (size_t)l * 512 + lane * 8;
    float cwv[3][8];
    { const float* cw = fin(F, 5) + (size_t)l * 3 * 512 + lane * 8;
#pragma unroll
      for (int t3 = 0; t3 < 3; ++t3) { const f32x4 c0 = *(const f32x4*)(cw + t3 * 512), c1 = *(const f32x4*)(cw + t3 * 512 + 4); cwv[t3][0] = c0.x; cwv[t3][1] = c0.y; cwv[t3][2] = c0.z; cwv[t3][3] = c0.w; cwv[t3][4] = c1.x; cwv[t3][5] = c1.y; cwv[t3][6] = c1.z; cwv[t3][7] = c1.w; } }
    for (int tok = gw; tok < T_TOK; tok += NGW) {
        float v[32];
        const u32x4 ya = __builtin_nontemporal_load((const u32x4*)(Y + (size_t)tok * DM + lane * 8));
        const int tl = tok & (SEQ - 1); const bf16* cs = P + (size_t)tok * NPROJ + lane * 8;
        const u32x4 z4 = (u32x4){0u, 0u, 0u, 0u};
        const u32x4 cbw = *(const u32x4*)(cs + C_CB), cc1 = *(const u32x4*)(cs + C_CC), ch1 = *(const u32x4*)(cs + C_CH);
        const u32x4 cc0 = tl > 0 ? *(const u32x4*)(cs - NPROJ + C_CC) : z4, ch0 = tl > 0 ? *(const u32x4*)(cs - NPROJ + C_CH) : z4;
        const u32x4 cc2 = tl < SEQ - 1 ? *(const u32x4*)(cs + NPROJ + C_CC) : z4, ch2 = tl < SEQ - 1 ? *(const u32x4*)(cs + NPROJ + C_CH) : z4;
        u32x4 pa[4], pb[4];
#pragma unroll
        for (int part = 0; part < 4; ++part) { pa[part] = __builtin_nontemporal_load((const u32x4*)(p0 + ((size_t)part * T_TOK + tok) * 512 + lane * 8)); pb[part] = __builtin_nontemporal_load((const u32x4*)(p1 + ((size_t)part * T_TOK + tok) * 512 + lane * 8)); }
        const u32x4 g0 = __builtin_nontemporal_load((const u32x4*)(P + (size_t)tok * NPROJ + C_GO + lane * 8)), g1 = __builtin_nontemporal_load((const u32x4*)(P + (size_t)tok * NPROJ + C_RG + lane * 8));
        { float t8[8]; unpack8(ya, t8);
#pragma unroll
          for (int q = 0; q < 8; ++q) v[q] = t8[q];
          float a0[8], h0[8], a1[8], h1[8], a2[8], h2[8], bq8[8]; unpack8(cc0, a0); unpack8(ch0, h0); unpack8(cc1, a1); unpack8(ch1, h1); unpack8(cc2, a2); unpack8(ch2, h2); unpack8(cbw, bq8);
#pragma unroll
          for (int q = 0; q < 8; ++q) v[8 + q] = bq8[q] * (cwv[0][q] * (a0[q] * h0[q]) + cwv[1][q] * (a1[q] * h1[q]) + cwv[2][q] * (a2[q] * h2[q])); }
#pragma unroll
        for (int mixer = 0; mixer < 2; ++mixer) {
            float o[8];
#pragma unroll
            for (int q = 0; q < 8; ++q) o[q] = 0.f;
#pragma unroll
            for (int part = 0; part < 4; ++part) { float t8[8]; unpack8(mixer == 0 ? pa[part] : pb[part], t8);
#pragma unroll
                for (int q = 0; q < 8; ++q) o[q] += t8[q]; }
            float s1 = 0.f, s2 = 0.f;
#pragma unroll
            for (int q = 0; q < 8; ++q) { s1 += o[q]; s2 += o[q] * o[q]; }
            s1 += sx<1>(s1); s2 += sx<1>(s2); s1 += sx<2>(s1); s2 += sx<2>(s2); s1 += sx<4>(s1); s2 += sx<4>(s2); s1 += sx<8>(s1); s2 += sx<8>(s2);
            float mean = 0.f, rstd;
            if (mixer == 0) rstd = __builtin_amdgcn_rsqf(s2 * (1.f / 128.f) + HN_EPS);
            else { mean = s1 * (1.f / 128.f); const float var = fmaxf(s2 * (1.f / 128.f) - mean * mean, 0.f); rstd = __builtin_amdgcn_rsqf(var + HN_EPS); }
            const float* ng = mixer == 0 ? ng0 : ng1; const f32x4 n0 = *(const f32x4*)ng, n1 = *(const f32x4*)(ng + 4); const float nn[8] = {n0.x, n0.y, n0.z, n0.w, n1.x, n1.y, n1.z, n1.w};
            float gate[8]; unpack8(mixer == 0 ? g0 : g1, gate);
#pragma unroll
            for (int q = 0; q < 8; ++q) v[16 + 8 * mixer + q] = (o[q] - mean) * rstd * nn[q] * siluf_(gate[q]);
        }
        float am = 0.f;
#pragma unroll
        for (int q = 0; q < 32; ++q) am = fmaxf(am, fabsf(v[q]));
        am = wave_max(am); const float inv = am > 0.f ? 127.0f / am : 0.f;
#pragma unroll
        for (int j = 0; j < 4; ++j) { u32x2 w2; w2.x = q8(v[j * 8] * inv) | (q8(v[j * 8 + 1] * inv) << 8) | (q8(v[j * 8 + 2] * inv) << 16) | (q8(v[j * 8 + 3] * inv) << 24);
            w2.y = q8(v[j * 8 + 4] * inv) | (q8(v[j * 8 + 5] * inv) << 8) | (q8(v[j * 8 + 6] * inv) << 16) | (q8(v[j * 8 + 7] * inv) << 24); *(u32x2*)(Y8 + (size_t)tok * DM + lane * 8 + 512 * j) = w2; }
        if (lane == 0) YSC[tok] = am * (1.0f / 127.0f);
    }
}

DI float reduce16(const float (&v)[16], int lane) {
    float a[8];
#pragma unroll
    for (int e = 0; e < 8; ++e) { const bool up = (lane & 32) != 0; const float keep = up ? v[e + 8] : v[e], give = up ? v[e] : v[e + 8]; a[e] = keep + sx32(give, lane); }
    float b4[4];
#pragma unroll
    for (int e = 0; e < 4; ++e) { const bool up = (lane & 16) != 0; const float keep = up ? a[e + 4] : a[e], give = up ? a[e] : a[e + 4]; b4[e] = keep + sx<16>(give); }
    float c2[2];
#pragma unroll
    for (int e = 0; e < 2; ++e) { const bool up = (lane & 8) != 0; const float keep = up ? b4[e + 2] : b4[e], give = up ? b4[e] : b4[e + 2]; c2[e] = keep + sx<8>(give); }
    float d; { const bool up = (lane & 4) != 0; const float keep = up ? c2[1] : c2[0], give = up ? c2[0] : c2[1]; d = keep + sx<4>(give); }
    d += sx<2>(d); d += sx<1>(d);
    return d;
}
constexpr int RW_RS = 2056;
DI void ln1_router_phase(Frame& F, int l, bool dry = false) {
    bf16* H = (bf16*)(fws(F) + WS_H); const unsigned char* MIX = fws(F) + WS_MIX; const float* MSC = (const float*)(fws(F) + WS_MSC);
    const float* g = fin(F, 11) + (size_t)l * DM; const float* bb = fin(F, 12) + (size_t)l * DM; const float* rw = fin(F, 13); const float* rb = fin(F, 14);
    int* EID = (int*)(fws(F) + WS_EID); float* EW = (float*)(fws(F) + WS_EW); int* CNT = (int*)(fws(F) + WS_CNT); unsigned char* H8 = fws(F) + WS_H8; float* HS = (float*)(fws(F) + WS_HS);
    bf16* HO = H; if (dry) { HO = (bf16*)(fws(F) + WS_OB1); H8 = fout(F) + DO_OB; EID = (int*)(fws(F) + WS_Y8); EW = (float*)(fws(F) + WS_Y8 + MiB); CNT = (int*)(fws(F) + WS_Y8 + 2 * MiB); HS = (float*)(fws(F) + WS_Y8 + 3 * MiB); }
    LAS bf16* rwb = (LAS bf16*)F.lds;
    LAS float* gl = (LAS float*)(F.lds + 16 * RW_RS * 2); LAS float* bl = gl + DM;
    LAS int* cnt = (LAS int*)(F.lds + LDSCTL_OFF + 64);
    const int lane = F.lane;
    const float rbe = rb[lane & 15];
    __syncthreads();
    stage_gb(F, g, bb, gl, bl);
    { f32x4 rv[16];
#pragma unroll
      for (int it = 0; it < 16; ++it) rv[it] = *(const f32x4*)(rw + 4 * (F.tid + 512 * it));
#pragma unroll
      for (int it = 0; it < 16; ++it) { const int i = 4 * (F.tid + 512 * it), k = i >> 4, e = i & 15; rwb[e * RW_RS + k] = f2bf(rv[it].x); rwb[(e + 1) * RW_RS + k] = f2bf(rv[it].y); rwb[(e + 2) * RW_RS + k] = f2bf(rv[it].z); rwb[(e + 3) * RW_RS + k] = f2bf(rv[it].w); } }
    for (int ch = F.vcu; ch < 256; ch += F.G) {
        if (F.tid < 16) cnt[F.tid] = 0;
        __syncthreads();
        const int tok0 = ch * 128 + F.wave * 16;
        u32x4 ph[4]; u32x2 pm[4]; float psc[4];
#pragma unroll
        for (int j = 0; j < 4; ++j) { ph[j] = *(const u32x4*)(H + (size_t)tok0 * DM + lane * 8 + 512 * j); pm[j] = __builtin_nontemporal_load((const u32x2*)(MIX + (size_t)tok0 * DM + lane * 8 + 512 * j)); psc[j] = MSC[(size_t)tok0 * 8 + (lane >> 5) + 2 * j]; }
#pragma unroll 1
        for (int ti = 0; ti < 16; ++ti) {
            const int tok = tok0 + ti;
            float v[32]; float s = 0.f;
#pragma unroll
            for (int j = 0; j < 4; ++j) { float a[8], m8[8]; unpack8(ph[j], a); unpack_i8(pm[j], psc[j], m8);
#pragma unroll
                for (int q = 0; q < 8; ++q) { v[j * 8 + q] = ALPHA * a[q] + m8[q]; s += v[j * 8 + q]; } }
            if (ti + 1 < 16) {
#pragma unroll
                for (int j = 0; j < 4; ++j) { ph[j] = *(const u32x4*)(H + (size_t)(tok + 1) * DM + lane * 8 + 512 * j); pm[j] = __builtin_nontemporal_load((const u32x2*)(MIX + (size_t)(tok + 1) * DM + lane * 8 + 512 * j)); psc[j] = MSC[(size_t)(tok + 1) * 8 + (lane >> 5) + 2 * j]; } }
            const float mean = wave_sum(s) * (1.f / DM); float s2 = 0.f;
#pragma unroll
            for (int q = 0; q < 32; ++q) { v[q] -= mean; s2 += v[q] * v[q]; }
            const float rstd = 1.f / sqrtf(wave_sum(s2) * (1.f / DM) + LN_EPS);
            float am = 0.f;
#pragma unroll
            for (int j = 0; j < 4; ++j) { const int c0 = lane * 8 + 512 * j; const f32x4 g0 = *(const LAS f32x4*)(gl + c0), g1 = *(const LAS f32x4*)(gl + c0 + 4), b0 = *(const LAS f32x4*)(bl + c0), b1 = *(const LAS f32x4*)(bl + c0 + 4);
                const float gg[8] = {g0.x, g0.y, g0.z, g0.w, g1.x, g1.y, g1.z, g1.w}, bv[8] = {b0.x, b0.y, b0.z, b0.w, b1.x, b1.y, b1.z, b1.w};
                float o[8];
#pragma unroll
                for (int q = 0; q < 8; ++q) { o[q] = v[j * 8 + q] * rstd * gg[q] + bv[q]; v[j * 8 + q] = o[q]; am = fmaxf(am, fabsf(o[q])); }
                *(u32x4*)(HO + (size_t)tok * DM + c0) = pack8(o); }
            (void)am; (void)HS;
#pragma unroll
            for (int j = 0; j < 4; ++j) { u32x2 w2; w2.x = pg8::pk_fp8x4(v[j * 8] * pg8::ACT_SCALE, v[j * 8 + 1] * pg8::ACT_SCALE, v[j * 8 + 2] * pg8::ACT_SCALE, v[j * 8 + 3] * pg8::ACT_SCALE);
                w2.y = pg8::pk_fp8x4(v[j * 8 + 4] * pg8::ACT_SCALE, v[j * 8 + 5] * pg8::ACT_SCALE, v[j * 8 + 6] * pg8::ACT_SCALE, v[j * 8 + 7] * pg8::ACT_SCALE); *(u32x2*)(H8 + (size_t)tok * DM + lane * 8 + 512 * j) = w2; }
        }
        asm volatile("s_waitcnt vmcnt(0)" ::: "memory");
        f32x4 acc = (f32x4){0.f, 0.f, 0.f, 0.f};
        { const bf16* hrow = HO + (size_t)(tok0 + (lane & 15)) * DM + 8 * (lane >> 4); const LAS bf16* wrow = rwb + (lane & 15) * RW_RS + 8 * (lane >> 4);
#pragma unroll 16
          for (int st = 0; st < 64; ++st) { const bf16x8 a = *(const bf16x8*)(hrow + 32 * st), bq = *(const LAS bf16x8*)(wrow + 32 * st); acc = __builtin_amdgcn_mfma_f32_16x16x32_bf16(a, bq, acc, 0, 0, 0); } }
#pragma unroll
        for (int reg = 0; reg < 4; ++reg) {
            const int tok = tok0 + 4 * (lane >> 4) + reg; const int rowb = lane & 48;
            const float x = acc[reg] + rbe;
            float mx = x;
            mx = fmaxf(mx, sx<1>(mx)); mx = fmaxf(mx, sx<2>(mx)); mx = fmaxf(mx, sx<4>(mx)); mx = fmaxf(mx, sx<8>(mx));
            const float p = __expf(x - mx);
            float qa = -1.f, qc = -1.f;
#pragma unroll
            for (int q = 0; q < 4; ++q) { const float y = shfl_idx(p, (lane & ~3) + q); if (y > qa) { qc = qa; qa = y; } else if (y > qc) qc = y; }
            const float gs = qa + qc;
            int gsel = 0; float gbest = -1.f;
#pragma unroll
            for (int gi = 0; gi < 4; ++gi) { const float y = shfl_idx(gs, rowb + 4 * gi); if (y > gbest) { gbest = y; gsel = gi; } }
            int i1 = 0, i2 = 0; float p1 = -1.f, p2 = -1.f;
#pragma unroll
            for (int q = 0; q < 4; ++q) { const float y = shfl_idx(p, rowb + 4 * gsel + q); if (y > p1) { p2 = p1; i2 = i1; p1 = y; i1 = q; } else if (y > p2) { p2 = y; i2 = q; } }
            if ((lane & 15) == 0) { const float inv = 1.f / (p1 + p2); const int e1 = gsel * 4 + i1, e2 = gsel * 4 + i2;
                EID[tok * 2] = e1; EID[tok * 2 + 1] = e2; EW[tok * 2] = p1 * inv; EW[tok * 2 + 1] = p2 * inv;
                __hip_atomic_fetch_add(cnt + e1, 1, __ATOMIC_RELAXED, __HIP_MEMORY_SCOPE_WORKGROUP); __hip_atomic_fetch_add(cnt + e2, 1, __ATOMIC_RELAXED, __HIP_MEMORY_SCOPE_WORKGROUP); }
        }
        __syncthreads();
        if (F.tid < 16) CNT[ch * 16 + F.tid] = cnt[F.tid];
        __syncthreads();
    }
}
DI void assign_phase(Frame& F) {
    const int* EID = (const int*)(fws(F) + WS_EID); const int* CNT = (const int*)(fws(F) + WS_CNT);
    int* SOT = (int*)(fws(F) + WS_SOT); int* TOS = (int*)(fws(F) + WS_TOS); int* TST = (int*)(fws(F) + WS_TST);
    LAS int* tot = (LAS int*)F.lds;
    LAS int* base = tot + 16;
    LAS int* pre = base + 16;
    LAS int* eids = pre + 16;
    LAS int* part = eids + 256;
    const int tid = F.tid;
    const int e = tid & 15, pp = tid >> 4;
    int cv[8];
#pragma unroll
    for (int k = 0; k < 8; ++k) cv[k] = CNT[(pp * 8 + k) * 16 + e];
    __syncthreads();
    { int s = 0;
#pragma unroll
      for (int k = 0; k < 8; ++k) s += cv[k];
      part[pp * 16 + e] = s; }
    __syncthreads();
    if (tid < 16) { int s = 0; for (int q = 0; q < 32; ++q) s += part[q * 16 + tid]; tot[tid] = s; }
    __syncthreads();
    if (tid == 0) { int acc = 0; for (int q = 0; q < 16; ++q) { base[q] = acc; acc += (tot[q] + 255) & ~255; }
        if (F.bx == 0) { int tacc = 0; for (int q = 0; q < 16; ++q) { TST[q] = tacc; tacc += (tot[q] + 255) >> 8; } TST[16] = tacc; } }
    __syncthreads();
    if (F.bx == 0) { for (int q = 0; q < 16; ++q) { const int lo = base[q] + tot[q], hi = base[q] + ((tot[q] + 255) & ~255); for (int s = lo + tid; s < hi; s += 512) TOS[s] = 0; } }
    for (int ch = F.vcu; ch < 256; ch += F.G) {
        __syncthreads();
        { int s = 0;
#pragma unroll
          for (int k = 0; k < 8; ++k) s += (pp * 8 + k < ch) ? cv[k] : 0;
          part[pp * 16 + e] = s; }
        if (tid < 256) eids[tid] = EID[ch * 256 + tid];
        __syncthreads();
        if (tid < 16) { int s = 0; for (int q = 0; q < 32; ++q) s += part[q * 16 + tid]; pre[tid] = s; }
        __syncthreads();
        if (tid < 256) { const int ee = eids[tid]; int rank = 0; for (int j = 0; j < tid; ++j) rank += (eids[j] == ee) ? 1 : 0;
            const int pos = base[ee] + pre[ee] + rank; const int tok = ch * 128 + (tid >> 1);
            TOS[pos] = tok; SOT[ch * 256 + tid] = pos; }
    }
}
DI void unpack_f8(u32x2 w, float* o) {
    const f32x2 a = __builtin_amdgcn_cvt_pk_f32_fp8((int)w.x, false), b = __builtin_amdgcn_cvt_pk_f32_fp8((int)w.x, true), c = __builtin_amdgcn_cvt_pk_f32_fp8((int)w.y, false), d = __builtin_amdgcn_cvt_pk_f32_fp8((int)w.y, true);
    o[0] = a.x; o[1] = a.y; o[2] = b.x; o[3] = b.y; o[4] = c.x; o[5] = c.y; o[6] = d.x; o[7] = d.y; }
DI void combine_ln2_phase(Frame& F, int l, bool final_out, bool dry = false) {
    bf16* H = (bf16*)(fws(F) + WS_H); const unsigned char* YS = fws(F) + WS_YS;
    const float* g = fin(F, 18) + (size_t)l * DM; const float* bb = fin(F, 19) + (size_t)l * DM;
    const int* SOT = (const int*)(fws(F) + WS_SOT); const float* EW = (const float*)(fws(F) + WS_EW);
    float* OUT = (float*)fout(F); unsigned char* H8 = fws(F) + WS_H8; float* HS = (float*)(fws(F) + WS_HS);
    bf16* HO = H; if (dry) { HO = (bf16*)(fws(F) + WS_OB1); H8 = fws(F) + WS_Y8; HS = (float*)(fws(F) + WS_YSC); final_out = false; }
    const int gw = F.vcu * 8 + F.wave, NGW = F.G * 8, lane = F.lane;
    LAS float* gl = (LAS float*)F.lds; LAS float* bl = gl + DM;
    __syncthreads(); stage_gb(F, g, bb, gl, bl); __syncthreads();
    int s0n = 0, s1n = 0; float w0n = 0.f, w1n = 0.f;
    float w0c = 0.f, w1c = 0.f; u32x4 ph[4]; u32x2 py0[4], py1[4];
    if (gw < T_TOK) { const int s0 = SOT[gw * 2], s1 = SOT[gw * 2 + 1]; w0c = EW[gw * 2]; w1c = EW[gw * 2 + 1];
#pragma unroll
        for (int j = 0; j < 4; ++j) { const int c0 = lane * 8 + 512 * j; ph[j] = *(const u32x4*)(H + (size_t)gw * DM + c0); py0[j] = __builtin_nontemporal_load((const u32x2*)(YS + (size_t)s0 * DM + c0)); py1[j] = __builtin_nontemporal_load((const u32x2*)(YS + (size_t)s1 * DM + c0)); }
        if (gw + NGW < T_TOK) { const int t2 = gw + NGW; s0n = SOT[t2 * 2]; s1n = SOT[t2 * 2 + 1]; w0n = EW[t2 * 2]; w1n = EW[t2 * 2 + 1]; } }
    for (int tok = gw; tok < T_TOK; tok += NGW) {
        const float w0 = w0c * (1.0f / pg8::YS_SCALE), w1 = w1c * (1.0f / pg8::YS_SCALE);
        float v[32]; float s = 0.f;
#pragma unroll
        for (int j = 0; j < 4; ++j) { float a[8], y0[8], y1[8]; unpack8(ph[j], a); unpack_f8(py0[j], y0); unpack_f8(py1[j], y1);
#pragma unroll
            for (int q = 0; q < 8; ++q) { v[j * 8 + q] = ALPHA * a[q] + w0 * y0[q] + w1 * y1[q]; s += v[j * 8 + q]; } }
        if (tok + NGW < T_TOK) { const int t1 = tok + NGW; const int s0 = s0n, s1 = s1n; w0c = w0n; w1c = w1n;
#pragma unroll
            for (int j = 0; j < 4; ++j) { const int c0 = lane * 8 + 512 * j; ph[j] = *(const u32x4*)(H + (size_t)t1 * DM + c0); py0[j] = __builtin_nontemporal_load((const u32x2*)(YS + (size_t)s0 * DM + c0)); py1[j] = __builtin_nontemporal_load((const u32x2*)(YS + (size_t)s1 * DM + c0)); }
            if (t1 + NGW < T_TOK) { const int t2 = t1 + NGW; s0n = SOT[t2 * 2]; s1n = SOT[t2 * 2 + 1]; w0n = EW[t2 * 2]; w1n = EW[t2 * 2 + 1]; } }
        const float mean = wave_sum(s) * (1.f / DM); float s2 = 0.f;
#pragma unroll
        for (int q = 0; q < 32; ++q) { v[q] -= mean; s2 += v[q] * v[q]; }
        const float rstd = 1.f / sqrtf(wave_sum(s2) * (1.f / DM) + LN_EPS);
#pragma unroll
        for (int j = 0; j < 4; ++j) { const int c0 = lane * 8 + 512 * j; const f32x4 g0 = *(const LAS f32x4*)(gl + c0), g1 = *(const LAS f32x4*)(gl + c0 + 4), b0 = *(const LAS f32x4*)(bl + c0), b1 = *(const LAS f32x4*)(bl + c0 + 4);
            const float gg[8] = {g0.x, g0.y, g0.z, g0.w, g1.x, g1.y, g1.z, g1.w}, bv[8] = {b0.x, b0.y, b0.z, b0.w, b1.x, b1.y, b1.z, b1.w};
            float o[8];
#pragma unroll
            for (int q = 0; q < 8; ++q) { o[q] = v[j * 8 + q] * rstd * gg[q] + bv[q]; v[j * 8 + q] = o[q]; }
            if (final_out) { __builtin_nontemporal_store((f32x4){o[0], o[1], o[2], o[3]}, (f32x4*)(OUT + (size_t)tok * DM + c0)); __builtin_nontemporal_store((f32x4){o[4], o[5], o[6], o[7]}, (f32x4*)(OUT + (size_t)tok * DM + c0 + 4)); }
            else *(u32x4*)(HO + (size_t)tok * DM + c0) = pack8(o); }
        if (!final_out) { float am = 0.f;
#pragma unroll
            for (int q = 0; q < 32; ++q) am = fmaxf(am, fabsf(v[q]));
            am = wave_max(am); const float inv = am > 0.f ? 127.0f / am : 0.f;
#pragma unroll
            for (int j = 0; j < 4; ++j) { u32x2 w2; w2.x = q8(v[j * 8] * inv) | (q8(v[j * 8 + 1] * inv) << 8) | (q8(v[j * 8 + 2] * inv) << 16) | (q8(v[j * 8 + 3] * inv) << 24);
                w2.y = q8(v[j * 8 + 4] * inv) | (q8(v[j * 8 + 5] * inv) << 8) | (q8(v[j * 8 + 6] * inv) << 16) | (q8(v[j * 8 + 7] * inv) << 24); *(u32x2*)(H8 + (size_t)tok * DM + lane * 8 + 512 * j) = w2; }
            if (lane == 0) HS[tok] = am * (1.0f / 127.0f); }
    }
}

constexpr int PH_PER_LAYER = 9, N_PHASES = 2 + DEPTH * PH_PER_LAYER;
#ifndef PH_MASK
#define PH_MASK 0xFFFFFFFFu
#endif
#define PHM(b) ((PH_MASK >> (b)) & 1u)
#define REP(b) _Pragma("unroll") for (int rep_ = 0; rep_ < 1 + (int)((PH_DUP >> (b)) & 1u); ++rep_)
__global__ void __launch_bounds__(512, 2) mk_fwd(Args args) {
    extern __shared__ __attribute__((aligned(16))) unsigned char lds_raw[];
    Frame F;
    F.lds = (LAS unsigned char*)lds_raw;
    F.wave0 = __builtin_amdgcn_readfirstlane((int)threadIdx.x >> 6);
    frame_refresh(F);
    volatile LAS unsigned* MISC = (volatile LAS unsigned*)(F.lds + MISC_OFF);
    for (int u = F.tid; u < (LDS_BYTES - LDSCTL_OFF) / 4; u += 512) ((LAS unsigned*)(F.lds + LDSCTL_OFF))[u] = 0u;
    __syncthreads();
    unsigned* ctl = (unsigned*)(fws(F) + WS_CTL);
    XcdBarrier bar; bar.bar = ctl + CW_BAR; bar.x = 0; bar.st = nullptr;
    const int lo = args.ph_lo, hi = args.ph_hi;
    const bool multi = (hi - lo) > 1;
    if (multi) bar = xcd_barrier_post(ctl + CW_BAR, MISC + 8);
#define IN(k) (frame_refresh(F), (lo <= (k) && (k) < hi))
#define SEAM(k) do { if (lo <= (k) && (k) + 1 < hi) { _Pragma("unroll") for (int rb_ = 0; rb_ < 1 + (int)((PH_DUP >> 16) & 1u); ++rb_) { XcdBarrier b2_ = bar; asm volatile("" : "+s"(b2_.bar)); xcd_barrier(b2_); } } } while (0)
    if (IN(0) && PHM(0)) {
        REP(0) wabs_phase(F, 0);
        REP(14) ln_emb(F);
        if (F.bx == 0) { float* LB = (float*)(fws(F) + WS_TST + 128); const float* hl = fin(F, 6); for (int d = F.tid; d < 512; d += 512) LB[d] = 1.0f / (1.0f + __expf(hl[d] - hl[512 + d])); }
    }
    SEAM(0);
    if (IN(1) && PHM(0)) { REP(15) { convert_weights(F, 0); __syncthreads(); } }
    SEAM(1);
#pragma unroll 1
    for (int l = 0; l < DEPTH; ++l) {
        const int p0 = 2 + l * PH_PER_LAYER;
        const float* lbp = (l == 0) ? nullptr : (const float*)(fws(F) + WS_TST + 128);
        if (IN(p0 + 0) && PHM(1)) REP(1) {
            const float* ABS = (const float*)(fws(F) + WS_CTL + CTL_ABS) + (size_t)l * ABS_PER_LAYER;
            pg8::Gemm g{(const bf16*)(fws(F) + WS_H8), (const bf16*)(fws(F) + WS_WIN), DM / 2}; pg8::StaticOrder S; S.init(T_TOK / 256, NPROJ / 256, F.G, F.bx);
            pg8::EpiBf16Q E{(bf16*)(fws(F) + WS_PROJ), NPROJ, (const float*)(fws(F) + WS_HS), ABS + ABS_IN};
            pg8::gemm_phase<pg8::EpiBf16Q, pg8::StaticOrder, false>(F.lds, F.tid, g, S, E, nullptr);
            if (l == 0) { frame_refresh(F); wabs_tail(F, (T_TOK / 256) * (NPROJ / 256), 0, WABS_T1); }
        }
        SEAM(p0 + 0);
        if (IN(p0 + 1)) { if (PHM(4)) REP(4) gla_seq_phase(F, l, lbp); if (PHM(2)) REP(2) attn_phase(F, l); }
        SEAM(p0 + 1);
        if (IN(p0 + 2) && PHM(5)) REP(5) gla_norm_phase(F, l);
        SEAM(p0 + 2);
        if (IN(p0 + 3) && PHM(7)) REP(7) {
            __syncthreads();
            const float* ABS = (const float*)(fws(F) + WS_CTL + CTL_ABS) + (size_t)l * ABS_PER_LAYER;
            pg8::Gemm g{(const bf16*)(fws(F) + WS_Y8), (const bf16*)(fws(F) + WS_WOUT), DM / 2}; pg8::StaticOrder S; S.init(T_TOK / 256, DM / 256, F.G, F.bx);
            pg8::EpiI8Tile<true> E{fws(F) + WS_MIX, DM, (float*)(fws(F) + WS_MSC), 8, (const float*)(fws(F) + WS_YSC), ABS + ABS_OUT, (LAS float*)(F.lds + RING_BYTES)};
            pg8::gemm_phase<pg8::EpiI8Tile<true>, pg8::StaticOrder, false>(F.lds, F.tid, g, S, E, nullptr);
        }
        SEAM(p0 + 3);
        if (IN(p0 + 4) && PHM(8)) {
#pragma unroll 1
            for (int rep_ = 0; rep_ < 1 + (int)((PH_DUP >> 8) & 1u); ++rep_) ln1_router_phase(F, l, rep_ == 1); }
        SEAM(p0 + 4);
        if (IN(p0 + 5) && PHM(9)) REP(9) assign_phase(F);
        SEAM(p0 + 5);
        if (IN(p0 + 6) && PHM(10)) REP(10) {
            __syncthreads();
            const int* TST = (const int*)(fws(F) + WS_TST);
            const float* ABS = (const float*)(fws(F) + WS_CTL + CTL_ABS) + (size_t)l * ABS_PER_LAYER;
            pg8::Gemm g{(const bf16*)(fws(F) + WS_H8), (const bf16*)(fws(F) + WS_WGU), DM / 2}; pg8::MoeOrder S; S.init(__builtin_amdgcn_readfirstlane(TST[16]), 8, F.G, F.bx); S.tile_start = TST; S.expert_stride = (size_t)2048 * DM;
            pg8::EpiSwiGLUF8 E{fws(F) + WS_HID, DEXP, (const float*)(fws(F) + WS_GUS) + l * 2 * NEXP, TST}; (void)ABS;
            pg8::gemm_phase<pg8::EpiSwiGLUF8, pg8::MoeOrder, true>(F.lds, F.tid, g, S, E, (const int*)(fws(F) + WS_TOS));
            if (l == 0) { frame_refresh(F); const int nu = ((const int*)(fws(F) + WS_TST))[16] * 8; wabs_tail(F, nu, WABS_T1, wabs_t2(F.G, nu)); }
        }
        SEAM(p0 + 6);
        if (IN(p0 + 7) && PHM(11)) REP(11) {
            const int* TST = (const int*)(fws(F) + WS_TST);
            pg8::Gemm g{(const bf16*)(fws(F) + WS_HID), (const bf16*)(fws(F) + WS_WD), DEXP / 2}; pg8::MoeOrder S; S.init(__builtin_amdgcn_readfirstlane(TST[16]), 8, F.G, F.bx); S.tile_start = TST; S.expert_stride = (size_t)DM * DEXP;
            pg8::EpiF8Out E{fws(F) + WS_YS, DM, (const float*)(fws(F) + WS_WDS) + l * NEXP, TST};
            pg8::gemm_phase<pg8::EpiF8Out, pg8::MoeOrder, false>(F.lds, F.tid, g, S, E, nullptr);
            if (l == 0) { frame_refresh(F); const int nu = ((const int*)(fws(F) + WS_TST))[16] * 8; wabs_tail(F, nu, wabs_t2(F.G, nu), WABS_PER_L); }
        }
        SEAM(p0 + 7);
        if (IN(p0 + 8)) { if (PHM(12)) { if ((PH_DUP >> 12) & 1u) combine_ln2_phase(F, l, false, true); combine_ln2_phase(F, l, l == DEPTH - 1); } if (PHM(13) && l + 1 < DEPTH) { __syncthreads(); convert_weights(F, l + 1); } }
        if (l + 1 < DEPTH) SEAM(p0 + 8);
    }
#undef IN
#undef SEAM
}

extern "C" void kernel_launch(void* const* d_in, const int* in_sizes, int n_in, void* d_out, int out_size, void* d_ws, size_t ws_size, hipStream_t stream) {
    static int grid = 0;
    if (grid == 0) {
        if (n_in != 20 || out_size != T_TOK * DM || ws_size < WS_END) { fprintf(stderr, "kernel_launch: unexpected shapes (n_in %d out %d ws %zu)\n", n_in, out_size, ws_size); grid = -1; return; }
        int dev = 0, cus = 0;
        if (hipGetDevice(&dev) != hipSuccess || hipDeviceGetAttribute(&cus, hipDeviceAttributeMultiprocessorCount, dev) != hipSuccess) { grid = -1; return; }
        if (hipFuncSetAttribute((const void*)mk_fwd, hipFuncAttributeMaxDynamicSharedMemorySize, LDS_BYTES) != hipSuccess) { fprintf(stderr, "kernel_launch: hipFuncSetAttribute failed\n"); grid = -1; return; }
        int per_cu = 0;
        if (hipOccupancyMaxActiveBlocksPerMultiprocessor(&per_cu, (const void*)mk_fwd, 512, LDS_BYTES) != hipSuccess || per_cu < 1) fprintf(stderr, "kernel_launch: occupancy query reports %d\n", per_cu);
        (void)hipGetLastError();
        grid = cus;
    }
    if (grid < 0) return;
    (void)hipMemsetAsync((char*)d_ws + WS_CTL, 0, CTL_ZERO_BYTES, stream);
    Args a{};
    for (int i = 0; i < 20; ++i) a.in[i] = (const float*)d_in[i];
    a.out = (float*)d_out; a.ws = (unsigned char*)d_ws;
#if MK_ONE_LAUNCH
    a.ph_lo = 0; a.ph_hi = N_PHASES;
    hipLaunchKernelGGL(mk_fwd, dim3(grid), dim3(512), LDS_BYTES, stream, a);
#else
    for (int p = 0; p < N_PHASES; ++p) { a.ph_lo = p; a.ph_hi = p + 1; hipLaunchKernelGGL(mk_fwd, dim3(grid), dim3(512), LDS_BYTES, stream, a); }
#endif
}
```

```cpp
#include <hip/hip_runtime.h>
#ifndef PH_DUP
#define PH_DUP 0u
#endif
#include <cstdio>
#include <cstdint>

#ifndef MK_ONE_LAUNCH
#define MK_ONE_LAUNCH 1
#endif

#define LAS __attribute__((address_space(3)))
#define GAS __attribute__((address_space(1)))
typedef unsigned short bf16;
typedef short bf16x8 __attribute__((ext_vector_type(8)));
typedef short s16x4 __attribute__((ext_vector_type(4)));
typedef float f32x2 __attribute__((ext_vector_type(2)));
typedef float f32x4 __attribute__((ext_vector_type(4)));
typedef float f32x16 __attribute__((ext_vector_type(16)));
typedef unsigned u32x2 __attribute__((ext_vector_type(2)));
typedef unsigned u32x4 __attribute__((ext_vector_type(4)));
#define DI __device__ __forceinline__

constexpr int T_TOK = 32768, DM = 2048, SEQ = 4096, NBATCH = 8, NPROJ = 6912, NEXP = 16, DEXP = 1024, DEPTH = 2;
constexpr int SLOT_CAP = 69632;
constexpr float LN_EPS = 1e-5f, HN_EPS = 1e-6f, ALPHA = 1.41421356237f;
constexpr int C_AQ = 0, C_AK = 512, C_AV = 640, C_CB = 768, C_CC = 1280, C_CH = 1792, C_GQ = 2304, C_GZF = 2816, C_GZB = 3328, C_GI = 3840, C_GO = 4352,
              C_RQ = 4864, C_RK = 5376, C_RV = 5888, C_RG = 6400;

constexpr size_t MiB = 1u << 20, KiB = 1u << 10;
constexpr size_t WS_CTL = 0, CTL_ZERO_BYTES = 1 * MiB;
constexpr size_t WS_EID = 1 * MiB, WS_EW = WS_EID + 256 * KiB, WS_SOT = WS_EW + 256 * KiB, WS_TOS = WS_SOT + 256 * KiB, WS_CNT = WS_TOS + 272 * KiB, WS_TST = WS_CNT + 16 * KiB;
constexpr size_t WS_WDS = WS_TST + 3072;
constexpr size_t WS_INS = WS_WDS + 512;
constexpr size_t WS_GUS = WS_WDS + 128;
constexpr size_t WS_HS = 3 * MiB, WS_YSC = WS_HS + 128 * KiB;
constexpr size_t WS_WIN = 8 * MiB, WS_WOUT = 22 * MiB, WS_WGU = 26 * MiB, WS_WD = 90 * MiB;
constexpr size_t WS_H8 = 154 * MiB;
constexpr size_t WS_H = 235 * MiB, WS_PROJ = 363 * MiB, WS_OB1 = 795 * MiB, WS_Y8 = 923 * MiB, WS_END = 987 * MiB;
constexpr size_t WS_MIX = WS_PROJ, WS_MSC = WS_PROJ + 64 * MiB, WS_HID = WS_PROJ, WS_YS = WS_PROJ + 136 * MiB, WS_YSS = WS_YS + 136 * MiB;
static_assert(WS_TST + 4096 <= WS_HS && WS_YSC + 128 * KiB <= WS_WIN, "ws map");
static_assert(WS_WIN + (size_t)NPROJ * DM <= WS_WOUT && WS_WOUT + (size_t)DM * DM <= WS_WGU && WS_WGU + (size_t)NEXP * 2048 * DM <= WS_WD && WS_WD + (size_t)NEXP * DM * DEXP * 2 <= WS_H8 && WS_H8 + (size_t)T_TOK * DM <= WS_H, "ws map");
static_assert(WS_H + (size_t)T_TOK * DM * 2 <= WS_PROJ && WS_PROJ + (size_t)T_TOK * NPROJ * 2 <= WS_OB1 && WS_YSS + (size_t)SLOT_CAP * 8 * 4 <= WS_OB1 && WS_YS + (size_t)SLOT_CAP * DM <= WS_YSS && WS_MSC + (size_t)T_TOK * 8 * 4 <= WS_YS && WS_HID + (size_t)SLOT_CAP * DEXP * 2 <= WS_YS, "ws map");
constexpr size_t CTL_ABS = 64 * KiB; constexpr int ABS_IN = 0, ABS_OUT = NPROJ, ABS_GU = NPROJ + DM, ABS_PER_LAYER = NPROJ + DM + NEXP * 2048;
static_assert(CTL_ABS + (size_t)2 * ABS_PER_LAYER * 4 <= CTL_ZERO_BYTES, "ctl map");
constexpr size_t DO_Y = 0, DO_OB = 128 * MiB;
constexpr int CW_BAR = 4096;

constexpr int RING_BYTES = 131072, LDSCTL_OFF = 147456, MISC_OFF = LDSCTL_OFF + 320, LDS_BYTES = 148480;

typedef __bf16 bf16x2_t __attribute__((ext_vector_type(2)));
DI unsigned cvt_pk_bf16(float lo, float hi) { const f32x2 v = {lo, hi}; const bf16x2_t b = __builtin_convertvector(v, bf16x2_t); return __builtin_bit_cast(unsigned, b); }
DI float bf_lo(unsigned w) { return __uint_as_float(w << 16); }
DI float bf_hi(unsigned w) { return __uint_as_float(w & 0xffff0000u); }
DI float bf2f(bf16 b) { return __uint_as_float(((unsigned)b) << 16); }
DI bf16 f2bf(float f) { return (bf16)(cvt_pk_bf16(f, 0.f) & 0xffffu); }
DI int lane_fresh() { unsigned z = 0u; asm volatile("" : "+s"(z)); int ln = (int)__builtin_amdgcn_mbcnt_hi(~0u, __builtin_amdgcn_mbcnt_lo(~0u, z)); return ln; }
DI float shfl_idx(float v, int src_lane) { return __builtin_bit_cast(float, __builtin_amdgcn_ds_bpermute(src_lane << 2, __builtin_bit_cast(int, v))); }
template <int M> DI float sx(float v) { static_assert(M >= 1 && M < 32, "swizzle mask"); return __builtin_bit_cast(float, __builtin_amdgcn_ds_swizzle(__builtin_bit_cast(int, v), (M << 10) | 0x1f)); }
DI float sum32(float v) { return v + __builtin_bit_cast(float, __builtin_amdgcn_ds_bpermute((lane_fresh() ^ 32) << 2, __builtin_bit_cast(int, v))); }
DI float max32(float v) { return fmaxf(v, __builtin_bit_cast(float, __builtin_amdgcn_ds_bpermute((lane_fresh() ^ 32) << 2, __builtin_bit_cast(int, v)))); }
DI float sx32(float v, int lane) { return __builtin_bit_cast(float, __builtin_amdgcn_ds_bpermute((lane ^ 32) << 2, __builtin_bit_cast(int, v))); }
DI float wave_sum(float v) { v += sx<1>(v); v += sx<2>(v); v += sx<4>(v); v += sx<8>(v); v += sx<16>(v); return sum32(v); }
DI float wave_max(float v) { v = fmaxf(v, sx<1>(v)); v = fmaxf(v, sx<2>(v)); v = fmaxf(v, sx<4>(v)); v = fmaxf(v, sx<8>(v)); v = fmaxf(v, sx<16>(v)); return max32(v); }
DI float sigmoidf_(float z) { return __builtin_amdgcn_rcpf(1.0f + __expf(-z)); }
DI float siluf_(float z) { return z * __builtin_amdgcn_rcpf(1.0f + __expf(-z)); }
DI void unpack8(const u32x4 w, float (&f)[8]) { f[0] = bf_lo(w.x); f[1] = bf_hi(w.x); f[2] = bf_lo(w.y); f[3] = bf_hi(w.y); f[4] = bf_lo(w.z); f[5] = bf_hi(w.z); f[6] = bf_lo(w.w); f[7] = bf_hi(w.w); }
DI void unpack_i8(const u32x2 w, float sc, float (&f)[8]) {
#pragma unroll
    for (int k = 0; k < 4; ++k) { f[k] = (float)((int)(w.x << (24 - 8 * k)) >> 24) * sc; f[4 + k] = (float)((int)(w.y << (24 - 8 * k)) >> 24) * sc; }
}
DI u32x4 pack8(const float (&f)[8]) { u32x4 w; w.x = cvt_pk_bf16(f[0], f[1]); w.y = cvt_pk_bf16(f[2], f[3]); w.z = cvt_pk_bf16(f[4], f[5]); w.w = cvt_pk_bf16(f[6], f[7]); return w; }
DI int crow(int i, int h) { return (i & 3) + 8 * (i >> 2) + 4 * h; }
#define LDS_WAIT() asm volatile("s_waitcnt lgkmcnt(0)" ::: "memory")
#define VM_WAIT() asm volatile("s_waitcnt vmcnt(0)" ::: "memory")
#define MFMA32(a, b, c) __builtin_amdgcn_mfma_f32_32x32x16_bf16((a), (b), (c), 0, 0, 0)

namespace pg8 {
typedef unsigned short bf16_t;
constexpr int BM = 256, BK = 64, HALF = 128, HTB = HALF * BK * 2, STAGE_BYTES = 8 * HTB, NXCD = 8, WGM = 8;
__host__ __device__ __forceinline__ int lds_byte(int r, int c) { const int st = (r >> 4) * 2 + (c >> 5), rr = r & 15, cc = c & 31, ob = rr * 64 + cc * 2; return st * 1024 + (ob ^ (((ob >> 9) & 1) << 5)); }
__host__ __device__ __forceinline__ void stage_rc(int b, int& R, int& C) { const int st = b / 1024, sb = b % 1024, swz = sb ^ (((sb >> 9) & 1) << 5); R = (st >> 1) * 16 + swz / 64; C = (st & 1) * 32 + (swz % 64) / 2; }
__host__ __device__ __forceinline__ int perm32(int rho) { const int n = rho >> 4, i = rho & 15; return 8 * (i >> 2) + 4 * n + (i & 3); }

struct Unit { int pm, pn; };
struct Gemm { const bf16_t* A; const bf16_t* Bt; int K; };

struct StaticOrder {
    int nM, nN, nwg, G, c;
    DI void init(int nM_, int nN_, int G_, int c_) { nM = nM_; nN = nN_; nwg = nM * nN; G = G_; c = c_; }
    DI bool next(int i, Unit& u) const {
        const long L = (long)i * G + c; if (L >= nwg) return false;
        int wgid = (int)L; { const int q = nwg / NXCD, r = nwg % NXCD, xcd = wgid % NXCD, off = wgid / NXCD; wgid = (xcd < r ? xcd * (q + 1) : r * (q + 1) + (xcd - r) * q) + off; }
        const int nig = WGM * nN, gid = wgid / nig, fm = gid * WGM, gsz = (nM - fm) < WGM ? (nM - fm) : WGM;
        u.pm = fm + ((wgid % nig) % gsz); u.pn = (wgid % nig) / gsz; return true;
    }
    DI size_t b_off(const Unit& u, size_t tstep) const { return (size_t)u.pn * tstep; }
};
struct MoeOrder : StaticOrder {
    const int* tile_start; size_t expert_stride;
    DI bool next(int i, Unit& u) const { Unit t; const bool ok = StaticOrder::next(i, t); u.pm = __builtin_amdgcn_readfirstlane(t.pm); u.pn = __builtin_amdgcn_readfirstlane(t.pn); return ok; }
    DI size_t b_off(const Unit& u, size_t tstep) const {
        int e = 0;
#pragma unroll
        for (int j = 1; j < 16; ++j) e += (u.pm >= tile_start[j]) ? 1 : 0;
        e = __builtin_amdgcn_readfirstlane(e);
        return (size_t)e * expert_stride + (size_t)u.pn * tstep;
    }
};

typedef int i32x4 __attribute__((ext_vector_type(4)));
DI unsigned q8f(float x) { return (unsigned)(int)__builtin_rintf(x) & 0xffu; }
struct EpiBf16Q {
    static constexpr bool PERM = true, I8 = true, F8 = false;
    bf16_t* O; int ldc; const float* sa; const float* sb;
    DI void operator()(const f32x4 (&acc)[2][2][4][2], const Unit& u, int wr, int wc, int fr, int fq) const {
        const int row0 = u.pm * BM + wr * 64 + fr; const int col0 = u.pn * BM + wc * 32 + 8 * fq;
        f32x4 bv[2][2];
#pragma unroll
        for (int bj = 0; bj < 2; ++bj)
#pragma unroll
            for (int n = 0; n < 2; ++n) bv[bj][n] = *(const f32x4*)(sb + col0 + bj * HALF + 4 * n) * (1.0f / 127.0f);
#pragma unroll
        for (int ai = 0; ai < 2; ++ai)
#pragma unroll
            for (int m = 0; m < 4; ++m) { const int row = row0 + ai * HALF + m * 16; const float ra = sa[row]; bf16_t* rowp = O + (size_t)row * ldc + col0;
#pragma unroll
                for (int bj = 0; bj < 2; ++bj) { const f32x4 v0 = __builtin_convertvector(__builtin_bit_cast(i32x4, acc[ai][bj][m][0]), f32x4) * (bv[bj][0] * ra), v1 = __builtin_convertvector(__builtin_bit_cast(i32x4, acc[ai][bj][m][1]), f32x4) * (bv[bj][1] * ra);
                    u32x4 w; w.x = cvt_pk_bf16(v0[0], v0[1]); w.y = cvt_pk_bf16(v0[2], v0[3]); w.z = cvt_pk_bf16(v1[0], v1[1]); w.w = cvt_pk_bf16(v1[2], v1[3]);
                    *(u32x4*)(rowp + bj * HALF) = w; } }
    }
};
typedef int i32x8 __attribute__((ext_vector_type(8)));
constexpr float ACT_SCALE = 16.0f;
DI float act_scale() { float a = ACT_SCALE; asm volatile("" : "+s"(a)); return a; }
constexpr float HID_SCALE = 8.0f;
DI unsigned pk_fp8x4(float a, float b, float c, float d) {
    float lim = 448.f; asm volatile("" : "+s"(lim));
    a = __builtin_amdgcn_fmed3f(a, -lim, lim); b = __builtin_amdgcn_fmed3f(b, -lim, lim); c = __builtin_amdgcn_fmed3f(c, -lim, lim); d = __builtin_amdgcn_fmed3f(d, -lim, lim);
    int w = __builtin_amdgcn_cvt_pk_fp8_f32(a, b, 0, false); w = __builtin_amdgcn_cvt_pk_fp8_f32(c, d, w, true); return (unsigned)w; }
struct EpiSwiGLUF8 {
    static constexpr bool PERM = true, I8 = false, F8 = true;
    unsigned char* O; int ldc; const float* gus; const int* tile_start;
    DI void operator()(const f32x4 (&acc)[2][2][4][2], const Unit& u, int wr, int wc, int fr, int fq) const {
        int e = 0;
#pragma unroll
        for (int j = 1; j < 16; ++j) e += (u.pm >= tile_start[j]) ? 1 : 0;
        const float mg = gus[2 * e], mu = gus[2 * e + 1];
        const int row0 = u.pm * BM + wr * 64 + fr; const int col0 = u.pn * HALF + wc * 32 + 8 * fq;
#pragma unroll
        for (int ai = 0; ai < 2; ++ai)
#pragma unroll
            for (int m = 0; m < 4; ++m) { unsigned char* rowp = O + (size_t)(row0 + ai * HALF + m * 16) * ldc + col0;
                float o[8];
#pragma unroll
                for (int n = 0; n < 2; ++n)
#pragma unroll
                    for (int j = 0; j < 4; ++j) { const float g = acc[ai][0][m][n][j] * mg; o[n * 4 + j] = g * __builtin_amdgcn_rcpf(1.0f + __expf(-g)) * (acc[ai][1][m][n][j] * mu); }
                u32x2 w; w.x = pk_fp8x4(o[0], o[1], o[2], o[3]); w.y = pk_fp8x4(o[4], o[5], o[6], o[7]);
                *(u32x2*)rowp = w; }
    }
};
struct EpiSwiGLUQ {
    static constexpr bool PERM = true, I8 = true, F8 = false;
    unsigned char* O; int ldc; const float* sa; const float* sb; const int* rowmap; const int* tile_start;
    DI void operator()(const f32x4 (&acc)[2][2][4][2], const Unit& u, int wr, int wc, int fr, int fq) const {
        int e = 0;
#pragma unroll
        for (int j = 1; j < 16; ++j) e += (u.pm >= tile_start[j]) ? 1 : 0;
        const int row0 = u.pm * BM + wr * 64 + fr; const int col0 = u.pn * HALF + wc * 32 + 8 * fq, bcol0 = e * 2048 + u.pn * BM + wc * 32 + 8 * fq;
        f32x4 bv[2][2];
#pragma unroll
        for (int bj = 0; bj < 2; ++bj)
#pragma unroll
            for (int n = 0; n < 2; ++n) bv[bj][n] = *(const f32x4*)(sb + bcol0 + bj * HALF + 4 * n) * (1.0f / 127.0f);
#pragma unroll
        for (int ai = 0; ai < 2; ++ai)
#pragma unroll
            for (int m = 0; m < 4; ++m) { const int row = row0 + ai * HALF + m * 16; const float ra = sa[rowmap[row]]; unsigned char* rowp = O + (size_t)row * ldc + col0;
                float o[8];
#pragma unroll
                for (int n = 0; n < 2; ++n) { const f32x4 gv = __builtin_convertvector(__builtin_bit_cast(i32x4, acc[ai][0][m][n]), f32x4) * (bv[0][n] * ra), uv = __builtin_convertvector(__builtin_bit_cast(i32x4, acc[ai][1][m][n]), f32x4) * (bv[1][n] * ra);
#pragma unroll
                    for (int j = 0; j < 4; ++j) { const float g = gv[j]; o[n * 4 + j] = g * __builtin_amdgcn_rcpf(1.0f + __expf(-g)) * (uv[j] * HID_SCALE); } }
                u32x2 w; w.x = pk_fp8x4(o[0], o[1], o[2], o[3]); w.y = pk_fp8x4(o[4], o[5], o[6], o[7]);
                *(u32x2*)rowp = w; }
    }
};
template <bool QIN, bool F8IN = false> struct EpiI8Tile {
    static constexpr bool PERM = true, I8 = QIN, F8 = F8IN;
    unsigned char* O8; int ldc; float* SC; int ntile; const float* sa; const float* sb; LAS float* xch; const float* wds; const int* tile_start;
    DI void operator()(const f32x4 (&acc)[2][2][4][2], const Unit& u, int wr, int wc, int fr, int fq) const {
        const int row0 = u.pm * BM + wr * 64 + fr; const int col0 = u.pn * BM + wc * 32 + 8 * fq;
        float mul = 1.0f / 127.0f;
        if constexpr (F8IN) { int e = 0;
#pragma unroll
            for (int j = 1; j < 16; ++j) e += (u.pm >= tile_start[j]) ? 1 : 0;
            mul *= wds[e]; }
        f32x4 bv[2][2];
        if constexpr (QIN) {
#pragma unroll
            for (int bj = 0; bj < 2; ++bj)
#pragma unroll
                for (int n = 0; n < 2; ++n) bv[bj][n] = *(const f32x4*)(sb + col0 + bj * HALF + 4 * n) * (1.0f / 127.0f); }
        f32x4 v[2][4][2][2]; float lmax[2][4];
#pragma unroll
        for (int ai = 0; ai < 2; ++ai)
#pragma unroll
            for (int m = 0; m < 4; ++m) { float ra = 1.f; if constexpr (QIN) ra = sa[row0 + ai * HALF + m * 16]; float mx = 0.f;
#pragma unroll
                for (int bj = 0; bj < 2; ++bj)
#pragma unroll
                    for (int n = 0; n < 2; ++n) { f32x4 x; if constexpr (QIN) x = __builtin_convertvector(__builtin_bit_cast(i32x4, acc[ai][bj][m][n]), f32x4) * (bv[bj][n] * ra); else x = acc[ai][bj][m][n];
                        v[ai][m][bj][n] = x; mx = fmaxf(mx, fmaxf(fmaxf(fabsf(x[0]), fabsf(x[1])), fmaxf(fabsf(x[2]), fabsf(x[3])))); }
                mx = fmaxf(mx, sx<16>(mx)); mx = max32(mx);
                lmax[ai][m] = mx;
                if (fq == 0) xch[(ai * HALF + wr * 64 + m * 16 + fr) * 4 + wc] = mx; }
        asm volatile("s_waitcnt lgkmcnt(0)\n\ts_barrier" ::: "memory");
#pragma unroll
        for (int ai = 0; ai < 2; ++ai)
#pragma unroll
            for (int m = 0; m < 4; ++m) { const int rl = ai * HALF + wr * 64 + m * 16 + fr; const f32x4 q4 = *(const LAS f32x4*)(xch + rl * 4);
                const float rmax = fmaxf(fmaxf(q4[0], q4[1]), fmaxf(q4[2], q4[3])); const float inv = rmax > 0.f ? 127.0f * __builtin_amdgcn_rcpf(rmax) : 0.f;
                const int row = row0 + ai * HALF + m * 16;
                if (wc == 0 && fq == 0) SC[(size_t)row * ntile + u.pn] = rmax * mul;
                unsigned char* rowp = O8 + (size_t)row * ldc + col0;
#pragma unroll
                for (int bj = 0; bj < 2; ++bj) { const f32x4 x0 = v[ai][m][bj][0] * inv, x1 = v[ai][m][bj][1] * inv;
                    u32x2 w2; w2.x = q8f(x0[0]) | (q8f(x0[1]) << 8) | (q8f(x0[2]) << 16) | (q8f(x0[3]) << 24); w2.y = q8f(x1[0]) | (q8f(x1[1]) << 8) | (q8f(x1[2]) << 16) | (q8f(x1[3]) << 24);
                    *(u32x2*)(rowp + bj * HALF) = w2; } }
    }
};
constexpr float YS_SCALE = 64.0f;
struct EpiF8Out {
    static constexpr bool PERM = true, I8 = false, F8 = true;
    unsigned char* O8; int ldc; const float* wds; const int* tile_start;
    DI void operator()(const f32x4 (&acc)[2][2][4][2], const Unit& u, int wr, int wc, int fr, int fq) const {
        int e = 0;
#pragma unroll
        for (int j = 1; j < 16; ++j) e += (u.pm >= tile_start[j]) ? 1 : 0;
        const float mul = wds[e] * YS_SCALE;
        const int row0 = u.pm * BM + wr * 64 + fr; const int col0 = u.pn * BM + wc * 32 + 8 * fq;
#pragma unroll
        for (int ai = 0; ai < 2; ++ai)
#pragma unroll
            for (int m = 0; m < 4; ++m) { unsigned char* rowp = O8 + (size_t)(row0 + ai * HALF + m * 16) * ldc + col0;
#pragma unroll
                for (int bj = 0; bj < 2; ++bj) { const f32x4 x0 = acc[ai][bj][m][0] * mul, x1 = acc[ai][bj][m][1] * mul;
                    u32x2 w2; w2.x = pk_fp8x4(x0[0], x0[1], x0[2], x0[3]); w2.y = pk_fp8x4(x1[0], x1[1], x1[2], x1[3]);
                    *(u32x2*)(rowp + bj * HALF) = w2; } }
    }
};
struct EpiBf16F8 {
    static constexpr bool PERM = true, I8 = false, F8 = true;
    bf16_t* O; int ldc; const float* mulp;
    DI void operator()(const f32x4 (&acc)[2][2][4][2], const Unit& u, int wr, int wc, int fr, int fq) const {
        const int row0 = u.pm * BM + wr * 64 + fr; const int col0 = u.pn * BM + wc * 32 + 8 * fq; const float mul = mulp[0];
#pragma unroll
        for (int ai = 0; ai < 2; ++ai)
#pragma unroll
            for (int m = 0; m < 4; ++m) { bf16_t* rowp = O + (size_t)(row0 + ai * HALF + m * 16) * ldc + col0;
#pragma unroll
                for (int bj = 0; bj < 2; ++bj) { const f32x4 v0 = acc[ai][bj][m][0] * mul, v1 = acc[ai][bj][m][1] * mul;
                    u32x4 w; w.x = cvt_pk_bf16(v0[0], v0[1]); w.y = cvt_pk_bf16(v0[2], v0[3]); w.z = cvt_pk_bf16(v1[0], v1[1]); w.w = cvt_pk_bf16(v1[2], v1[3]);
                    *(u32x4*)(rowp + bj * HALF) = w; } }
    }
};
struct EpiBf16 {
    static constexpr bool PERM = true, I8 = false, F8 = false;
    bf16_t* O; int ldc;
    DI void operator()(const f32x4 (&acc)[2][2][4][2], const Unit& u, int wr, int wc, int fr, int fq) const {
        const int row0 = u.pm * BM + wr * 64 + fr; const int col0 = u.pn * BM + wc * 32 + 8 * fq;
#pragma unroll
        for (int ai = 0; ai < 2; ++ai)
#pragma unroll
            for (int m = 0; m < 4; ++m) { bf16_t* rowp = O + (size_t)(row0 + ai * HALF + m * 16) * ldc + col0;
#pragma unroll
                for (int bj = 0; bj < 2; ++bj) { const f32x4 v0 = acc[ai][bj][m][0], v1 = acc[ai][bj][m][1];
                    u32x4 w; w.x = cvt_pk_bf16(v0[0], v0[1]); w.y = cvt_pk_bf16(v0[2], v0[3]); w.z = cvt_pk_bf16(v1[0], v1[1]); w.w = cvt_pk_bf16(v1[2], v1[3]);
                    *(u32x4*)(rowp + bj * HALF) = w; } }
    }
};
struct EpiSwiGLU {
    static constexpr bool PERM = true, I8 = false, F8 = false;
    bf16_t* O; int ldc;
    DI void operator()(const f32x4 (&acc)[2][2][4][2], const Unit& u, int wr, int wc, int fr, int fq) const {
        const int row0 = u.pm * BM + wr * 64 + fr; const int col0 = u.pn * HALF + wc * 32 + 8 * fq;
#pragma unroll
        for (int ai = 0; ai < 2; ++ai)
#pragma unroll
            for (int m = 0; m < 4; ++m) { bf16_t* rowp = O + (size_t)(row0 + ai * HALF + m * 16) * ldc + col0;
                float o[8];
#pragma unroll
                for (int n = 0; n < 2; ++n)
#pragma unroll
                    for (int j = 0; j < 4; ++j) { const float g = acc[ai][0][m][n][j], up = acc[ai][1][m][n][j]; o[n * 4 + j] = g * __builtin_amdgcn_rcpf(1.0f + __expf(-g)) * up; }
                u32x4 w; w.x = cvt_pk_bf16(o[0], o[1]); w.y = cvt_pk_bf16(o[2], o[3]); w.z = cvt_pk_bf16(o[4], o[5]); w.w = cvt_pk_bf16(o[6], o[7]);
                *(u32x4*)rowp = w; }
    }
};

template <class Epi, class Sched, bool GATHER>
DI void gemm_phase(LAS unsigned char* lds, const int tid, const Gemm g, const Sched& S, const Epi& E, const int* rowmap) {
    const int wid = __builtin_amdgcn_readfirstlane(tid >> 6), lane = tid & 63, wr = wid >> 2, wc = wid & 3, fr = lane & 15, fq = lane >> 4;
    const int K = g.K, nt = K / BK;
    unsigned voffA[2], voffB[2];
#pragma unroll
    for (int i = 0; i < 2; ++i) { int R, C; stage_rc(tid * 16 + i * 8192, R, C); const int Rb = Epi::PERM ? ((R & ~31) + perm32(R & 31)) : R;
        voffA[i] = (unsigned)(R * K + C) * 2u; voffB[i] = (unsigned)(Rb * K + C) * 2u; }
    const size_t kstep = (size_t)(BK * 2);
    const size_t hstep = (size_t)HALF * K * 2;
    const size_t tstep = 2 * hstep;
    const unsigned ldsw = (unsigned)wid * 1024u;
    const int aoff = lds_byte(wr * 64 + fr, fq * 8), boff = lds_byte(wc * 32 + fr, fq * 8);
#define PG8_SA(b, h) (((b) * 2 + (h)) * HTB)
#define PG8_SB(b, h) ((4 + (b) * 2 + (h)) * HTB)
#define PG8_STAGE(bufoff, gbase, voff) do { _Pragma("unroll") for (int _i = 0; _i < 2; ++_i) { unsigned vo_ = (voff)[_i]; asm volatile("" : "+v"(vo_)); \
        __builtin_amdgcn_global_load_lds((const unsigned*)((const char*)(gbase) + vo_), (LAS unsigned*)(lds + (bufoff) + ldsw + _i * 8192), 16, 0, 0); } } while (0)
#define PG8_LDA(dst, b, h) do { _Pragma("unroll") for (int m = 0; m < 4; ++m) { if constexpr (Epi::F8) { const i32x4 lo_ = *(const LAS i32x4*)(lds + PG8_SA(b, h) + aoff + m * 2048), hi_ = *(const LAS i32x4*)(lds + PG8_SA(b, h) + aoff + m * 2048 + 1024); \
            dst##8[m] = __builtin_shufflevector(lo_, hi_, 0, 1, 2, 3, 4, 5, 6, 7); } else { _Pragma("unroll") for (int k = 0; k < 2; ++k) dst[m][k] = *(const LAS bf16x8*)(lds + PG8_SA(b, h) + aoff + m * 2048 + k * 1024); } } } while (0)
#define PG8_LDB(dst, b, h) do { _Pragma("unroll") for (int n = 0; n < 2; ++n) { if constexpr (Epi::F8) { const i32x4 lo_ = *(const LAS i32x4*)(lds + PG8_SB(b, h) + boff + n * 2048), hi_ = *(const LAS i32x4*)(lds + PG8_SB(b, h) + boff + n * 2048 + 1024); \
            dst##8[n] = __builtin_shufflevector(lo_, hi_, 0, 1, 2, 3, 4, 5, 6, 7); } else { _Pragma("unroll") for (int k = 0; k < 2; ++k) dst[n][k] = *(const LAS bf16x8*)(lds + PG8_SB(b, h) + boff + n * 2048 + k * 1024); } } } while (0)
#define PG8_MMA(ai, bj, At, Bt) do { __builtin_amdgcn_s_setprio(1); _Pragma("unroll") for (int m = 0; m < 4; ++m) _Pragma("unroll") for (int n = 0; n < 2; ++n) _Pragma("unroll") for (int k = 0; k < 2; ++k) { \
        if constexpr (Epi::F8) { if (k == 0) acc[ai][bj][m][n] = __builtin_amdgcn_mfma_scale_f32_16x16x128_f8f6f4(Bt##8[n], At##8[m], acc[ai][bj][m][n], 0, 0, 0, 0, 0, 0); } \
        else if constexpr (Epi::I8) acc[ai][bj][m][n] = __builtin_bit_cast(f32x4, __builtin_amdgcn_mfma_i32_16x16x64_i8(__builtin_bit_cast(i32x4, Bt[n][k]), __builtin_bit_cast(i32x4, At[m][k]), __builtin_bit_cast(i32x4, acc[ai][bj][m][n]), 0, 0, 0)); \
        else acc[ai][bj][m][n] = __builtin_amdgcn_mfma_f32_16x16x32_bf16(Bt[n][k], At[m][k], acc[ai][bj][m][n], 0, 0, 0); } __builtin_amdgcn_s_setprio(0); } while (0)
#define PG8_WAIT_V(n) asm volatile("s_waitcnt vmcnt(" #n ")" ::: "memory")
#define PG8_WAIT_L(n) asm volatile("s_waitcnt lgkmcnt(" #n ")" ::: "memory")
#define PG8_BAR __builtin_amdgcn_s_barrier()
#define PG8_SCHED __builtin_amdgcn_sched_barrier(0)
    Unit cur, nxt; int ui = 0;
    if (!S.next(0, cur)) return;
    f32x4 acc[2][2][4][2];
#pragma unroll
    for (int a = 0; a < 2; ++a)
#pragma unroll
        for (int b = 0; b < 2; ++b)
#pragma unroll
            for (int m = 0; m < 4; ++m)
#pragma unroll
                for (int n = 0; n < 2; ++n) acc[a][b][m][n] = (f32x4){0.f, 0.f, 0.f, 0.f};
    bf16x8 At[4][2], B0[2][2], B1[2][2];
    i32x8 At8[4], B08[2], B18[2];
    unsigned cvA[2][2];
    const char* cA = (const char*)g.A + (GATHER ? (size_t)0 : (size_t)cur.pm * tstep);
#define PG8_LOAD_ROWS(unit) do { _Pragma("unroll") for (int h = 0; h < 2; ++h) _Pragma("unroll") for (int i = 0; i < 2; ++i) { int R, C; stage_rc(tid * 16 + i * 8192, R, C); \
        cvA[h][i] = (unsigned)(rowmap[(unit).pm * BM + h * HALF + R] * K + C) * 2u; } } while (0)
    if constexpr (GATHER) { PG8_LOAD_ROWS(cur); }
    const char* cB = (const char*)g.Bt + S.b_off(cur, tstep);
#define PG8_STAGE_A(bufoff, base_direct, koff_gather, h, usenext) do { if constexpr (GATHER) { PG8_STAGE(bufoff, (const char*)g.A + (koff_gather), cvA[h]); } \
        else { PG8_STAGE(bufoff, (base_direct), voffA); } } while (0)
    PG8_STAGE(PG8_SB(0, 0), cB, voffB); PG8_STAGE(PG8_SB(0, 1), cB + hstep, voffB); PG8_STAGE_A(PG8_SA(0, 0), cA, 0, 0, false); PG8_STAGE_A(PG8_SA(0, 1), cA + hstep, 0, 1, false);
    if (wr == 1) PG8_BAR;
    PG8_WAIT_V(2); PG8_BAR;
    PG8_STAGE(PG8_SB(1, 0), cB + kstep, voffB); PG8_STAGE_A(PG8_SA(1, 0), cA + kstep, kstep, 0, false); PG8_STAGE(PG8_SB(1, 1), cB + hstep + kstep, voffB);
    PG8_WAIT_V(6); PG8_BAR;
    for (;;) {
        const bool has_next = S.next(ui + 1, nxt);
        const char* nA = has_next ? (const char*)g.A + (GATHER ? (size_t)0 : (size_t)nxt.pm * tstep) : cA; const char* nB = has_next ? (const char*)g.Bt + S.b_off(nxt, tstep) : cB;
        for (int t = 0; t < nt; t += 2) {
            const bool last = (t == nt - 2);
            const char* a1 = cA + (size_t)(t + 1) * kstep;
            const char* a2 = last ? nA : cA + (size_t)(t + 2) * kstep; const char* b2 = last ? nB : cB + (size_t)(t + 2) * kstep;
            const char* a3 = a2 + kstep; const char* b3 = b2 + kstep;
            const size_t k1 = (size_t)(t + 1) * kstep, k2 = last ? (size_t)0 : (size_t)(t + 2) * kstep, k3 = k2 + kstep;
            PG8_LDB(B0, 0, 0); PG8_LDB(B1, 0, 1); PG8_SCHED; PG8_LDA(At, 0, 0); PG8_STAGE_A(PG8_SA(1, 1), a1 + hstep, k1, 1, false);
            if constexpr (GATHER) { if (last && has_next) { PG8_LOAD_ROWS(nxt); } }
            PG8_WAIT_V(8); PG8_WAIT_L(0); PG8_BAR; PG8_MMA(0, 0, At, B0); PG8_MMA(0, 1, At, B1); PG8_BAR; PG8_SCHED;
            PG8_LDA(At, 0, 1); PG8_STAGE(PG8_SB(0, 0), b2, voffB); PG8_STAGE(PG8_SB(0, 1), b2 + hstep, voffB); PG8_STAGE_A(PG8_SA(0, 0), a2, k2, 0, last);
            PG8_WAIT_V(8); PG8_WAIT_L(0); PG8_BAR; PG8_MMA(1, 0, At, B0); PG8_MMA(1, 1, At, B1); PG8_BAR; PG8_SCHED;
            PG8_LDB(B0, 1, 0); PG8_LDB(B1, 1, 1); PG8_SCHED; PG8_LDA(At, 1, 0); PG8_STAGE_A(PG8_SA(0, 1), a2 + hstep, k2, 1, last);
            PG8_WAIT_V(8); PG8_WAIT_L(0); PG8_BAR; PG8_MMA(0, 0, At, B0); PG8_MMA(0, 1, At, B1); PG8_BAR; PG8_SCHED;
            PG8_LDA(At, 1, 1); PG8_STAGE(PG8_SB(1, 0), b3, voffB); PG8_STAGE(PG8_SB(1, 1), b3 + hstep, voffB); PG8_STAGE_A(PG8_SA(1, 0), a3, k3, 0, last);
            PG8_WAIT_V(8); PG8_WAIT_L(0); PG8_BAR; PG8_MMA(1, 0, At, B0); PG8_MMA(1, 1, At, B1); PG8_BAR; PG8_SCHED;
        }
        if (wr == 0) PG8_BAR;
        { const int ln_ = lane_fresh(); int fr_ = ln_ & 15, fq_ = ln_ >> 4; asm volatile("" : "+v"(fr_), "+v"(fq_));
          E(acc, cur, wr, wc, fr_, fq_); }
        if (!has_next) break;
#pragma unroll
        for (int a = 0; a < 2; ++a)
#pragma unroll
            for (int b = 0; b < 2; ++b)
#pragma unroll
                for (int m = 0; m < 4; ++m)
#pragma unroll
                    for (int n = 0; n < 2; ++n) acc[a][b][m][n] = (f32x4){0.f, 0.f, 0.f, 0.f};
        cur = nxt; cA = nA; cB = nB; ++ui;
        if (wr == 1) PG8_BAR;
    }
    PG8_WAIT_V(0);
    PG8_BAR;
#undef PG8_SA
#undef PG8_SB
#undef PG8_STAGE
#undef PG8_STAGE_A
#undef PG8_LOAD_ROWS
#undef PG8_LDA
#undef PG8_LDB
#undef PG8_MMA
#undef PG8_WAIT_V
#undef PG8_WAIT_L
#undef PG8_BAR
#undef PG8_SCHED
}
}

#define XB_TMO      128
#define XB_XCNT(j)  (256  + 64 * (j))
#define XB_XSUB(j)  (1280 + 64 * (j))
#define XB_XGEN(j)  (2304 + 64 * (j))
#define XB_TOP      3328
#define XB_TOPGEN   3392
#define XCD_BAR_WORDS 3456
#define XB_SPIN_CAP (1u << 18)
__device__ __forceinline__ unsigned xb_ld(unsigned* p)              { return __hip_atomic_load(p, __ATOMIC_RELAXED, __HIP_MEMORY_SCOPE_AGENT); }
__device__ __forceinline__ unsigned xb_add(unsigned* p, unsigned v) { return __hip_atomic_fetch_add(p, v, __ATOMIC_RELAXED, __HIP_MEMORY_SCOPE_AGENT); }
__device__ __forceinline__ unsigned xb_xcc_id() { return (unsigned)__builtin_amdgcn_s_getreg((3 << 11) | 20) & 0xFu; }
#define XB_SPIN(cond, bar) do { unsigned _sp = 0; while (cond) { __builtin_amdgcn_s_sleep(1); \
    if ((++_sp & 255u) == 0u) { if (xb_ld(&(bar)[XB_TMO])) break; if (_sp > XB_SPIN_CAP) { atomicAdd(&(bar)[XB_TMO], 1u); break; } } } } while (0)
struct XcdBarrier { unsigned* bar; unsigned x; volatile LAS unsigned* st; };
__device__ __forceinline__ XcdBarrier xcd_barrier_post(unsigned* bar, volatile LAS unsigned* st) {
    XcdBarrier b; b.bar = bar; b.x = xb_xcc_id(); b.st = st;
    if (threadIdx.x == 0) (void)xb_add(&bar[XB_XCNT(b.x)], 1u);
    return b;
}
__device__ __forceinline__ void xcd_barrier_complete(unsigned* bar, unsigned x, unsigned& nloc, unsigned& nx) {
    const unsigned G = gridDim.x * gridDim.y * gridDim.z;
    unsigned sum, cnt, mine, sp = 0u;
    for (;;) {
        sum = 0u; cnt = 0u; mine = 0u;
#pragma unroll
        for (unsigned j = 0; j < 16; ++j) { const unsigned c = xb_ld(&bar[XB_XCNT(j)]); sum += c; cnt += (c > 0u) ? 1u : 0u; mine = (j == x) ? c : mine; }
        if (sum == G) break;
        __builtin_amdgcn_s_sleep(1);
        if ((++sp & 255u) == 0u) { if (xb_ld(&bar[XB_TMO])) break; if (sp > XB_SPIN_CAP) { atomicAdd(&bar[XB_TMO], 1u); break; } }
    }
    nloc = mine > 0u ? mine : 1u; nx = cnt > 0u ? cnt : 1u;
}
__device__ __forceinline__ void xcd_barrier(const XcdBarrier& b, const bool t0) {
    asm volatile("s_waitcnt vmcnt(0)" ::: "memory");
    __syncthreads();
    if (t0) {
        unsigned* bar = b.bar;
        __builtin_amdgcn_s_waitcnt(0);
        unsigned nloc = b.st[0], nx = b.st[1];
        if (nloc == 0u) { xcd_barrier_complete(bar, b.x, nloc, nx); b.st[0] = nloc; b.st[1] = nx; }
        const unsigned old = xb_add(&bar[XB_XSUB(b.x)], 1u);
        const unsigned gen = old / nloc;
        if (old + 1u == (gen + 1u) * nloc) {
            __builtin_amdgcn_fence(__ATOMIC_RELEASE, "agent");
            asm volatile("s_waitcnt vmcnt(0)" ::: "memory");
            const unsigned og = xb_add(&bar[XB_TOP], 1u);
            const unsigned tg = og / nx;
            if (og + 1u == (tg + 1u) * nx) xb_add(&bar[XB_TOPGEN], 1u);
            else XB_SPIN(xb_ld(&bar[XB_TOPGEN]) == tg, bar);
            __builtin_amdgcn_fence(__ATOMIC_ACQUIRE, "agent");
            xb_add(&bar[XB_XGEN(b.x)], 1u);
            asm volatile("s_waitcnt vmcnt(0)" ::: "memory");
        } else {
            XB_SPIN(xb_ld(&bar[XB_XGEN(b.x)]) == gen, bar);
            __builtin_amdgcn_fence(__ATOMIC_ACQUIRE, "agent");
            asm volatile("s_waitcnt vmcnt(0)" ::: "memory");
        }
    }
    __syncthreads();
}

struct Args { const float* in[20]; float* out; unsigned char* ws; int ph_lo, ph_hi; };
typedef __attribute__((address_space(4))) const unsigned char* kptr_t;
struct Frame {
    LAS unsigned char* lds;
    int tid, lane, wave, vcu, G, bx;
    int wave0;
    kptr_t ka;
};
DI void frame_refresh(Frame& F) {
    int wv = F.wave0; asm volatile("" : "+s"(wv)); int ln = lane_fresh(); asm volatile("" : "+v"(ln));
    F.lane = ln; F.wave = wv; F.tid = wv * 64 + ln;
    int g = gridDim.x; asm volatile("" : "+s"(g)); F.G = g; int bx = blockIdx.x; asm volatile("" : "+s"(bx)); F.bx = bx;
    F.vcu = (g % 8 == 0) ? (bx % 8) * (g / 8) + bx / 8 : bx;
    kptr_t p = (kptr_t)__builtin_amdgcn_kernarg_segment_ptr(); asm volatile("" : "+s"(p)); F.ka = p;
}
DI kptr_t karg_fresh() { kptr_t p = (kptr_t)__builtin_amdgcn_kernarg_segment_ptr(); asm volatile("" : "+s"(p)); return p; }
DI const float* fin(const Frame& F, int i) { return (const float*)(*(const GAS float* const __attribute__((address_space(4)))*)(F.ka + 8 * i)); }
DI unsigned char* fout(const Frame& F) { return (unsigned char*)(*(GAS unsigned char* const __attribute__((address_space(4)))*)(F.ka + 160)); }
DI unsigned char* fws(const Frame& F) { return (unsigned char*)(*(GAS unsigned char* const __attribute__((address_space(4)))*)(F.ka + 168)); }

typedef short v4i16_t __attribute__((ext_vector_type(4)));
DI s16x4 lds_tr(const LAS bf16* p) { return __builtin_bit_cast(s16x4, __builtin_amdgcn_ds_read_tr16_b64_v4i16((LAS v4i16_t*)p)); }
DI bf16x8 tr_frag(const LAS bf16* img, int stride, int row_lo, int row_hi, int colbase, int lane) {
    const int q = (lane & 15) >> 2, p = lane & 3, blk = (lane >> 4) & 1;
    const s16x4 lo = lds_tr(img + (row_lo + q) * stride + colbase + 16 * blk + 4 * p);
    const s16x4 hi = lds_tr(img + (row_hi + q) * stride + colbase + 16 * blk + 4 * p);
    return (bf16x8){lo[0], lo[1], lo[2], lo[3], hi[0], hi[1], hi[2], hi[3]};
}
DI void transpose_item(const float* W, int N, int K, int k0, int n0, bf16* WT, int dst_row0, LAS bf16* img, int lane) {
    const int kk = lane >> 4, n4 = (lane & 15) * 4;
    f32x4 v[16];
#pragma unroll
    for (int i = 0; i < 16; ++i) v[i] = __builtin_nontemporal_load((const f32x4*)(W + (size_t)(k0 + 4 * i + kk) * N + n0 + n4));
#pragma unroll
    for (int i = 0; i < 16; ++i) { u32x2 w2; w2.x = cvt_pk_bf16(v[i].x, v[i].y); w2.y = cvt_pk_bf16(v[i].z, v[i].w); *(LAS u32x2*)(img + (4 * i + kk) * 72 + n4) = w2; }
    LDS_WAIT(); asm volatile("" ::: "memory");
    const int r = lane & 31, h = lane >> 5;
#pragma unroll
    for (int cb = 0; cb < 2; ++cb)
#pragma unroll
        for (int kb = 0; kb < 4; ++kb) { const bf16x8 f = tr_frag(img, 72, 16 * kb + 8 * h, 16 * kb + 8 * h + 4, 32 * cb, lane);
            *(bf16x8*)(WT + (size_t)(dst_row0 + 32 * cb + r) * K + k0 + 16 * kb + 8 * h) = f; }
    LDS_WAIT(); asm volatile("" ::: "memory");
}
DI void wabs_item(const float* W, int N, int k0, int n0, unsigned* dst, int lane) {
    const float* p = W + (size_t)k0 * N + n0 + lane * 4;
    f32x4 m = (f32x4){0.f, 0.f, 0.f, 0.f};
#pragma unroll 8
    for (int k = 0; k < 128; ++k) { const f32x4 v = __builtin_nontemporal_load((const f32x4*)(p + (size_t)k * N)); m.x = fmaxf(m.x, fabsf(v.x)); m.y = fmaxf(m.y, fabsf(v.y)); m.z = fmaxf(m.z, fabsf(v.z)); m.w = fmaxf(m.w, fabsf(v.w)); }
    unsigned* d = dst + lane * 4;
    __hip_atomic_fetch_max(d + 0, __float_as_uint(m.x), __ATOMIC_RELAXED, __HIP_MEMORY_SCOPE_AGENT); __hip_atomic_fetch_max(d + 1, __float_as_uint(m.y), __ATOMIC_RELAXED, __HIP_MEMORY_SCOPE_AGENT);
    __hip_atomic_fetch_max(d + 2, __float_as_uint(m.z), __ATOMIC_RELAXED, __HIP_MEMORY_SCOPE_AGENT); __hip_atomic_fetch_max(d + 3, __float_as_uint(m.w), __ATOMIC_RELAXED, __HIP_MEMORY_SCOPE_AGENT);
}
constexpr int WABS_I_IN = 0 * (NPROJ / 256) * 16,
               WABS_I_OUT = (DM / 256) * 16, WABS_I_G1 = (DEXP / 256) * 16, WABS_I_GU = NEXP * 2 * WABS_I_G1, WABS_PER_L = WABS_I_IN + WABS_I_OUT;
DI void wabs_layer_item(Frame& F, int l, int r) {
    unsigned* A = (unsigned*)(fws(F) + WS_CTL + CTL_ABS) + (size_t)l * ABS_PER_LAYER;
    if (r < WABS_I_IN) { const int nb = r >> 4, kr = r & 15; wabs_item(fin(F, 3) + (size_t)l * DM * NPROJ, NPROJ, 128 * kr, 256 * nb, A + ABS_IN + 256 * nb, F.lane); return; } r -= WABS_I_IN;
    if (r < WABS_I_OUT) { const int nb = r >> 4, kr = r & 15; wabs_item(fin(F, 10) + (size_t)l * DM * DM, DM, 128 * kr, 256 * nb, A + ABS_OUT + 256 * nb, F.lane); return; } r -= WABS_I_OUT;
    { const int e = r / (2 * WABS_I_G1), r2 = r % (2 * WABS_I_G1), isup = r2 / WABS_I_G1, r3 = r2 % WABS_I_G1, nb = r3 >> 4, kr = r3 & 15;
      const float* W = (isup ? fin(F, 16) : fin(F, 15)) + ((size_t)l * NEXP + e) * DM * DEXP;
      const int n0 = 256 * nb; unsigned* dst = A + ABS_GU + e * 2048;
      const float* p = W + (size_t)(128 * kr) * DEXP + n0 + F.lane * 4;
      f32x4 m = (f32x4){0.f, 0.f, 0.f, 0.f};
#pragma unroll 8
      for (int k = 0; k < 128; ++k) { const f32x4 v = __builtin_nontemporal_load((const f32x4*)(p + (size_t)k * DEXP)); m.x = fmaxf(m.x, fabsf(v.x)); m.y = fmaxf(m.y, fabsf(v.y)); m.z = fmaxf(m.z, fabsf(v.z)); m.w = fmaxf(m.w, fabsf(v.w)); }
      const int n = n0 + F.lane * 4; unsigned* d = dst + 256 * (n >> 7) + 128 * isup + (n & 127);
      __hip_atomic_fetch_max(d + 0, __float_as_uint(m.x), __ATOMIC_RELAXED, __HIP_MEMORY_SCOPE_AGENT); __hip_atomic_fetch_max(d + 1, __float_as_uint(m.y), __ATOMIC_RELAXED, __HIP_MEMORY_SCOPE_AGENT);
      __hip_atomic_fetch_max(d + 2, __float_as_uint(m.z), __ATOMIC_RELAXED, __HIP_MEMORY_SCOPE_AGENT); __hip_atomic_fetch_max(d + 3, __float_as_uint(m.w), __ATOMIC_RELAXED, __HIP_MEMORY_SCOPE_AGENT); }
}
DI void wabs_phase(Frame& F, int l) {
    const int gw = F.vcu * 8 + F.wave, NGW = F.G * 8;
    for (int it = gw; it < WABS_PER_L; it += NGW) wabs_layer_item(F, l, it);
}
constexpr int WABS_T1 = WABS_PER_L < 1024 ? WABS_PER_L : 1024;
DI int wabs_t2(int G, int nunits) { const int nfull = nunits % G, nidle = nfull ? G - nfull : G; const int t2 = WABS_T1 + nidle * 8; return t2 < WABS_PER_L ? t2 : WABS_PER_L; }
DI void wabs_tail(Frame& F, int nunits, int lo, int hi) {
    const int nfull = nunits % F.G; const int nidle = nfull ? F.G - nfull : F.G; const int fi = nfull ? F.bx - nfull : F.bx;
    if (fi < 0) return;
    for (int it = lo + fi * 8 + F.wave; it < hi; it += nidle * 8) wabs_layer_item(F, 1, it);
}
DI unsigned q8(float x) { return (unsigned)(int)__builtin_rintf(x) & 0xffu; }
DI void transpose_item_q(const float* W, int N, int K8, int k0, int n0, unsigned char* WT8, int dst_row0, const float* amax, LAS bf16* img, int lane) {
    const int kk2 = lane >> 4, n4 = (lane & 15) * 4;
    const f32x4 am = *(const f32x4*)(amax + dst_row0 + n4);
    const f32x4 inv = (f32x4){am.x > 0.f ? 127.0f / am.x : 0.f, am.y > 0.f ? 127.0f / am.y : 0.f, am.z > 0.f ? 127.0f / am.z : 0.f, am.w > 0.f ? 127.0f / am.w : 0.f};
    f32x4 va[8], vb[8];
#pragma unroll
    for (int i = 0; i < 8; ++i) { const float* p = W + (size_t)(k0 + 8 * i + 2 * kk2) * N + n0 + n4; va[i] = __builtin_nontemporal_load((const f32x4*)p); vb[i] = __builtin_nontemporal_load((const f32x4*)(p + N)); }
#pragma unroll
    for (int i = 0; i < 8; ++i) { const f32x4 a = va[i] * inv, b2 = vb[i] * inv;
        const unsigned e0 = q8(a.x) | (q8(b2.x) << 8), e1 = q8(a.y) | (q8(b2.y) << 8), e2 = q8(a.z) | (q8(b2.z) << 8), e3 = q8(a.w) | (q8(b2.w) << 8);
        u32x2 w2; w2.x = e0 | (e1 << 16); w2.y = e2 | (e3 << 16); *(LAS u32x2*)(img + (4 * i + kk2) * 72 + n4) = w2; }
    LDS_WAIT(); asm volatile("" ::: "memory");
    const int r = lane & 31, h = lane >> 5;
#pragma unroll
    for (int cb = 0; cb < 2; ++cb)
#pragma unroll
        for (int kb = 0; kb < 2; ++kb) { const bf16x8 f = tr_frag(img, 72, 16 * kb + 8 * h, 16 * kb + 8 * h + 4, 32 * cb, lane);
            *(bf16x8*)(WT8 + (size_t)(dst_row0 + 32 * cb + r) * K8 + k0 + 32 * kb + 16 * h) = f; }
    LDS_WAIT(); asm volatile("" ::: "memory");
}
DI void transpose_item_f8(const float* W, int N, int K8, int k0, int n0, unsigned char* WT8, int dst_row0, const float scale, LAS bf16* img, int lane) {
    const int kk2 = lane >> 4, n4 = (lane & 15) * 4;
    f32x4 va[8], vb[8];
#pragma unroll
    for (int i = 0; i < 8; ++i) { const float* p = W + (size_t)(k0 + 8 * i + 2 * kk2) * N + n0 + n4; va[i] = __builtin_nontemporal_load((const f32x4*)p); vb[i] = __builtin_nontemporal_load((const f32x4*)(p + N)); }
#pragma unroll
    for (int i = 0; i < 8; ++i) { const f32x4 a = va[i] * scale, b2 = vb[i] * scale;
        u32x2 w2; w2.x = pg8::pk_fp8x4(a.x, b2.x, a.y, b2.y); w2.y = pg8::pk_fp8x4(a.z, b2.z, a.w, b2.w); *(LAS u32x2*)(img + (4 * i + kk2) * 72 + n4) = w2; }
    LDS_WAIT(); asm volatile("" ::: "memory");
    const int r = lane & 31, h = lane >> 5;
#pragma unroll
    for (int cb = 0; cb < 2; ++cb)
#pragma unroll
        for (int kb = 0; kb < 2; ++kb) { const bf16x8 f = tr_frag(img, 72, 16 * kb + 8 * h, 16 * kb + 8 * h + 4, 32 * cb, lane);
            *(bf16x8*)(WT8 + (size_t)(dst_row0 + 32 * cb + r) * K8 + k0 + 32 * kb + 16 * h) = f; }
    LDS_WAIT(); asm volatile("" ::: "memory");
}
DI void convert_weights(Frame& F, int l) {
    LAS bf16* img = (LAS bf16*)(F.lds + F.wave * 9216);
    const int gw = F.vcu * 8 + F.wave, NGW = F.G * 8;
    const float* w_in = fin(F, 3) + (size_t)l * DM * NPROJ; const float* w_out = fin(F, 10) + (size_t)l * DM * DM;
    const float* w_gate = fin(F, 15) + (size_t)l * NEXP * DM * DEXP; const float* w_up = fin(F, 16) + (size_t)l * NEXP * DM * DEXP; const float* w_down = fin(F, 17) + (size_t)l * NEXP * DEXP * DM;
    unsigned char* WIN = fws(F) + WS_WIN; unsigned char* WOUT = fws(F) + WS_WOUT; unsigned char* WGU = fws(F) + WS_WGU; unsigned char* WD = fws(F) + WS_WD;
    const float* ABS = (const float*)(fws(F) + WS_CTL + CTL_ABS) + (size_t)l * ABS_PER_LAYER;
    LAS float* wred = (LAS float*)(F.lds + 81920); LAS float* wsc = wred + 512;
    __syncthreads();
#pragma unroll 1
    for (int eb = 0; eb < 4 * NEXP; eb += 16) {
        f32x4 v[16];
#pragma unroll
        for (int i = 0; i < 16; ++i) { const int e = eb + i; const float* src = e < NEXP ? w_down + (size_t)e * DEXP * DM : (e < 3 * NEXP ? ((e & 1) ? w_up : w_gate) + (size_t)((e - NEXP) >> 1) * DM * DEXP : w_in + (size_t)(e - 3 * NEXP) * 128 * NPROJ);
            v[i] = *(const f32x4*)(src + 4 * F.tid); }
#pragma unroll
        for (int i = 0; i < 16; ++i) { const float m = wave_max(fmaxf(fmaxf(fabsf(v[i].x), fabsf(v[i].y)), fmaxf(fabsf(v[i].z), fabsf(v[i].w)))); if (F.lane == 0) wred[(eb + i) * 8 + F.wave] = m; } }
    __syncthreads();
    if (F.tid == 3 * NEXP) { float m = 1e-30f;
        for (int j = 0; j < 128; ++j) m = fmaxf(m, wred[3 * NEXP * 8 + j]);
        const float sc = exp2f(floorf(log2f(64.0f / m))); wsc[3 * NEXP] = sc; if (F.bx == 0) ((float*)(fws(F) + WS_INS))[l] = 1.0f / (pg8::ACT_SCALE * sc); }
    if (F.tid < 3 * NEXP) { float m = 1e-30f;
#pragma unroll
        for (int j = 0; j < 8; ++j) m = fmaxf(m, wred[F.tid * 8 + j]);
        const float sc = exp2f(floorf(log2f(64.0f / m))); wsc[F.tid] = sc;
        if (F.bx == 0) { if (F.tid < NEXP) ((float*)(fws(F) + WS_WDS))[l * NEXP + F.tid] = 1.0f / (pg8::HID_SCALE * sc); else ((float*)(fws(F) + WS_GUS))[l * 2 * NEXP + F.tid - NEXP] = (((F.tid - NEXP) & 1) ? pg8::HID_SCALE : 1.0f) / (pg8::ACT_SCALE * sc); } }
    __syncthreads();
    constexpr int I_IN = (DM / 64) * (NPROJ / 64), I_OUT = (DM / 64) * (DM / 64), I_G1 = (DM / 64) * (DEXP / 64), I_GU = NEXP * 2 * I_G1, I_D1 = (DEXP / 64) * (DM / 64), I_D = NEXP * I_D1;
    constexpr int NITEMS = I_IN + I_OUT + I_GU + I_D;
    for (int it = gw; it < NITEMS; it += NGW) {
        int r = it;
        if (r < I_IN) { const int nblk = NPROJ / 64, kb = r / nblk, nb = r % nblk; transpose_item_f8(w_in, NPROJ, DM, 64 * kb, 64 * nb, WIN, 64 * nb, wsc[3 * NEXP], img, F.lane); continue; } r -= I_IN;
        if (r < I_OUT) { const int nblk = DM / 64, kb = r / nblk, nb = r % nblk; transpose_item_q(w_out, DM, DM, 64 * kb, 64 * nb, WOUT, 64 * nb, ABS + ABS_OUT, img, F.lane); continue; } r -= I_OUT;
        if (r < I_GU) { const int e = r / (2 * I_G1), r2 = r % (2 * I_G1), isup = r2 / I_G1, r3 = r2 % I_G1; const int nblk = DEXP / 64, kb = r3 / nblk, nb = r3 % nblk, n0 = 64 * nb;
            const float* W = (isup ? w_up : w_gate) + (size_t)e * DM * DEXP;
            transpose_item_f8(W, DEXP, DM, 64 * kb, n0, WGU + (size_t)e * 2048 * DM, 256 * (n0 >> 7) + 128 * isup + (n0 & 127), wsc[NEXP + 2 * e + isup], img, F.lane); continue; } r -= I_GU;
        { const int e = r / I_D1, r3 = r % I_D1; const int nblk = DM / 64, kb = r3 / nblk, nb = r3 % nblk;
            transpose_item_f8(w_down + (size_t)e * DEXP * DM, DM, DEXP, 64 * kb, 64 * nb, WD + (size_t)e * DM * DEXP, 64 * nb, wsc[e], img, F.lane); }
    }
}
DI void stage_gb(Frame& F, const float* g, const float* bb, LAS float* gl, LAS float* bl) {
    const f32x4 gv = *(const f32x4*)(g + 4 * F.tid), bv = *(const f32x4*)(bb + 4 * F.tid);
    *(LAS f32x4*)(gl + 4 * F.tid) = gv; *(LAS f32x4*)(bl + 4 * F.tid) = bv;
}
DI void ln_emb(Frame& F) {
    const int gw = F.vcu * 8 + F.wave, NGW = F.G * 8;
    const float* x = fin(F, 0); const float* g = fin(F, 1); const float* bb = fin(F, 2); bf16* H = (bf16*)(fws(F) + WS_H); unsigned char* H8 = fws(F) + WS_H8; float* HS = (float*)(fws(F) + WS_HS);
    LAS float* gl = (LAS float*)F.lds; LAS float* bl = gl + DM;
    __syncthreads(); stage_gb(F, g, bb, gl, bl); __syncthreads();
    f32x4 pre[8];
    if (gw < T_TOK) { const f32x4* xr = (const f32x4*)(x + (size_t)gw * DM) + F.lane;
#pragma unroll
        for (int j = 0; j < 8; ++j) pre[j] = __builtin_nontemporal_load(xr + 64 * j); }
    for (int m = gw; m < T_TOK; m += NGW) {
        f32x4 v[8]; float s = 0.f;
#pragma unroll
        for (int j = 0; j < 8; ++j) { v[j] = pre[j]; s += (v[j].x + v[j].y) + (v[j].z + v[j].w); }
        if (m + NGW < T_TOK) { const f32x4* xr = (const f32x4*)(x + (size_t)(m + NGW) * DM) + F.lane;
#pragma unroll
            for (int j = 0; j < 8; ++j) pre[j] = __builtin_nontemporal_load(xr + 64 * j); }
        const float mean = wave_sum(s) * (1.f / DM); float s2 = 0.f;
#pragma unroll
        for (int j = 0; j < 8; ++j) { v[j] = v[j] - mean; s2 += (v[j].x * v[j].x + v[j].y * v[j].y) + (v[j].z * v[j].z + v[j].w * v[j].w); }
        const float rstd = 1.f / sqrtf(wave_sum(s2) * (1.f / DM) + LN_EPS);
        u32x2* o8 = (u32x2*)(H + (size_t)m * DM) + F.lane; float am = 0.f;
#pragma unroll
        for (int j = 0; j < 8; ++j) { const f32x4 gg = ((const LAS f32x4*)gl)[F.lane + 64 * j], bv = ((const LAS f32x4*)bl)[F.lane + 64 * j];
            v[j] = v[j] * rstd * gg + bv; am = fmaxf(fmaxf(am, fmaxf(fabsf(v[j].x), fabsf(v[j].y))), fmaxf(fabsf(v[j].z), fabsf(v[j].w)));
            u32x2 w; w.x = cvt_pk_bf16(v[j].x, v[j].y); w.y = cvt_pk_bf16(v[j].z, v[j].w); o8[64 * j] = w; }
        am = wave_max(am); const float inv = am > 0.f ? 127.0f / am : 0.f;
        unsigned* q4 = (unsigned*)(H8 + (size_t)m * DM) + F.lane;
#pragma unroll
        for (int j = 0; j < 8; ++j) q4[64 * j] = pg8::pk_fp8x4(v[j].x * pg8::act_scale(), v[j].y * pg8::act_scale(), v[j].z * pg8::act_scale(), v[j].w * pg8::act_scale());
        (void)inv; (void)HS;
    }
}

constexpr int AT_KS = 72, AT_VS = 392;
DI void attn_phase(Frame& F, int l) {
    const bf16* P = (const bf16*)(fws(F) + WS_PROJ); bf16* Y = (bf16*)(fout(F) + DO_Y);
    LAS bf16* Ks = (LAS bf16*)F.lds; LAS bf16* Vt = (LAS bf16*)(F.lds + 384 * AT_KS * 2);
    const int tid = F.tid, lane = F.lane, w = F.wave, r = lane & 31, h = lane >> 5;
    const float* sinkp = fin(F, 4) + l * 8;
    const bool deal = (F.G == 256);
    const int u_first = deal ? (F.vcu >= 128 ? (F.vcu - 128) * 4 : F.vcu * 4 + 3) : F.vcu, u_step = deal ? 1 : F.G, u_end = deal ? (F.vcu >= 128 ? (F.vcu - 128) * 4 + 3 : F.vcu * 4 + 4) : NBATCH * 32 * 2;
    for (int u = u_first; u < u_end; u += u_step) {
        const int kvh = u & 1, n = (u >> 1) & 31, b = u >> 6;
        const size_t rowb = (size_t)b * SEQ;
        __syncthreads();
#pragma unroll
        for (int i = 0; i < 6; ++i) { const int idx = tid + 512 * i, row = idx >> 3, ch = idx & 7; const int tok = n * 128 - 128 + row;
            u32x4 kv = (u32x4){0u, 0u, 0u, 0u}, vv = (u32x4){0u, 0u, 0u, 0u};
            if (tok >= 0 && tok < SEQ) { const bf16* src = P + (rowb + tok) * NPROJ; kv = *(const u32x4*)(src + C_AK + kvh * 64 + ch * 8); vv = *(const u32x4*)(src + C_AV + kvh * 64 + ch * 8); }
            *(LAS u32x4*)(Ks + row * AT_KS + ch * 8) = kv;
            LAS bf16* vd = Vt + (ch * 8) * AT_VS + row;
            vd[0 * AT_VS] = (bf16)(vv.x & 0xffffu); vd[1 * AT_VS] = (bf16)(vv.x >> 16); vd[2 * AT_VS] = (bf16)(vv.y & 0xffffu); vd[3 * AT_VS] = (bf16)(vv.y >> 16);
            vd[4 * AT_VS] = (bf16)(vv.z & 0xffffu); vd[5 * AT_VS] = (bf16)(vv.z >> 16); vd[6 * AT_VS] = (bf16)(vv.w & 0xffffu); vd[7 * AT_VS] = (bf16)(vv.w >> 16); }
        __syncthreads();
        const int hq = kvh * 4 + (w >> 1);
        const float slope2 = exp2f(-(float)(hq + 1)) * 1.4426950408889634f; const float sink2 = sinkp[hq] * 1.4426950408889634f; const float c1 = 0.125f * 1.4426950408889634f;
        const bool edge = (n == 0) || (n == 31); const int jlo = (n == 0) ? 128 : 0, jhi = (n == 31) ? 256 : 384;
#pragma unroll 1
        for (int qi = 0; qi < 2; ++qi) {
            const int t0 = (w & 1) * 64 + 32 * qi;
            const bf16* qsrc = P + (rowb + n * 128 + t0 + r) * NPROJ + C_AQ + hq * 64 + 8 * h;
            bf16x8 qf[4];
#pragma unroll
            for (int ks = 0; ks < 4; ++ks) qf[ks] = *(const bf16x8*)(qsrc + ks * 16);
            float m = sink2, lsum = (h == 0) ? 1.0f : 0.0f;
            f32x16 O0, O1;
#pragma unroll
            for (int i = 0; i < 16; ++i) { O0[i] = 0.f; O1[i] = 0.f; }
#pragma unroll 1
            for (int kt = 0; kt < 9; ++kt) {
                const int j0 = t0 + 32 * kt;
                f32x16 s;
#pragma unroll
                for (int i = 0; i < 16; ++i) s[i] = 0.f;
#pragma unroll
                for (int ks = 0; ks < 4; ++ks) { const bf16x8 a = *(const LAS bf16x8*)(Ks + (j0 + r) * AT_KS + ks * 16 + 8 * h); s = MFMA32(a, qf[ks], s); }
                const float fbase = (float)(32 * kt - 128 - r + 4 * h);
#pragma unroll
                for (int i = 0; i < 16; ++i) { const float fd = fbase + (float)((i & 3) + 8 * (i >> 2)); s[i] = __builtin_fmaf(s[i], c1, -slope2 * __builtin_fabsf(fd)); }
                if (kt == 0 || kt == 8 || edge) {
#pragma unroll
                    for (int i = 0; i < 16; ++i) { const float fd = fbase + (float)((i & 3) + 8 * (i >> 2)); const int j = j0 + crow(i, h);
                        const bool ok = (__builtin_fabsf(fd) <= 128.f) && (j >= jlo) && (j < jhi); s[i] = ok ? s[i] : -INFINITY; } }
                float mx = -INFINITY;
#pragma unroll
                for (int i = 0; i < 16; ++i) mx = fmaxf(mx, s[i]);
                mx = max32(mx);
                const float mn = fmaxf(m, mx); const float sc = __builtin_amdgcn_exp2f(m - mn); m = mn;
                float ps = 0.f;
#pragma unroll
                for (int i = 0; i < 16; ++i) { const float p = __builtin_amdgcn_exp2f(s[i] - mn); s[i] = p; ps += p; }
                lsum = lsum * sc + ps;
#pragma unroll
                for (int i = 0; i < 16; ++i) { O0[i] *= sc; O1[i] *= sc; }
#pragma unroll
                for (int s2 = 0; s2 < 2; ++s2) {
                    u32x4 pw; pw.x = cvt_pk_bf16(s[8 * s2 + 0], s[8 * s2 + 1]); pw.y = cvt_pk_bf16(s[8 * s2 + 2], s[8 * s2 + 3]); pw.z = cvt_pk_bf16(s[8 * s2 + 4], s[8 * s2 + 5]); pw.w = cvt_pk_bf16(s[8 * s2 + 6], s[8 * s2 + 7]);
                    const bf16x8 pf = __builtin_bit_cast(bf16x8, pw);
                    const LAS bf16* vb = Vt + j0 + 16 * s2 + 4 * h;
                    { const u32x2 lo = *(const LAS u32x2*)(vb + r * AT_VS), hi = *(const LAS u32x2*)(vb + r * AT_VS + 8); const u32x4 aw = (u32x4){lo.x, lo.y, hi.x, hi.y}; O0 = MFMA32(__builtin_bit_cast(bf16x8, aw), pf, O0); }
                    { const u32x2 lo = *(const LAS u32x2*)(vb + (32 + r) * AT_VS), hi = *(const LAS u32x2*)(vb + (32 + r) * AT_VS + 8); const u32x4 aw = (u32x4){lo.x, lo.y, hi.x, hi.y}; O1 = MFMA32(__builtin_bit_cast(bf16x8, aw), pf, O1); }
                }
            }
            const float lt = sum32(lsum); const float inv = __builtin_amdgcn_rcpf(lt);
            bf16* yo = Y + (rowb + n * 128 + t0 + r) * DM + hq * 64 + 4 * h;
#pragma unroll
            for (int g4 = 0; g4 < 4; ++g4) {
                u32x2 w0; w0.x = cvt_pk_bf16(O0[4 * g4] * inv, O0[4 * g4 + 1] * inv); w0.y = cvt_pk_bf16(O0[4 * g4 + 2] * inv, O0[4 * g4 + 3] * inv); *(u32x2*)(yo + 8 * g4) = w0;
                u32x2 w1; w1.x = cvt_pk_bf16(O1[4 * g4] * inv, O1[4 * g4 + 1] * inv); w1.y = cvt_pk_bf16(O1[4 * g4 + 2] * inv, O1[4 * g4 + 3] * inv); *(u32x2*)(yo + 32 + 8 * g4) = w1; }
        }
    }
}

DI void conv_phase(Frame& F, int l) {
    const bf16* P = (const bf16*)(fws(F) + WS_PROJ); bf16* Y = (bf16*)(fout(F) + DO_Y);
    const float* cw = fin(F, 5) + (size_t)l * 3 * 512;
    const int nthr = F.G * 512;
    for (int it = F.vcu * 512 + F.tid; it < T_TOK * 64; it += nthr) {
        const int ch = it & 63, tok = it >> 6, tl = tok & (SEQ - 1);
        const bf16* src = P + (size_t)tok * NPROJ + ch * 8;
        float u0[8], u1[8], u2[8], bq[8], a[8], c[8];
        { const u32x4 cc = *(const u32x4*)(src + C_CC), hh = *(const u32x4*)(src + C_CH); unpack8(cc, a); unpack8(hh, c);
#pragma unroll
          for (int j = 0; j < 8; ++j) u1[j] = a[j] * c[j]; }
        if (tl > 0) { const u32x4 cc = *(const u32x4*)(src - NPROJ + C_CC), hh = *(const u32x4*)(src - NPROJ + C_CH); unpack8(cc, a); unpack8(hh, c);
#pragma unroll
          for (int j = 0; j < 8; ++j) u0[j] = a[j] * c[j]; }
        else {
#pragma unroll
          for (int j = 0; j < 8; ++j) u0[j] = 0.f; }
        if (tl < SEQ - 1) { const u32x4 cc = *(const u32x4*)(src + NPROJ + C_CC), hh = *(const u32x4*)(src + NPROJ + C_CH); unpack8(cc, a); unpack8(hh, c);
#pragma unroll
          for (int j = 0; j < 8; ++j) u2[j] = a[j] * c[j]; }
        else {
#pragma unroll
          for (int j = 0; j < 8; ++j) u2[j] = 0.f; }
        { const u32x4 bw = *(const u32x4*)(src + C_CB); unpack8(bw, bq); }
        float o[8];
#pragma unroll
        for (int j = 0; j < 8; ++j) { const int cidx = ch * 8 + j; o[j] = bq[j] * (cw[cidx] * u0[j] + cw[512 + cidx] * u1[j] + cw[1024 + cidx] * u2[j]); }
        *(u32x4*)(Y + (size_t)tok * DM + 512 + ch * 8) = pack8(o);
    }
}

constexpr int GL_RS = 72;
constexpr int GL_VS = 136;
constexpr int GL_QH_OFF = 0;
constexpr int GL_KD_OFF = GL_QH_OFF + 64 * GL_RS * 2;
constexpr int GL_KT_OFF = GL_KD_OFF + 64 * GL_RS * 2;
constexpr int GL_QT_OFF = GL_KT_OFF + 64 * GL_RS * 2;
constexpr int GL_KO_OFF = GL_QT_OFF + 32 * GL_RS * 2;
constexpr int GL_V_OFF = GL_KO_OFF + 32 * GL_RS * 2;
constexpr int GL_RZ_OFF = GL_V_OFF + 2 * 64 * GL_VS * 2;
constexpr int GL_RQ_OFF = GL_RZ_OFF + 64 * GL_RS * 2;
constexpr int GL_OB_OFF = GL_RQ_OFF + 64 * GL_RS * 2;
constexpr int GL_SX_OFF = GL_OB_OFF + 64 * GL_VS * 2;
constexpr int GL_DEC_OFF = GL_SX_OFF + 2 * 128 * GL_RS * 2;
constexpr int GL_END = GL_DEC_OFF + 64 * 4;
static_assert(GL_END <= LDSCTL_OFF, "GLA LDS");
#define LDS_BARRIER() asm volatile("s_waitcnt lgkmcnt(0)\n\ts_barrier" ::: "memory")

template <int N> DI float dpp_row_shr(float x) { return __builtin_bit_cast(float, __builtin_amdgcn_update_dpp(0, __builtin_bit_cast(int, x), 0x110 + N, 0xf, 0xf, true)); }
DI float wave_scan_incl(float x, int lane) {
    x += dpp_row_shr<1>(x); x += dpp_row_shr<2>(x); x += dpp_row_shr<4>(x); x += dpp_row_shr<8>(x);
    x += __builtin_bit_cast(float, __builtin_amdgcn_update_dpp(0, __builtin_bit_cast(int, x), 0x142, 0xa, 0xf, false));
    x += __builtin_bit_cast(float, __builtin_amdgcn_update_dpp(0, __builtin_bit_cast(int, x), 0x143, 0xc, 0xf, false));
    (void)lane;
    return x;
}
DI float gla_lgamma(Frame& F, int l, int dir, int hh) { const float dl = fin(F, 8)[(l * 2 + dir) * 4 + hh]; return -__logf(1.0f + __expf(-dl)); }
DI bf16* gla_partial(Frame& F, int mixer, int dir, int dkh) {
    unsigned char* base = mixer == 0 ? (fout(F) + DO_OB) : (fws(F) + WS_OB1);
    return (bf16*)base + (size_t)(dir * 2 + dkh) * T_TOK * 512;
}

template <int I>
DI void gla_out_tile(const LAS bf16* Sc, const LAS bf16* Qh, const LAS bf16* Qt, const LAS bf16* Kd, const LAS bf16* Ko, const LAS bf16* Vc, LAS bf16* Ob, const int dvt, const int r, const int h, const int lane) {
    const LAS bf16* Qi = (I == 0) ? Qh : Qt;
    f32x16 acc;
#pragma unroll
    for (int i = 0; i < 16; ++i) acc[i] = 0.f;
#pragma unroll
    for (int ks = 0; ks < 4; ++ks) { const bf16x8 a = tr_frag(Sc, GL_VS, 16 * ks + 8 * h, 16 * ks + 8 * h + 4, 32 * dvt, lane), bb = *(const LAS bf16x8*)(Qi + r * GL_RS + ks * 16 + 8 * h); acc = MFMA32(a, bb, acc); }
    bf16x8 qb[4];
#pragma unroll
    for (int ks = 0; ks < 4; ++ks) qb[ks] = *(const LAS bf16x8*)(Qh + (32 * I + r) * GL_RS + ks * 16 + 8 * h);
#pragma unroll
    for (int J = 0; J <= I; ++J) {
        const LAS bf16* Ksrc = (J == I) ? (Kd + (32 * J) * GL_RS) : Ko;
        f32x16 s;
#pragma unroll
        for (int i = 0; i < 16; ++i) s[i] = 0.f;
#pragma unroll
        for (int ks = 0; ks < 4; ++ks) { const bf16x8 a = *(const LAS bf16x8*)(Ksrc + r * GL_RS + ks * 16 + 8 * h); s = MFMA32(a, qb[ks], s); }
        if (J == I) {
#pragma unroll
            for (int i = 0; i < 16; ++i) s[i] = (crow(i, h) <= r) ? s[i] : 0.f; }
#pragma unroll
        for (int s2 = 0; s2 < 2; ++s2) {
            u32x4 pw; pw.x = cvt_pk_bf16(s[8 * s2 + 0], s[8 * s2 + 1]); pw.y = cvt_pk_bf16(s[8 * s2 + 2], s[8 * s2 + 3]); pw.z = cvt_pk_bf16(s[8 * s2 + 4], s[8 * s2 + 5]); pw.w = cvt_pk_bf16(s[8 * s2 + 6], s[8 * s2 + 7]);
            const int rl = 32 * J + 16 * s2 + 4 * h;
            const bf16x8 a = tr_frag(Vc, GL_VS, rl, rl + 8, 32 * dvt, lane);
            acc = MFMA32(a, __builtin_bit_cast(bf16x8, pw), acc); }
    }
    LAS bf16* yo = Ob + (32 * I + r) * GL_VS + 32 * dvt + 4 * h;
#pragma unroll
    for (int g4 = 0; g4 < 4; ++g4) { u32x2 w0; w0.x = cvt_pk_bf16(acc[4 * g4], acc[4 * g4 + 1]); w0.y = cvt_pk_bf16(acc[4 * g4 + 2], acc[4 * g4 + 3]); *(LAS u32x2*)(yo + 8 * g4) = w0; }
}

DI void gla_seq_phase(Frame& F, int l, const float* lbp) {
    const bf16* P = (const bf16*)(fws(F) + WS_PROJ);
    const int tid = F.tid, lane = F.lane, w = F.wave, r = lane & 31, h = lane >> 5;
    LAS bf16* Qh = (LAS bf16*)(F.lds + GL_QH_OFF); LAS bf16* Kd = (LAS bf16*)(F.lds + GL_KD_OFF); LAS bf16* Qt = (LAS bf16*)(F.lds + GL_QT_OFF); LAS bf16* Kt = (LAS bf16*)(F.lds + GL_KT_OFF);
    LAS bf16* Ko = (LAS bf16*)(F.lds + GL_KO_OFF); LAS bf16* Vs = (LAS bf16*)(F.lds + GL_V_OFF); LAS bf16* Sx = (LAS bf16*)(F.lds + GL_SX_OFF); LAS float* dec = (LAS float*)(F.lds + GL_DEC_OFF);
    LAS bf16* Rz = (LAS bf16*)(F.lds + GL_RZ_OFF); LAS bf16* Rq = (LAS bf16*)(F.lds + GL_RQ_OFF); LAS bf16* Ob = (LAS bf16*)(F.lds + GL_OB_OFF);
    const int zrow = tid >> 3, zch = tid & 7, vrow0 = tid >> 4, vch = tid & 15;
    for (int unit = F.vcu; unit < 256; unit += F.G)
#pragma unroll 1
    for (int rp_ = 0; rp_ < 1 + (int)((((PH_DUP >> 17) & 1u) && unit < 128) || (((PH_DUP >> 18) & 1u) && unit >= 128)); ++rp_) {
        const int dkh = unit & 1, dir = (unit >> 1) & 1, hh = (unit >> 2) & 3, b = (unit >> 4) & 7, mixer = unit >> 7;
        const int qcol = mixer == 0 ? C_GQ : C_RQ, zcol = mixer == 0 ? (dir ? C_GZB : C_GZF) : C_RK, vcol = mixer == 0 ? C_GI : C_RV;
        const float lg = mixer == 1 ? gla_lgamma(F, l, dir, hh) : 0.f;
        const float rbu = (float)(lane + 1) * lg, rbeta = (lane >= 32) ? 32.f * lg : 0.f;
        const float rfa = __expf(rbu - rbeta), rfna = __expf(fminf(rbeta - rbu, 80.f)), rfkt = __expf(64.f * lg - rbu), re31 = __expf(32.f * lg), rdec = __expf(64.f * lg);
        const size_t rowb = (size_t)b * SEQ;
        bf16* ob = gla_partial(F, mixer, dir, dkh);
        const int dch = hh * 128 + 64 * dkh;
        float lbv[8];
#pragma unroll
        for (int j = 0; j < 8; ++j) lbv[j] = (mixer == 0 && lbp) ? lbp[dch + 8 * w + j] : 0.f;
        __syncthreads();
        for (int i = tid; i < 64 * GL_VS / 2; i += 512) ((LAS unsigned*)Sx)[i] = 0u;
        f32x16 st0, st1;
#pragma unroll
        for (int i = 0; i < 16; ++i) { st0[i] = 0.f; st1[i] = 0.f; }
        u32x4 zr, qr, vr0, vr1;
#define GLA_LOAD(cc) do { const int c_ = (cc); const bf16* s0_ = P + (rowb + c_ * 64 + (dir ? 63 - zrow : zrow)) * NPROJ; zr = *(const u32x4*)(s0_ + zcol + dch + 8 * zch); qr = *(const u32x4*)(s0_ + qcol + dch + 8 * zch); \
        const bf16* s1_ = P + (rowb + c_ * 64 + (dir ? 63 - vrow0 : vrow0)) * NPROJ + vcol + hh * 128 + 8 * vch; const bf16* s2_ = P + (rowb + c_ * 64 + (dir ? 63 - (vrow0 + 32) : (vrow0 + 32))) * NPROJ + vcol + hh * 128 + 8 * vch; \
        vr0 = *(const u32x4*)s1_; vr1 = *(const u32x4*)s2_; } while (0)
#define GLA_STASH(vb) do { *(LAS u32x4*)(Rz + zrow * GL_RS + 8 * zch) = zr; *(LAS u32x4*)(Rq + zrow * GL_RS + 8 * zch) = qr; \
        *(LAS u32x4*)(Vs + (vb) * (64 * GL_VS) + vrow0 * GL_VS + 8 * vch) = vr0; *(LAS u32x4*)(Vs + (vb) * (64 * GL_VS) + (vrow0 + 32) * GL_VS + 8 * vch) = vr1; } while (0)
        GLA_LOAD(dir ? 63 : 0);
        GLA_STASH(0);
        GLA_LOAD(dir ? 62 : 1);
        LDS_BARRIER();
#pragma unroll 1
        for (int cs = 0; cs < 64; ++cs) {
            const int c = dir ? 63 - cs : cs;
            if (cs > 0) { const int cp = dir ? 64 - cs : cs - 1;
#pragma unroll
                for (int k2 = 0; k2 < 2; ++k2) { const int u = vrow0 + 32 * k2; const u32x4 ov = *(const LAS u32x4*)(Ob + u * GL_VS + 8 * vch);
                    *(u32x4*)(ob + (rowb + cp * 64 + (dir ? 63 - u : u)) * 512 + hh * 128 + 8 * vch) = ov; } }
            float kk[8], bq[8], qv[8];
            unpack8(*(const LAS u32x4*)(Rz + lane * GL_RS + 8 * w), kk); unpack8(*(const LAS u32x4*)(Rq + lane * GL_RS + 8 * w), qv);
            float qh[8], kd[8], kq[8], kt[8];
            if (mixer == 1) {
#pragma unroll
                for (int j = 0; j < 8; ++j) { const float k2 = kk[j] * 0.08838834764831845f; qh[j] = qv[j] * rfa; kd[j] = k2 * rfna; kt[j] = k2 * rfkt; kq[j] = (lane >= 32 ? qh[j] : kd[j]) * re31; }
                if (lane < 8) dec[8 * w + lane] = rdec;
            } else {
#pragma unroll
            for (int j = 0; j < 8; ++j) { const float f = lbv[j] + (1.0f - lbv[j]) * __builtin_amdgcn_rcpf(1.0f + __builtin_amdgcn_exp2f(kk[j] * -1.4426950408889634f)); kk[j] = 1.0f - f; bq[j] = __builtin_amdgcn_logf(f); }
#pragma unroll
            for (int j = 0; j < 8; ++j) bq[j] = wave_scan_incl(bq[j], lane);
#pragma unroll
            for (int j = 0; j < 8; ++j) {
                const float b31 = __builtin_bit_cast(float, __builtin_amdgcn_readlane(__builtin_bit_cast(int, bq[j]), 31));
                const float bl = __builtin_bit_cast(float, __builtin_amdgcn_readlane(__builtin_bit_cast(int, bq[j]), 63));
                const bool up = lane >= 32; const float beta = up ? b31 : 0.f; const float a = bq[j] - beta;
                const float e31 = __builtin_amdgcn_exp2f(b31);
                qh[j] = qv[j] * __builtin_amdgcn_exp2f(a); kd[j] = kk[j] * __builtin_amdgcn_exp2f(fminf(-a, 115.f)); kt[j] = kk[j] * __builtin_amdgcn_exp2f(bl - bq[j]);
                kq[j] = (up ? qh[j] : kd[j]) * e31;
            }
            if (lane == 63) {
                *(LAS f32x4*)(dec + 8 * w) = (f32x4){__builtin_amdgcn_exp2f(bq[0]), __builtin_amdgcn_exp2f(bq[1]), __builtin_amdgcn_exp2f(bq[2]), __builtin_amdgcn_exp2f(bq[3])};
                *(LAS f32x4*)(dec + 8 * w + 4) = (f32x4){__builtin_amdgcn_exp2f(bq[4]), __builtin_amdgcn_exp2f(bq[5]), __builtin_amdgcn_exp2f(bq[6]), __builtin_amdgcn_exp2f(bq[7])}; }
            }
            { const int off = lane * GL_RS + 8 * w;
              *(LAS u32x4*)(Qh + off) = pack8(qh); *(LAS u32x4*)(Kd + off) = pack8(kd); *(LAS u32x4*)(Kt + off) = pack8(kt);
              if (lane < 32) *(LAS u32x4*)(Ko + off) = pack8(kq); else *(LAS u32x4*)(Qt + (lane - 32) * GL_RS + 8 * w) = pack8(kq); }
            LDS_BARRIER();
            if (cs + 1 < 64) { GLA_STASH((cs + 1) & 1); if (cs + 2 < 64) GLA_LOAD(dir ? 61 - cs : cs + 2); }
            const LAS bf16* Vc = Vs + (cs & 1) * (64 * GL_VS);
            if (w < 4) {
                gla_out_tile<0>(Sx + (cs & 1) * (64 * GL_VS), Qh, Qt, Kd, Ko, Vc, Ob, w, r, h, lane);
                const float dl0 = dec[r], dl1 = dec[32 + r];
                LAS bf16* Sn = Sx + ((cs + 1) & 1) * (64 * GL_VS);
#pragma unroll
                for (int i = 0; i < 16; ++i) { st0[i] *= dl0; st1[i] *= dl1; }
#pragma unroll
                for (int ks = 0; ks < 4; ++ks) {
                    const bf16x8 a = tr_frag(Vc, GL_VS, 16 * ks + 8 * h, 16 * ks + 8 * h + 4, 32 * w, lane);
                    const bf16x8 b0 = tr_frag(Kt, GL_RS, 16 * ks + 8 * h, 16 * ks + 8 * h + 4, 0, lane), b1 = tr_frag(Kt, GL_RS, 16 * ks + 8 * h, 16 * ks + 8 * h + 4, 32, lane);
                    st0 = MFMA32(a, b0, st0); st1 = MFMA32(a, b1, st1); }
#pragma unroll
                for (int g4 = 0; g4 < 4; ++g4) {
                    u32x2 w0; w0.x = cvt_pk_bf16(st0[4 * g4], st0[4 * g4 + 1]); w0.y = cvt_pk_bf16(st0[4 * g4 + 2], st0[4 * g4 + 3]); *(LAS u32x2*)(Sn + r * GL_VS + 32 * w + 8 * g4 + 4 * h) = w0;
                    u32x2 w1; w1.x = cvt_pk_bf16(st1[4 * g4], st1[4 * g4 + 1]); w1.y = cvt_pk_bf16(st1[4 * g4 + 2], st1[4 * g4 + 3]); *(LAS u32x2*)(Sn + (32 + r) * GL_VS + 32 * w + 8 * g4 + 4 * h) = w1; }
            } else gla_out_tile<1>(Sx + (cs & 1) * (64 * GL_VS), Qh, Qt, Kd, Ko, Vc, Ob, w & 3, r, h, lane);
            LDS_BARRIER();
        }
        { const int cp = dir ? 0 : 63;
#pragma unroll
          for (int k2 = 0; k2 < 2; ++k2) { const int u = vrow0 + 32 * k2; const u32x4 ov = *(const LAS u32x4*)(Ob + u * GL_VS + 8 * vch);
              *(u32x4*)(ob + (rowb + cp * 64 + (dir ? 63 - u : u)) * 512 + hh * 128 + 8 * vch) = ov; } }
#undef GLA_LOAD
#undef GLA_STASH
    }
}
DI void gla_norm_phase(Frame& F, int l) {
    const bf16* P = (const bf16*)(fws(F) + WS_PROJ); const bf16* Y = (const bf16*)(fout(F) + DO_Y); unsigned char* Y8 = fws(F) + WS_Y8; float* YSC = (float*)(fws(F) + WS_YSC);
    const int gw = F.vcu * 8 + F.wave, NGW = F.G * 8, lane = F.lane;
    const bf16* p0 = gla_partial(F, 0, 0, 0); const bf16* p1 = gla_partial(F, 1, 0, 0);
    const float* ng0 = fin(F, 7) + (size_t)l * 512 + lane * 8; const float* ng1 = fin(F, 9) + (size_t)l * 512 + lane * 8;
    float cwv[3][8];
    { const float* cw = fin(F, 5) + (size_t)l * 3 * 512 + lane * 8;
#pragma unroll
      for (int t3 = 0; t3 < 3; ++t3) { const f32x4 c0 = *(const f32x4*)(cw + t3 * 512), c1 = *(const f32x4*)(cw + t3 * 512 + 4); cwv[t3][0] = c0.x; cwv[t3][1] = c0.y; cwv[t3][2] = c0.z; cwv[t3][3] = c0.w; cwv[t3][4] = c1.x; cwv[t3][5] = c1.y; cwv[t3][6] = c1.z; cwv[t3][7] = c1.w; } }
    for (int tok = gw; tok < T_TOK; tok += NGW) {
        float v[32];
        const u32x4 ya = __builtin_nontemporal_load((const u32x4*)(Y + (size_t)tok * DM + lane * 8));
        const int tl = tok & (SEQ - 1); const bf16* cs = P + (size_t)tok * NPROJ + lane * 8;
        const u32x4 z4 = (u32x4){0u, 0u, 0u, 0u};
        const u32x4 cbw = *(const u32x4*)(cs + C_CB), cc1 = *(const u32x4*)(cs + C_CC), ch1 = *(const u32x4*)(cs + C_CH);
        const u32x4 cc0 = tl > 0 ? *(const u32x4*)(cs - NPROJ + C_CC) : z4, ch0 = tl > 0 ? *(const u32x4*)(cs - NPROJ + C_CH) : z4;
        const u32x4 cc2 = tl < SEQ - 1 ? *(const u32x4*)(cs + NPROJ + C_CC) : z4, ch2 = tl < SEQ - 1 ? *(const u32x4*)(cs + NPROJ + C_CH) : z4;
        u32x4 pa[4], pb[4];
#pragma unroll
        for (int part = 0; part < 4; ++part) { pa[part] = __builtin_nontemporal_load((const u32x4*)(p0 + ((size_t)part * T_TOK + tok) * 512 + lane * 8)); pb[part] = __builtin_nontemporal_load((const u32x4*)(p1 + ((size_t)part * T_TOK + tok) * 512 + lane * 8)); }
        const u32x4 g0 = __builtin_nontemporal_load((const u32x4*)(P + (size_t)tok * NPROJ + C_GO + lane * 8)), g1 = __builtin_nontemporal_load((const u32x4*)(P + (size_t)tok * NPROJ + C_RG + lane * 8));
        { float t8[8]; unpack8(ya, t8);
#pragma unroll
          for (int q = 0; q < 8; ++q) v[q] = t8[q];
          float a0[8], h0[8], a1[8], h1[8], a2[8], h2[8], bq8[8]; unpack8(cc0, a0); unpack8(ch0, h0); unpack8(cc1, a1); unpack8(ch1, h1); unpack8(cc2, a2); unpack8(ch2, h2); unpack8(cbw, bq8);
#pragma unroll
          for (int q = 0; q < 8; ++q) v[8 + q] = bq8[q] * (cwv[0][q] * (a0[q] * h0[q]) + cwv[1][q] * (a1[q] * h1[q]) + cwv[2][q] * (a2[q] * h2[q])); }
#pragma unroll
        for (int mixer = 0; mixer < 2; ++mixer) {
            float o[8];
#pragma unroll
            for (int q = 0; q < 8; ++q) o[q] = 0.f;
#pragma unroll
            for (int part = 0; part < 4; ++part) { float t8[8]; unpack8(mixer == 0 ? pa[part] : pb[part], t8);
#pragma unroll
                for (int q = 0; q < 8; ++q) o[q] += t8[q]; }
            float s1 = 0.f, s2 = 0.f;
#pragma unroll
            for (int q = 0; q < 8; ++q) { s1 += o[q]; s2 += o[q] * o[q]; }
            s1 += sx<1>(s1); s2 += sx<1>(s2); s1 += sx<2>(s1); s2 += sx<2>(s2); s1 += sx<4>(s1); s2 += sx<4>(s2); s1 += sx<8>(s1); s2 += sx<8>(s2);
            float mean = 0.f, rstd;
            if (mixer == 0) rstd = __builtin_amdgcn_rsqf(s2 * (1.f / 128.f) + HN_EPS);
            else { mean = s1 * (1.f / 128.f); const float var = fmaxf(s2 * (1.f / 128.f) - mean * mean, 0.f); rstd = __builtin_amdgcn_rsqf(var + HN_EPS); }
            const float* ng = mixer == 0 ? ng0 : ng1; const f32x4 n0 = *(const f32x4*)ng, n1 = *(const f32x4*)(ng + 4); const float nn[8] = {n0.x, n0.y, n0.z, n0.w, n1.x, n1.y, n1.z, n1.w};
            float gate[8]; unpack8(mixer == 0 ? g0 : g1, gate);
#pragma unroll
            for (int q = 0; q < 8; ++q) v[16 + 8 * mixer + q] = (o[q] - mean) * rstd * nn[q] * siluf_(gate[q]);
        }
        float am = 0.f;
#pragma unroll
        for (int q = 0; q < 32; ++q) am = fmaxf(am, fabsf(v[q]));
        am = wave_max(am); const float inv = am > 0.f ? 127.0f / am : 0.f;
#pragma unroll
        for (int j = 0; j < 4; ++j) { u32x2 w2; w2.x = q8(v[j * 8] * inv) | (q8(v[j * 8 + 1] * inv) << 8) | (q8(v[j * 8 + 2] * inv) << 16) | (q8(v[j * 8 + 3] * inv) << 24);
            w2.y = q8(v[j * 8 + 4] * inv) | (q8(v[j * 8 + 5] * inv) << 8) | (q8(v[j * 8 + 6] * inv) << 16) | (q8(v[j * 8 + 7] * inv) << 24); *(u32x2*)(Y8 + (size_t)tok * DM + lane * 8 + 512 * j) = w2; }
        if (lane == 0) YSC[tok] = am * (1.0f / 127.0f);
    }
}

DI float reduce16(const float (&v)[16], int lane) {
    float a[8];
#pragma unroll
    for (int e = 0; e < 8; ++e) { const bool up = (lane & 32) != 0; const float keep = up ? v[e + 8] : v[e], give = up ? v[e] : v[e + 8]; a[e] = keep + sx32(give, lane); }
    float b4[4];
#pragma unroll
    for (int e = 0; e < 4; ++e) { const bool up = (lane & 16) != 0; const float keep = up ? a[e + 4] : a[e], give = up ? a[e] : a[e + 4]; b4[e] = keep + sx<16>(give); }
    float c2[2];
#pragma unroll
    for (int e = 0; e < 2; ++e) { const bool up = (lane & 8) != 0; const float keep = up ? b4[e + 2] : b4[e], give = up ? b4[e] : b4[e + 2]; c2[e] = keep + sx<8>(give); }
    float d; { const bool up = (lane & 4) != 0; const float keep = up ? c2[1] : c2[0], give = up ? c2[0] : c2[1]; d = keep + sx<4>(give); }
    d += sx<2>(d); d += sx<1>(d);
    return d;
}
constexpr int RW_RS = 2056;
DI void ln1_router_phase(Frame& F, int l, bool dry = false) {
    bf16* H = (bf16*)(fws(F) + WS_H); const unsigned char* MIX = fws(F) + WS_MIX; const float* MSC = (const float*)(fws(F) + WS_MSC);
    const float* g = fin(F, 11) + (size_t)l * DM; const float* bb = fin(F, 12) + (size_t)l * DM; const float* rw = fin(F, 13); const float* rb = fin(F, 14);
    int* EID = (int*)(fws(F) + WS_EID); float* EW = (float*)(fws(F) + WS_EW); int* CNT = (int*)(fws(F) + WS_CNT); unsigned char* H8 = fws(F) + WS_H8; float* HS = (float*)(fws(F) + WS_HS);
    bf16* HO = H; if (dry) { HO = (bf16*)(fws(F) + WS_OB1); H8 = fout(F) + DO_OB; EID = (int*)(fws(F) + WS_Y8); EW = (float*)(fws(F) + WS_Y8 + MiB); CNT = (int*)(fws(F) + WS_Y8 + 2 * MiB); HS = (float*)(fws(F) + WS_Y8 + 3 * MiB); }
    LAS bf16* rwb = (LAS bf16*)F.lds;
    LAS float* gl = (LAS float*)(F.lds + 16 * RW_RS * 2); LAS float* bl = gl + DM;
    LAS int* cnt = (LAS int*)(F.lds + LDSCTL_OFF + 64);
    const int lane = F.lane;
    const float rbe = rb[lane & 15];
    __syncthreads();
    stage_gb(F, g, bb, gl, bl);
    { f32x4 rv[16];
#pragma unroll
      for (int it = 0; it < 16; ++it) rv[it] = *(const f32x4*)(rw + 4 * (F.tid + 512 * it));
#pragma unroll
      for (int it = 0; it < 16; ++it) { const int i = 4 * (F.tid + 512 * it), k = i >> 4, e = i & 15; rwb[e * RW_RS + k] = f2bf(rv[it].x); rwb[(e + 1) * RW_RS + k] = f2bf(rv[it].y); rwb[(e + 2) * RW_RS + k] = f2bf(rv[it].z); rwb[(e + 3) * RW_RS + k] = f2bf(rv[it].w); } }
    for (int ch = F.vcu; ch < 256; ch += F.G) {
        if (F.tid < 16) cnt[F.tid] = 0;
        __syncthreads();
        const int tok0 = ch * 128 + F.wave * 16;
        u32x4 ph[4]; u32x2 pm[4]; float psc[4];
#pragma unroll
        for (int j = 0; j < 4; ++j) { ph[j] = *(const u32x4*)(H + (size_t)tok0 * DM + lane * 8 + 512 * j); pm[j] = __builtin_nontemporal_load((const u32x2*)(MIX + (size_t)tok0 * DM + lane * 8 + 512 * j)); psc[j] = MSC[(size_t)tok0 * 8 + (lane >> 5) + 2 * j]; }
#pragma unroll 1
        for (int ti = 0; ti < 16; ++ti) {
            const int tok = tok0 + ti;
            float v[32]; float s = 0.f;
#pragma unroll
            for (int j = 0; j < 4; ++j) { float a[8], m8[8]; unpack8(ph[j], a); unpack_i8(pm[j], psc[j], m8);
#pragma unroll
                for (int q = 0; q < 8; ++q) { v[j * 8 + q] = ALPHA * a[q] + m8[q]; s += v[j * 8 + q]; } }
            if (ti + 1 < 16) {
#pragma unroll
                for (int j = 0; j < 4; ++j) { ph[j] = *(const u32x4*)(H + (size_t)(tok + 1) * DM + lane * 8 + 512 * j); pm[j] = __builtin_nontemporal_load((const u32x2*)(MIX + (size_t)(tok + 1) * DM + lane * 8 + 512 * j)); psc[j] = MSC[(size_t)(tok + 1) * 8 + (lane >> 5) + 2 * j]; } }
            const float mean = wave_sum(s) * (1.f / DM); float s2 = 0.f;
#pragma unroll
            for (int q = 0; q < 32; ++q) { v[q] -= mean; s2 += v[q] * v[q]; }
            const float rstd = 1.f / sqrtf(wave_sum(s2) * (1.f / DM) + LN_EPS);
            float am = 0.f;
#pragma unroll
            for (int j = 0; j < 4; ++j) { const int c0 = lane * 8 + 512 * j; const f32x4 g0 = *(const LAS f32x4*)(gl + c0), g1 = *(const LAS f32x4*)(gl + c0 + 4), b0 = *(const LAS f32x4*)(bl + c0), b1 = *(const LAS f32x4*)(bl + c0 + 4);
                const float gg[8] = {g0.x, g0.y, g0.z, g0.w, g1.x, g1.y, g1.z, g1.w}, bv[8] = {b0.x, b0.y, b0.z, b0.w, b1.x, b1.y, b1.z, b1.w};
                float o[8];
#pragma unroll
                for (int q = 0; q < 8; ++q) { o[q] = v[j * 8 + q] * rstd * gg[q] + bv[q]; v[j * 8 + q] = o[q]; am = fmaxf(am, fabsf(o[q])); }
                *(u32x4*)(HO + (size_t)tok * DM + c0) = pack8(o); }
            (void)am; (void)HS;
#pragma unroll
            for (int j = 0; j < 4; ++j) { u32x2 w2; w2.x = pg8::pk_fp8x4(v[j * 8] * pg8::act_scale(), v[j * 8 + 1] * pg8::act_scale(), v[j * 8 + 2] * pg8::act_scale(), v[j * 8 + 3] * pg8::act_scale());
                w2.y = pg8::pk_fp8x4(v[j * 8 + 4] * pg8::act_scale(), v[j * 8 + 5] * pg8::act_scale(), v[j * 8 + 6] * pg8::act_scale(), v[j * 8 + 7] * pg8::act_scale()); *(u32x2*)(H8 + (size_t)tok * DM + lane * 8 + 512 * j) = w2; }
        }
        asm volatile("s_waitcnt vmcnt(0)" ::: "memory");
        f32x4 acc = (f32x4){0.f, 0.f, 0.f, 0.f};
        { const bf16* hrow = HO + (size_t)(tok0 + (lane & 15)) * DM + 8 * (lane >> 4); const LAS bf16* wrow = rwb + (lane & 15) * RW_RS + 8 * (lane >> 4);
#pragma unroll 16
          for (int st = 0; st < 64; ++st) { const bf16x8 a = *(const bf16x8*)(hrow + 32 * st), bq = *(const LAS bf16x8*)(wrow + 32 * st); acc = __builtin_amdgcn_mfma_f32_16x16x32_bf16(a, bq, acc, 0, 0, 0); } }
#pragma unroll
        for (int reg = 0; reg < 4; ++reg) {
            const int tok = tok0 + 4 * (lane >> 4) + reg; const int rowb = lane & 48;
            const float x = acc[reg] + rbe;
            float mx = x;
            mx = fmaxf(mx, sx<1>(mx)); mx = fmaxf(mx, sx<2>(mx)); mx = fmaxf(mx, sx<4>(mx)); mx = fmaxf(mx, sx<8>(mx));
            const float p = __expf(x - mx);
            float qa = -1.f, qc = -1.f;
#pragma unroll
            for (int q = 0; q < 4; ++q) { const float y = shfl_idx(p, (lane & ~3) + q); if (y > qa) { qc = qa; qa = y; } else if (y > qc) qc = y; }
            const float gs = qa + qc;
            int gsel = 0; float gbest = -1.f;
#pragma unroll
            for (int gi = 0; gi < 4; ++gi) { const float y = shfl_idx(gs, rowb + 4 * gi); if (y > gbest) { gbest = y; gsel = gi; } }
            int i1 = 0, i2 = 0; float p1 = -1.f, p2 = -1.f;
#pragma unroll
            for (int q = 0; q < 4; ++q) { const float y = shfl_idx(p, rowb + 4 * gsel + q); if (y > p1) { p2 = p1; i2 = i1; p1 = y; i1 = q; } else if (y > p2) { p2 = y; i2 = q; } }
            if ((lane & 15) == 0) { const float inv = 1.f / (p1 + p2); const int e1 = gsel * 4 + i1, e2 = gsel * 4 + i2;
                EID[tok * 2] = e1; EID[tok * 2 + 1] = e2; EW[tok * 2] = p1 * inv; EW[tok * 2 + 1] = p2 * inv;
                __hip_atomic_fetch_add(cnt + e1, 1, __ATOMIC_RELAXED, __HIP_MEMORY_SCOPE_WORKGROUP); __hip_atomic_fetch_add(cnt + e2, 1, __ATOMIC_RELAXED, __HIP_MEMORY_SCOPE_WORKGROUP); }
        }
        __syncthreads();
        if (F.tid < 16) CNT[ch * 16 + F.tid] = cnt[F.tid];
        __syncthreads();
    }
}
DI void assign_phase(Frame& F) {
    const int* EID = (const int*)(fws(F) + WS_EID); const int* CNT = (const int*)(fws(F) + WS_CNT);
    int* SOT = (int*)(fws(F) + WS_SOT); int* TOS = (int*)(fws(F) + WS_TOS); int* TST = (int*)(fws(F) + WS_TST);
    LAS int* tot = (LAS int*)F.lds;
    LAS int* base = tot + 16;
    LAS int* pre = base + 16;
    LAS int* eids = pre + 16;
    LAS int* part = eids + 256;
    const int tid = F.tid;
    const int e = tid & 15, pp = tid >> 4;
    int cv[8];
#pragma unroll
    for (int k = 0; k < 8; ++k) cv[k] = CNT[(pp * 8 + k) * 16 + e];
    __syncthreads();
    { int s = 0;
#pragma unroll
      for (int k = 0; k < 8; ++k) s += cv[k];
      part[pp * 16 + e] = s; }
    __syncthreads();
    if (tid < 16) { int s = 0; for (int q = 0; q < 32; ++q) s += part[q * 16 + tid]; tot[tid] = s; }
    __syncthreads();
    if (tid == 0) { int acc = 0; for (int q = 0; q < 16; ++q) { base[q] = acc; acc += (tot[q] + 255) & ~255; }
        if (F.bx == 0) { int tacc = 0; for (int q = 0; q < 16; ++q) { TST[q] = tacc; tacc += (tot[q] + 255) >> 8; } TST[16] = tacc; } }
    __syncthreads();
    if (F.bx == 0) { for (int q = 0; q < 16; ++q) { const int lo = base[q] + tot[q], hi = base[q] + ((tot[q] + 255) & ~255); for (int s = lo + tid; s < hi; s += 512) TOS[s] = 0; } }
    for (int ch = F.vcu; ch < 256; ch += F.G) {
        __syncthreads();
        { int s = 0;
#pragma unroll
          for (int k = 0; k < 8; ++k) s += (pp * 8 + k < ch) ? cv[k] : 0;
          part[pp * 16 + e] = s; }
        if (tid < 256) eids[tid] = EID[ch * 256 + tid];
        __syncthreads();
        if (tid < 16) { int s = 0; for (int q = 0; q < 32; ++q) s += part[q * 16 + tid]; pre[tid] = s; }
        __syncthreads();
        if (tid < 256) { const int ee = eids[tid]; int rank = 0; for (int j = 0; j < tid; ++j) rank += (eids[j] == ee) ? 1 : 0;
            const int pos = base[ee] + pre[ee] + rank; const int tok = ch * 128 + (tid >> 1);
            TOS[pos] = tok; SOT[ch * 256 + tid] = pos; }
    }
}
DI void unpack_f8(u32x2 w, float* o) {
    const f32x2 a = __builtin_amdgcn_cvt_pk_f32_fp8((int)w.x, false), b = __builtin_amdgcn_cvt_pk_f32_fp8((int)w.x, true), c = __builtin_amdgcn_cvt_pk_f32_fp8((int)w.y, false), d = __builtin_amdgcn_cvt_pk_f32_fp8((int)w.y, true);
    o[0] = a.x; o[1] = a.y; o[2] = b.x; o[3] = b.y; o[4] = c.x; o[5] = c.y; o[6] = d.x; o[7] = d.y; }
DI void combine_ln2_phase(Frame& F, int l, bool final_out, bool dry = false) {
    bf16* H = (bf16*)(fws(F) + WS_H); const unsigned char* YS = fws(F) + WS_YS;
    const float* g = fin(F, 18) + (size_t)l * DM; const float* bb = fin(F, 19) + (size_t)l * DM;
    const int* SOT = (const int*)(fws(F) + WS_SOT); const float* EW = (const float*)(fws(F) + WS_EW);
    float* OUT = (float*)fout(F); unsigned char* H8 = fws(F) + WS_H8; float* HS = (float*)(fws(F) + WS_HS);
    bf16* HO = H; if (dry) { HO = (bf16*)(fws(F) + WS_OB1); H8 = fws(F) + WS_Y8; HS = (float*)(fws(F) + WS_YSC); final_out = false; }
    const int gw = F.vcu * 8 + F.wave, NGW = F.G * 8, lane = F.lane;
    LAS float* gl = (LAS float*)F.lds; LAS float* bl = gl + DM;
    __syncthreads(); stage_gb(F, g, bb, gl, bl); __syncthreads();
    int s0n = 0, s1n = 0; float w0n = 0.f, w1n = 0.f;
    float w0c = 0.f, w1c = 0.f; u32x4 ph[4]; u32x2 py0[4], py1[4];
    if (gw < T_TOK) { const int s0 = SOT[gw * 2], s1 = SOT[gw * 2 + 1]; w0c = EW[gw * 2]; w1c = EW[gw * 2 + 1];
#pragma unroll
        for (int j = 0; j < 4; ++j) { const int c0 = lane * 8 + 512 * j; ph[j] = *(const u32x4*)(H + (size_t)gw * DM + c0); py0[j] = __builtin_nontemporal_load((const u32x2*)(YS + (size_t)s0 * DM + c0)); py1[j] = __builtin_nontemporal_load((const u32x2*)(YS + (size_t)s1 * DM + c0)); }
        if (gw + NGW < T_TOK) { const int t2 = gw + NGW; s0n = SOT[t2 * 2]; s1n = SOT[t2 * 2 + 1]; w0n = EW[t2 * 2]; w1n = EW[t2 * 2 + 1]; } }
    for (int tok = gw; tok < T_TOK; tok += NGW) {
        const float w0 = w0c * (1.0f / pg8::YS_SCALE), w1 = w1c * (1.0f / pg8::YS_SCALE);
        float v[32]; float s = 0.f;
#pragma unroll
        for (int j = 0; j < 4; ++j) { float a[8], y0[8], y1[8]; unpack8(ph[j], a); unpack_f8(py0[j], y0); unpack_f8(py1[j], y1);
#pragma unroll
            for (int q = 0; q < 8; ++q) { v[j * 8 + q] = ALPHA * a[q] + w0 * y0[q] + w1 * y1[q]; s += v[j * 8 + q]; } }
        if (tok + NGW < T_TOK) { const int t1 = tok + NGW; const int s0 = s0n, s1 = s1n; w0c = w0n; w1c = w1n;
#pragma unroll
            for (int j = 0; j < 4; ++j) { const int c0 = lane * 8 + 512 * j; ph[j] = *(const u32x4*)(H + (size_t)t1 * DM + c0); py0[j] = __builtin_nontemporal_load((const u32x2*)(YS + (size_t)s0 * DM + c0)); py1[j] = __builtin_nontemporal_load((const u32x2*)(YS + (size_t)s1 * DM + c0)); }
            if (t1 + NGW < T_TOK) { const int t2 = t1 + NGW; s0n = SOT[t2 * 2]; s1n = SOT[t2 * 2 + 1]; w0n = EW[t2 * 2]; w1n = EW[t2 * 2 + 1]; } }
        const float mean = wave_sum(s) * (1.f / DM); float s2 = 0.f;
#pragma unroll
        for (int q = 0; q < 32; ++q) { v[q] -= mean; s2 += v[q] * v[q]; }
        const float rstd = 1.f / sqrtf(wave_sum(s2) * (1.f / DM) + LN_EPS);
#pragma unroll
        for (int j = 0; j < 4; ++j) { const int c0 = lane * 8 + 512 * j; const f32x4 g0 = *(const LAS f32x4*)(gl + c0), g1 = *(const LAS f32x4*)(gl + c0 + 4), b0 = *(const LAS f32x4*)(bl + c0), b1 = *(const LAS f32x4*)(bl + c0 + 4);
            const float gg[8] = {g0.x, g0.y, g0.z, g0.w, g1.x, g1.y, g1.z, g1.w}, bv[8] = {b0.x, b0.y, b0.z, b0.w, b1.x, b1.y, b1.z, b1.w};
            float o[8];
#pragma unroll
            for (int q = 0; q < 8; ++q) { o[q] = v[j * 8 + q] * rstd * gg[q] + bv[q]; v[j * 8 + q] = o[q]; }
            if (final_out) { __builtin_nontemporal_store((f32x4){o[0], o[1], o[2], o[3]}, (f32x4*)(OUT + (size_t)tok * DM + c0)); __builtin_nontemporal_store((f32x4){o[4], o[5], o[6], o[7]}, (f32x4*)(OUT + (size_t)tok * DM + c0 + 4)); }
            else *(u32x4*)(HO + (size_t)tok * DM + c0) = pack8(o); }
        if (!final_out) { float am = 0.f;
#pragma unroll
            for (int q = 0; q < 32; ++q) am = fmaxf(am, fabsf(v[q]));
            am = wave_max(am); const float inv = am > 0.f ? 127.0f / am : 0.f;
#pragma unroll
            for (int j = 0; j < 4; ++j) { u32x2 w2; w2.x = pg8::pk_fp8x4(v[j * 8] * pg8::act_scale(), v[j * 8 + 1] * pg8::act_scale(), v[j * 8 + 2] * pg8::act_scale(), v[j * 8 + 3] * pg8::act_scale());
                w2.y = pg8::pk_fp8x4(v[j * 8 + 4] * pg8::act_scale(), v[j * 8 + 5] * pg8::act_scale(), v[j * 8 + 6] * pg8::act_scale(), v[j * 8 + 7] * pg8::act_scale()); *(u32x2*)(H8 + (size_t)tok * DM + lane * 8 + 512 * j) = w2; }
            (void)inv; (void)HS; }
    }
}

constexpr int PH_PER_LAYER = 9, N_PHASES = 2 + DEPTH * PH_PER_LAYER;
#ifndef PH_MASK
#define PH_MASK 0xFFFFFFFFu
#endif
#define PHM(b) ((PH_MASK >> (b)) & 1u)
#define REP(b) _Pragma("unroll") for (int rep_ = 0; rep_ < 1 + (int)((PH_DUP >> (b)) & 1u); ++rep_)
__global__ void __launch_bounds__(512, 2) mk_fwd(Args args) {
    extern __shared__ __attribute__((aligned(16))) unsigned char lds_raw[];
    Frame F;
    F.lds = (LAS unsigned char*)lds_raw;
    F.wave0 = __builtin_amdgcn_readfirstlane((int)threadIdx.x >> 6);
    frame_refresh(F);
    volatile LAS unsigned* MISC = (volatile LAS unsigned*)(F.lds + MISC_OFF);
    for (int u = F.tid; u < (LDS_BYTES - LDSCTL_OFF) / 4; u += 512) ((LAS unsigned*)(F.lds + LDSCTL_OFF))[u] = 0u;
    __syncthreads();
    unsigned* ctl = (unsigned*)(fws(F) + WS_CTL);
    XcdBarrier bar; bar.bar = ctl + CW_BAR; bar.x = 0; bar.st = nullptr;
    const int lo = args.ph_lo, hi = args.ph_hi;
    const bool multi = (hi - lo) > 1;
    if (multi) bar = xcd_barrier_post(ctl + CW_BAR, MISC + 8);
#define IN(k) (frame_refresh(F), (lo <= (k) && (k) < hi))
#define SEAM(k) do { if (lo <= (k) && (k) + 1 < hi) { _Pragma("unroll") for (int rb_ = 0; rb_ < 1 + (int)((PH_DUP >> 16) & 1u); ++rb_) { XcdBarrier b2_ = bar; asm volatile("" : "+s"(b2_.bar)); xcd_barrier(b2_, F.wave0 == 0 && lane_fresh() == 0); } } } while (0)
    if (IN(0) && PHM(0)) {
        REP(0) wabs_phase(F, 0);
        REP(14) ln_emb(F);
        if (F.bx == 0) { float* LB = (float*)(fws(F) + WS_TST + 128); const float* hl = fin(F, 6); for (int d = F.tid; d < 512; d += 512) LB[d] = 1.0f / (1.0f + __expf(hl[d] - hl[512 + d])); }
    }
    SEAM(0);
    if (IN(1) && PHM(0)) { REP(15) { convert_weights(F, 0); __syncthreads(); } }
    SEAM(1);
#pragma unroll 1
    for (int l = 0; l < DEPTH; ++l) {
        const int p0 = 2 + l * PH_PER_LAYER;
        const float* lbp = (l == 0) ? nullptr : (const float*)(fws(F) + WS_TST + 128);
        if (IN(p0 + 0) && PHM(1)) REP(1) {
            const float* ABS = (const float*)(fws(F) + WS_CTL + CTL_ABS) + (size_t)l * ABS_PER_LAYER;
            pg8::Gemm g{(const bf16*)(fws(F) + WS_H8), (const bf16*)(fws(F) + WS_WIN), DM / 2}; pg8::StaticOrder S; S.init(T_TOK / 256, NPROJ / 256, F.G, F.bx);
            pg8::EpiBf16F8 E{(bf16*)(fws(F) + WS_PROJ), NPROJ, (const float*)(fws(F) + WS_INS) + l}; (void)ABS;
            pg8::gemm_phase<pg8::EpiBf16F8, pg8::StaticOrder, false>(F.lds, F.tid, g, S, E, nullptr);
            if (l == 0) { frame_refresh(F); wabs_tail(F, (T_TOK / 256) * (NPROJ / 256), 0, WABS_T1); }
        }
        SEAM(p0 + 0);
        if (IN(p0 + 1)) { if (PHM(4)) REP(4) gla_seq_phase(F, l, lbp); if (PHM(2)) REP(2) attn_phase(F, l); }
        SEAM(p0 + 1);
        if (IN(p0 + 2) && PHM(5)) REP(5) gla_norm_phase(F, l);
        SEAM(p0 + 2);
        if (IN(p0 + 3) && PHM(7)) REP(7) {
            __syncthreads();
            const float* ABS = (const float*)(fws(F) + WS_CTL + CTL_ABS) + (size_t)l * ABS_PER_LAYER;
            pg8::Gemm g{(const bf16*)(fws(F) + WS_Y8), (const bf16*)(fws(F) + WS_WOUT), DM / 2}; pg8::StaticOrder S; S.init(T_TOK / 256, DM / 256, F.G, F.bx);
            pg8::EpiI8Tile<true> E{fws(F) + WS_MIX, DM, (float*)(fws(F) + WS_MSC), 8, (const float*)(fws(F) + WS_YSC), ABS + ABS_OUT, (LAS float*)(F.lds + RING_BYTES)};
            pg8::gemm_phase<pg8::EpiI8Tile<true>, pg8::StaticOrder, false>(F.lds, F.tid, g, S, E, nullptr);
        }
        SEAM(p0 + 3);
        if (IN(p0 + 4) && PHM(8)) {
#pragma unroll 1
            for (int rep_ = 0; rep_ < 1 + (int)((PH_DUP >> 8) & 1u); ++rep_) ln1_router_phase(F, l, rep_ == 1); }
        SEAM(p0 + 4);
        if (IN(p0 + 5) && PHM(9)) REP(9) assign_phase(F);
        SEAM(p0 + 5);
        if (IN(p0 + 6) && PHM(10)) REP(10) {
            __syncthreads();
            const int* TST = (const int*)(fws(F) + WS_TST);
            const float* ABS = (const float*)(fws(F) + WS_CTL + CTL_ABS) + (size_t)l * ABS_PER_LAYER;
            pg8::Gemm g{(const bf16*)(fws(F) + WS_H8), (const bf16*)(fws(F) + WS_WGU), DM / 2}; pg8::MoeOrder S; S.init(__builtin_amdgcn_readfirstlane(TST[16]), 8, F.G, F.bx); S.tile_start = TST; S.expert_stride = (size_t)2048 * DM;
            pg8::EpiSwiGLUF8 E{fws(F) + WS_HID, DEXP, (const float*)(fws(F) + WS_GUS) + l * 2 * NEXP, TST}; (void)ABS;
            pg8::gemm_phase<pg8::EpiSwiGLUF8, pg8::MoeOrder, true>(F.lds, F.tid, g, S, E, (const int*)(fws(F) + WS_TOS));
            if (l == 0) { frame_refresh(F); const int nu = ((const int*)(fws(F) + WS_TST))[16] * 8; wabs_tail(F, nu, WABS_T1, wabs_t2(F.G, nu)); }
        }
        SEAM(p0 + 6);
        if (IN(p0 + 7) && PHM(11)) REP(11) {
            const int* TST = (const int*)(fws(F) + WS_TST);
            pg8::Gemm g{(const bf16*)(fws(F) + WS_HID), (const bf16*)(fws(F) + WS_WD), DEXP / 2}; pg8::MoeOrder S; S.init(__builtin_amdgcn_readfirstlane(TST[16]), 8, F.G, F.bx); S.tile_start = TST; S.expert_stride = (size_t)DM * DEXP;
            pg8::EpiF8Out E{fws(F) + WS_YS, DM, (const float*)(fws(F) + WS_WDS) + l * NEXP, TST};
            pg8::gemm_phase<pg8::EpiF8Out, pg8::MoeOrder, false>(F.lds, F.tid, g, S, E, nullptr);
            if (l == 0) { frame_refresh(F); const int nu = ((const int*)(fws(F) + WS_TST))[16] * 8; wabs_tail(F, nu, wabs_t2(F.G, nu), WABS_PER_L); }
        }
        SEAM(p0 + 7);
        if (IN(p0 + 8)) { if (PHM(12)) { if ((PH_DUP >> 12) & 1u) combine_ln2_phase(F, l, false, true); combine_ln2_phase(F, l, l == DEPTH - 1); } if (PHM(13) && l + 1 < DEPTH) { __syncthreads(); convert_weights(F, l + 1); } }
        if (l + 1 < DEPTH) SEAM(p0 + 8);
    }
#undef IN
#undef SEAM
}

extern "C" void kernel_launch(void* const* d_in, const int* in_sizes, int n_in, void* d_out, int out_size, void* d_ws, size_t ws_size, hipStream_t stream) {
    static int grid = 0;
    if (grid == 0) {
        if (n_in != 20 || out_size != T_TOK * DM || ws_size < WS_END) { fprintf(stderr, "kernel_launch: unexpected shapes (n_in %d out %d ws %zu)\n", n_in, out_size, ws_size); grid = -1; return; }
        int dev = 0, cus = 0;
        if (hipGetDevice(&dev) != hipSuccess || hipDeviceGetAttribute(&cus, hipDeviceAttributeMultiprocessorCount, dev) != hipSuccess) { grid = -1; return; }
        if (hipFuncSetAttribute((const void*)mk_fwd, hipFuncAttributeMaxDynamicSharedMemorySize, LDS_BYTES) != hipSuccess) { fprintf(stderr, "kernel_launch: hipFuncSetAttribute failed\n"); grid = -1; return; }
        int per_cu = 0;
        if (hipOccupancyMaxActiveBlocksPerMultiprocessor(&per_cu, (const void*)mk_fwd, 512, LDS_BYTES) != hipSuccess || per_cu < 1) fprintf(stderr, "kernel_launch: occupancy query reports %d\n", per_cu);
        (void)hipGetLastError();
        grid = cus;
    }
    if (grid < 0) return;
    (void)hipMemsetAsync((char*)d_ws + WS_CTL, 0, CTL_ZERO_BYTES, stream);
    Args a{};
    for (int i = 0; i < 20; ++i) a.in[i] = (const float*)d_in[i];
    a.out = (float*)d_out; a.ws = (unsigned char*)d_ws;
#if MK_ONE_LAUNCH
    a.ph_lo = 0; a.ph_hi = N_PHASES;
    hipLaunchKernelGGL(mk_fwd, dim3(grid), dim3(512), LDS_BYTES, stream, a);
#else
    for (int p = 0; p < N_PHASES; ++p) { a.ph_lo = p; a.ph_hi = p + 1; hipLaunchKernelGGL(mk_fwd, dim3(grid), dim3(512), LDS_BYTES, stream, a); }
#endif
}
```
